# Optimizing an MI355X kernel written in HIP

```python
import jax, jax.numpy as jnp
from jax import lax
import numpy as np

D_MODEL = 2048
BATCH = 4
SEQ = 2048
DEPTH = 1

N_META = 16
HEAD_DIM = 64
N_Q_HEADS = 32
N_KV_HEADS = 4
GQA_GROUP = N_Q_HEADS // N_KV_HEADS
WINDOW = 128
BLOCK = WINDOW
ATTN_WIDTH = N_Q_HEADS * HEAD_DIM
KV_WIDTH = N_KV_HEADS * HEAD_DIM
CONV_WIDTH = D_MODEL
CONV_K = 3
N_GROUPS = 4
EXPERTS_PER_GROUP = 8
N_EXPERTS = N_GROUPS * EXPERTS_PER_GROUP
TOP_K = 2
D_EXPERT = D_MODEL // 4
LN_EPS = 1e-5
ALPHA = (2.0 * DEPTH) ** 0.25
BETA = (8.0 * DEPTH) ** -0.25
NEG_INF = -1e30
IN_SIZES = (ATTN_WIDTH, KV_WIDTH, KV_WIDTH, CONV_WIDTH, CONV_WIDTH, CONV_WIDTH, D_MODEL, D_MODEL)
IN_COLS = sum(IN_SIZES)
IN_SPLITS = tuple(int(v) for v in np.cumsum(IN_SIZES)[:-1])

kernel_name = "hybrid_swa_sink_shortconv_hmoe_deepnorm"


def layer_norm(x, g, b):
    x32 = x.astype(jnp.float32)
    mu = jnp.mean(x32, axis=-1, keepdims=True)
    var = jnp.mean(jnp.square(x32 - mu), axis=-1, keepdims=True)
    y = (x32 - mu) * lax.rsqrt(var + LN_EPS)
    return (y * g.astype(jnp.float32) + b.astype(jnp.float32)).astype(x.dtype)


def softmax_with_sink(logits, sink):
    sink_col = jnp.broadcast_to(sink[:, :, None, None], logits.shape[:-1] + (1,))
    full = jnp.concatenate([logits, sink_col], axis=-1)
    return jax.nn.softmax(full, axis=-1)[..., :-1]


def sliding_window_sink_attention(q, k, v, sinks):
    b, l = q.shape[0], q.shape[1]
    s = l - N_META
    nb = s // BLOCK
    scale = HEAD_DIM ** -0.5
    f32 = jnp.float32
    q = q.reshape(b, l, N_KV_HEADS, GQA_GROUP, HEAD_DIM)
    sink = sinks.astype(f32).reshape(N_KV_HEADS, GQA_GROUP)
    qm, qr = q[:, :N_META], q[:, N_META:]
    km, kr = k[:, :N_META], k[:, N_META:]
    vm, vr = v[:, :N_META], v[:, N_META:]

    sm = jnp.einsum('bqkgd,bskd->bkgqs', qm, km, preferred_element_type=f32) * scale
    causal = jnp.tril(jnp.ones((N_META, N_META), dtype=bool))
    sm = jnp.where(causal, sm, NEG_INF)
    pm = softmax_with_sink(sm, sink).astype(v.dtype)
    om = jnp.einsum('bkgqs,bskd->bqkgd', pm, vm)

    qb = qr.reshape(b, nb, BLOCK, N_KV_HEADS, GQA_GROUP, HEAD_DIM)
    kb = kr.reshape(b, nb, BLOCK, N_KV_HEADS, HEAD_DIM)
    vb = vr.reshape(b, nb, BLOCK, N_KV_HEADS, HEAD_DIM)
    zpad = jnp.zeros_like(kb[:, :1])
    k_band = jnp.concatenate([jnp.concatenate([zpad, kb[:, :-1]], axis=1), kb], axis=2)
    v_band = jnp.concatenate([jnp.concatenate([zpad, vb[:, :-1]], axis=1), vb], axis=2)
    s_meta = jnp.einsum('bnqkgd,bmkd->bnkgqm', qb, km, preferred_element_type=f32) * scale
    s_band = jnp.einsum('bnqkgd,bnskd->bnkgqs', qb, k_band, preferred_element_type=f32) * scale
    qi = jnp.arange(BLOCK)[:, None]
    si = jnp.arange(2 * BLOCK)[None, :]
    rel = qi + BLOCK - si
    blk = jnp.arange(nb)[:, None, None]
    valid = (rel >= 0) & (rel < WINDOW) & ((blk > 0) | (si >= BLOCK))
    s_band = jnp.where(valid[None, :, None, None], s_band, NEG_INF)
    p = softmax_with_sink(jnp.concatenate([s_meta, s_band], axis=-1), sink).astype(v.dtype)
    p_meta, p_band = p[..., :N_META], p[..., N_META:]
    orl = (jnp.einsum('bnkgqm,bmkd->bnqkgd', p_meta, vm)
           + jnp.einsum('bnkgqs,bnskd->bnqkgd', p_band, v_band))
    orl = orl.reshape(b, s, ATTN_WIDTH)
    return jnp.concatenate([om.reshape(b, N_META, ATTN_WIDTH), orl], axis=1)


def causal_depthwise_conv(u, w):
    l = u.shape[1]
    up = jnp.pad(u, ((0, 0), (CONV_K - 1, 0), (0, 0)))
    return sum(w[j] * up[:, j:j + l] for j in range(CONV_K))


def token_mixers(h, w_in, sinks, conv_w, w_branch_attn, w_branch_conv, w_out):
    b, l, _ = h.shape
    proj = h @ w_in
    q, k, v, cb, cc, ch, ga, gc = jnp.split(proj, IN_SPLITS, axis=-1)
    attn = sliding_window_sink_attention(
        q.reshape(b, l, N_Q_HEADS, HEAD_DIM),
        k.reshape(b, l, N_KV_HEADS, HEAD_DIM),
        v.reshape(b, l, N_KV_HEADS, HEAD_DIM), sinks)
    y_attn = attn @ w_branch_attn
    y_conv = (cb * causal_depthwise_conv(cc * ch, conv_w)) @ w_branch_conv
    merged = jax.nn.sigmoid(ga) * y_attn + jax.nn.sigmoid(gc) * y_conv
    return merged @ w_out


def hierarchical_moe(h, rg_w, rg_b, re_w, re_b, w_gate, w_up, w_down):
    n = h.shape[0]
    f32 = jnp.float32
    g_prob = jax.nn.softmax((h @ rg_w + rg_b).astype(f32), axis=-1)
    p_group, g_sel = lax.top_k(g_prob, 1)
    e_logits = (h @ re_w + re_b).astype(f32).reshape(n, N_GROUPS, EXPERTS_PER_GROUP)
    e_in = jnp.take_along_axis(e_logits, g_sel[:, :, None], axis=1)[:, 0]
    top_p, top_i = lax.top_k(jax.nn.softmax(e_in, axis=-1), TOP_K)
    top_w = top_p / jnp.sum(top_p, axis=-1, keepdims=True) * p_group
    e_idx = g_sel * EXPERTS_PER_GROUP + top_i
    combine = jnp.zeros((n, N_EXPERTS), f32).at[jnp.arange(n)[:, None], e_idx].add(top_w)
    combine = combine.astype(h.dtype)
    out = jnp.zeros_like(h)
    for e in range(N_EXPERTS):
        y = (jax.nn.silu(h @ w_gate[e]) * (h @ w_up[e])) @ w_down[e]
        out = out + combine[:, e:e + 1] * y
    return out


def setup_inputs(seed: int = 0) -> dict:
    key = jax.random.key(seed)
    ks = jax.random.split(key, 24)
    nrm = lambda k, shape, s: jax.random.normal(k, shape, jnp.float32) * s
    D = D_MODEL
    return {
        "x": nrm(ks[0], (BATCH, SEQ, D), 1.0),
        "meta_tokens": nrm(ks[1], (N_META, D), 1.0),
        "ln_in_g": 1.0 + nrm(ks[2], (D,), 0.02),
        "ln_in_b": nrm(ks[3], (D,), 0.02),
        "w_in": nrm(ks[4], (DEPTH, D, IN_COLS), D ** -0.5),
        "sinks": nrm(ks[5], (DEPTH, N_Q_HEADS), 1.0),
        "conv_w": nrm(ks[6], (DEPTH, CONV_K, CONV_WIDTH), CONV_K ** -0.5),
        "w_branch_attn": nrm(ks[7], (DEPTH, ATTN_WIDTH, D), ATTN_WIDTH ** -0.5),
        "w_branch_conv": nrm(ks[8], (DEPTH, CONV_WIDTH, D), CONV_WIDTH ** -0.5),
        "w_out": nrm(ks[9], (DEPTH, D, D), BETA * D ** -0.5),
        "ln1_g": 1.0 + nrm(ks[10], (DEPTH, D), 0.02),
        "ln1_b": nrm(ks[11], (DEPTH, D), 0.02),
        "router_group_w": nrm(ks[12], (DEPTH, D, N_GROUPS), D ** -0.5),
        "router_group_b": nrm(ks[13], (DEPTH, N_GROUPS), 0.01),
        "router_expert_w": nrm(ks[14], (DEPTH, D, N_EXPERTS), D ** -0.5),
        "router_expert_b": nrm(ks[15], (DEPTH, N_EXPERTS), 0.01),
        "w_gate": nrm(ks[16], (DEPTH, N_EXPERTS, D, D_EXPERT), D ** -0.5),
        "w_up": nrm(ks[17], (DEPTH, N_EXPERTS, D, D_EXPERT), D ** -0.5),
        "w_down": nrm(ks[18], (DEPTH, N_EXPERTS, D_EXPERT, D), BETA * D_EXPERT ** -0.5),
        "ln2_g": 1.0 + nrm(ks[19], (DEPTH, D), 0.02),
        "ln2_b": nrm(ks[20], (DEPTH, D), 0.02),
    }


def reference(x, meta_tokens, ln_in_g, ln_in_b, w_in, sinks, conv_w, w_branch_attn, w_branch_conv,
              w_out, ln1_g, ln1_b, router_group_w, router_group_b, router_expert_w, router_expert_b,
              w_gate, w_up, w_down, ln2_g, ln2_b):
    b = x.shape[0]
    meta = jnp.broadcast_to(meta_tokens[None].astype(x.dtype), (b, N_META, D_MODEL))
    h = layer_norm(jnp.concatenate([meta, x], axis=1), ln_in_g, ln_in_b)
    for layer in range(DEPTH):
        mix = token_mixers(h, w_in[layer], sinks[layer], conv_w[layer], w_branch_attn[layer],
                           w_branch_conv[layer], w_out[layer])
        h = layer_norm(ALPHA * h + mix, ln1_g[layer], ln1_b[layer])
        f = hierarchical_moe(h.reshape(-1, D_MODEL), router_group_w[layer], router_group_b[layer],
                             router_expert_w[layer], router_expert_b[layer], w_gate[layer],
                             w_up[layer], w_down[layer]).reshape(h.shape)
        h = layer_norm(ALPHA * h + f, ln2_g[layer], ln2_b[layer])
    return h[:, N_META:]
```

```cpp
#include <hip/hip_runtime.h>
#include <cstdio>
#include <cstdint>

#ifndef MK_N_LAUNCHES
#define MK_N_LAUNCHES 1
#endif

__device__ __forceinline__ int lane_id() { int l = (int)__builtin_amdgcn_mbcnt_hi(~0u, __builtin_amdgcn_mbcnt_lo(~0u, 0u)); asm volatile("" : "+v"(l)); return l; }
namespace pg8 {
#define PG8_LAS __attribute__((address_space(3)))
typedef unsigned short bf16_t;
typedef short bf16x8 __attribute__((ext_vector_type(8)));
typedef float f32x4 __attribute__((ext_vector_type(4)));
typedef float f32x2 __attribute__((ext_vector_type(2)));
typedef unsigned u32x4 __attribute__((ext_vector_type(4)));
typedef unsigned u32x2 __attribute__((ext_vector_type(2)));
constexpr int BM = 256, BK = 64, HALF = 128, HTB = HALF * BK * 2  , STAGE_BYTES = 8 * HTB, NXCD = 8, WGM = 8;

__host__ __device__ __forceinline__ int lds_byte(int r, int c) { const int st = (r >> 4) * 2 + (c >> 5), rr = r & 15, cc = c & 31, ob = rr * 64 + cc * 2; return st * 1024 + (ob ^ (((ob >> 9) & 1) << 5)); }
__host__ __device__ __forceinline__ void stage_rc(int b, int& R, int& C) { const int st = b / 1024, sb = b % 1024, swz = sb ^ (((sb >> 9) & 1) << 5); R = (st >> 1) * 16 + swz / 64; C = (st & 1) * 32 + (swz % 64) / 2; }
__host__ __device__ __forceinline__ int perm32(int rho) { const int n = rho >> 4, i = rho & 15; return 8 * (i >> 2) + 4 * n + (i & 3); }

struct Unit { int pm, pn; long a_byte, b_byte; int e, mt, cnt; };
struct Gemm { const bf16_t* A; const bf16_t* Bt; int lda; int K; int tmid; };

__device__ __forceinline__ unsigned cvt_pk_bf16(float lo, float hi) { unsigned r; asm volatile("v_cvt_pk_bf16_f32 %0, %1, %2" : "=v"(r) : "v"(lo), "v"(hi)); return r; }
__device__ __forceinline__ float bf_lo(unsigned u) { return __builtin_bit_cast(float, u << 16); }
__device__ __forceinline__ float bf_hi(unsigned u) { return __builtin_bit_cast(float, u & 0xffff0000u); }

template <class Epi, class Sched, bool ALIGN_EPI>
__device__ __forceinline__ void gemm_phase(PG8_LAS unsigned char* lds, const Gemm g, const Sched& S, const Epi& E) {
    constexpr bool GATHER = Sched::GATHER;
    const int lane = lane_id(), wid = S.wave, tid = wid * 64 + lane, wr = wid >> 2, wc = wid & 3, fr = lane & 15, fq = lane >> 4;
    const int K = g.K, nt = K / BK, lda = g.lda;
    unsigned voffA[2], voffB[2]; int rA[2]; unsigned cA2[2];
#pragma unroll
    for (int i = 0; i < 2; ++i) { int R, C; stage_rc(tid * 16 + i * 8192, R, C); const int Rb = Epi::PERM ? ((R & ~31) + perm32(R & 31)) : R;
        voffA[i] = (unsigned)(R * lda + C) * 2u; voffB[i] = (unsigned)(Rb * K + C) * 2u; rA[i] = R; cA2[i] = (unsigned)C * 2u; }
    const size_t kstep = (size_t)(BK * 2);
    const size_t hstepA = (size_t)HALF * lda * 2, hstepB = (size_t)HALF * K * 2;
    const unsigned ldsw = (unsigned)wid * 1024u;
    const int aoff = lds_byte(wr * 64 + fr, fq * 8), boff = lds_byte(wc * 32 + fr, fq * 8);
#define PG8_SA(b, h) (((b) * 2 + (h)) * HTB)
#define PG8_SB(b, h) ((4 + (b) * 2 + (h)) * HTB)
#define PG8_GLDS(gp, ldsoff) __builtin_amdgcn_global_load_lds((const unsigned*)(gp), (PG8_LAS unsigned*)(lds + (ldsoff)), 16, 0, 0)
#define PG8_STAGE_O(bufoff, gbase, o0, o1) do { PG8_GLDS((const char*)(gbase) + (o0), (bufoff) + ldsw); PG8_GLDS((const char*)(gbase) + (o1), (bufoff) + ldsw + 8192); } while (0)
#define PG8_STB(bufoff, gbase) PG8_STAGE_O(bufoff, gbase, voffB[0], voffB[1])
#define PG8_STA(bufoff, ap, h, V) do { if constexpr (GATHER) PG8_STAGE_O(bufoff, ap, V[h][0], V[h][1]); else PG8_STAGE_O(bufoff, (ap) + (h) * hstepA, voffA[0], voffA[1]); } while (0)
#define PG8_LDA(dst, b, h) do { _Pragma("unroll") for (int m = 0; m < 4; ++m) _Pragma("unroll") for (int k = 0; k < 2; ++k) dst[m][k] = *(const PG8_LAS bf16x8*)(lds + PG8_SA(b, h) + aoff + m * 2048 + k * 1024); } while (0)
#define PG8_LDB(dst, b, h) do { _Pragma("unroll") for (int n = 0; n < 2; ++n) _Pragma("unroll") for (int k = 0; k < 2; ++k) dst[n][k] = *(const PG8_LAS bf16x8*)(lds + PG8_SB(b, h) + boff + n * 2048 + k * 1024); } while (0)
#define PG8_MMA(ai, bj, At, Bt) do { __builtin_amdgcn_s_setprio(1); _Pragma("unroll") for (int m = 0; m < 4; ++m) _Pragma("unroll") for (int n = 0; n < 2; ++n) _Pragma("unroll") for (int k = 0; k < 2; ++k) \
        acc[ai][bj][m][n] = __builtin_amdgcn_mfma_f32_16x16x32_bf16(Bt[n][k], At[m][k], acc[ai][bj][m][n], 0, 0, 0); __builtin_amdgcn_s_setprio(0); } while (0)
#define PG8_WAIT_V(n) asm volatile("s_waitcnt vmcnt(" #n ")" ::: "memory")
#define PG8_WAIT_L(n) asm volatile("s_waitcnt lgkmcnt(" #n ")" ::: "memory")
#define PG8_BAR __builtin_amdgcn_s_barrier()
#define PG8_SCHED __builtin_amdgcn_sched_barrier(0)
    Unit cur, nxt; int ui = 0;
    if (!S.next(0, cur)) return;
    f32x4 acc[2][2][4][2];
#pragma unroll
    for (int a = 0; a < 2; ++a)
#pragma unroll
        for (int b = 0; b < 2; ++b)
#pragma unroll
            for (int m = 0; m < 4; ++m)
#pragma unroll
                for (int n = 0; n < 2; ++n) acc[a][b][m][n] = (f32x4){0.f, 0.f, 0.f, 0.f};
    bf16x8 At[4][2], B0[2][2], B1[2][2];
    unsigned va[2][2], nva[2][2];
    if constexpr (GATHER) {
#pragma unroll
        for (int h = 0; h < 2; ++h)
#pragma unroll
            for (int i = 0; i < 2; ++i) { va[h][i] = S.row_byte(cur, h * HALF + rA[i]) + cA2[i]; nva[h][i] = va[h][i]; }
    } else { va[0][0] = va[0][1] = va[1][0] = va[1][1] = 0u; nva[0][0] = nva[0][1] = nva[1][0] = nva[1][1] = 0u; }
    const char* cA = (const char*)g.A + cur.a_byte; const char* cB = (const char*)g.Bt + cur.b_byte;
    PG8_STB(PG8_SB(0, 0), cB); PG8_STB(PG8_SB(0, 1), cB + hstepB); PG8_STA(PG8_SA(0, 0), cA, 0, va); PG8_STA(PG8_SA(0, 1), cA, 1, va);
    if (wr == 1) PG8_BAR;
    PG8_WAIT_V(2); PG8_BAR;
    PG8_STB(PG8_SB(1, 0), cB + kstep); PG8_STA(PG8_SA(1, 0), cA + kstep, 0, va); PG8_STB(PG8_SB(1, 1), cB + hstepB + kstep);
    PG8_WAIT_V(6); PG8_BAR;
    for (;;) {
        const bool has_next = S.next(ui + 1, nxt);
        const char* nA = has_next ? (const char*)g.A + nxt.a_byte : cA; const char* nB = has_next ? (const char*)g.Bt + nxt.b_byte : cB;
        if constexpr (GATHER) {
            if (has_next) {
#pragma unroll
                for (int h = 0; h < 2; ++h)
#pragma unroll
                    for (int i = 0; i < 2; ++i) nva[h][i] = S.row_byte(nxt, h * HALF + rA[i]) + cA2[i];
            }
            asm volatile("" : "+v"(nva[0][0]), "+v"(nva[0][1]), "+v"(nva[1][0]), "+v"(nva[1][1]));
        }
        for (int t = 0; t < nt; t += 2) {
            const bool last = (t == nt - 2);
            if constexpr (Epi::MID) { if (t == g.tmid) E.mid(acc, cur, wr, wc, fr, fq); }
            const char* a1 = cA + (size_t)(t + 1) * kstep;
            const char* a2 = last ? nA : cA + (size_t)(t + 2) * kstep; const char* b2 = last ? nB : cB + (size_t)(t + 2) * kstep;
            const char* a3 = a2 + kstep; const char* b3 = b2 + kstep;
            unsigned xa[2][2];
#pragma unroll
            for (int h = 0; h < 2; ++h)
#pragma unroll
                for (int i = 0; i < 2; ++i) xa[h][i] = last ? nva[h][i] : va[h][i];
            PG8_LDB(B0, 0, 0); PG8_LDB(B1, 0, 1); PG8_SCHED; PG8_LDA(At, 0, 0); PG8_STA(PG8_SA(1, 1), a1, 1, va);
            PG8_WAIT_V(8); PG8_WAIT_L(0); PG8_BAR; PG8_MMA(0, 0, At, B0); PG8_MMA(0, 1, At, B1); PG8_BAR; PG8_SCHED;
            PG8_LDA(At, 0, 1); PG8_STB(PG8_SB(0, 0), b2); PG8_STB(PG8_SB(0, 1), b2 + hstepB); PG8_STA(PG8_SA(0, 0), a2, 0, xa);
            PG8_WAIT_V(8); PG8_WAIT_L(0); PG8_BAR; PG8_MMA(1, 0, At, B0); PG8_MMA(1, 1, At, B1); PG8_BAR; PG8_SCHED;
            PG8_LDB(B0, 1, 0); PG8_LDB(B1, 1, 1); PG8_SCHED; PG8_LDA(At, 1, 0); PG8_STA(PG8_SA(0, 1), a2, 1, xa);
            PG8_WAIT_V(8); PG8_WAIT_L(0); PG8_BAR; PG8_MMA(0, 0, At, B0); PG8_MMA(0, 1, At, B1); PG8_BAR; PG8_SCHED;
            PG8_LDA(At, 1, 1); PG8_STB(PG8_SB(1, 0), b3); PG8_STB(PG8_SB(1, 1), b3 + hstepB); PG8_STA(PG8_SA(1, 0), a3, 0, xa);
            PG8_WAIT_V(8); PG8_WAIT_L(0); PG8_BAR; PG8_MMA(1, 0, At, B0); PG8_MMA(1, 1, At, B1); PG8_BAR; PG8_SCHED;
        }
        if constexpr (ALIGN_EPI) { if (wr == 0) PG8_BAR; }
        E(acc, cur, wr, wc, fr, fq);
        if (!has_next) break;
#pragma unroll
        for (int a = 0; a < 2; ++a)
#pragma unroll
            for (int b = 0; b < 2; ++b)
#pragma unroll
                for (int m = 0; m < 4; ++m)
#pragma unroll
                    for (int n = 0; n < 2; ++n) acc[a][b][m][n] = (f32x4){0.f, 0.f, 0.f, 0.f};
        cur = nxt; cA = nA; cB = nB; ++ui;
        if constexpr (GATHER) {
#pragma unroll
            for (int h = 0; h < 2; ++h)
#pragma unroll
                for (int i = 0; i < 2; ++i) va[h][i] = nva[h][i];
        }
        if constexpr (ALIGN_EPI) { if (wr == 1) PG8_BAR; }
    }
    PG8_WAIT_V(0);
    if constexpr (!ALIGN_EPI) { if (wr == 0) PG8_BAR; }
    PG8_BAR;
#undef PG8_SA
#undef PG8_SB
#undef PG8_GLDS
#undef PG8_STAGE_O
#undef PG8_STB
#undef PG8_STA
#undef PG8_LDA
#undef PG8_LDB
#undef PG8_MMA
#undef PG8_WAIT_V
#undef PG8_WAIT_L
#undef PG8_BAR
#undef PG8_SCHED
}
}

constexpr int NWAVES = 8;
constexpr int N_LAUNCHES = MK_N_LAUNCHES;
constexpr int PER_PHASE = 9;
constexpr int BATCH = 4, SEQ = 2048, DM = 2048, NMETA = 16;
constexpr int MREAL = BATCH * SEQ;
constexpr int MPAD = MREAL + 256;
constexpr int LDP = 12800;
constexpr int PC_Q = 0, PC_CB = 2048, PC_K = 4096, PC_V = 4352, PC_CC = 4608, PC_CH = 6656, PC_GA = 8704, PC_GC = 10752;
constexpr int NQH = 32, NKVH = 4, HD = 64, WIN = 128;
constexpr int NEXP = 32, NGRP = 4, EPG = 8, DE = 512;
constexpr float LN_EPS = 1e-5f;
constexpr float ALPHA = 1.189207115002721f;
constexpr int MOE_ROWS_MAX = 2 * MREAL + NEXP * 256;

constexpr size_t MiB = 1u << 20;
constexpr size_t WS_CTL = 0, CTL_ZERO_BYTES = 1 * MiB;
constexpr size_t WS_ROWIDX = 1 * MiB;
constexpr size_t WS_TOKW = 2 * MiB;
constexpr size_t WS_REWG = 3 * MiB;
constexpr size_t WS_WIN = 4 * MiB;
constexpr size_t WS_WB2 = 54 * MiB;
constexpr size_t WS_WOUT = 70 * MiB;
constexpr size_t WS_WGU = 78 * MiB;
constexpr size_t WS_WD = 206 * MiB;
constexpr size_t WS_XN = 270 * MiB;
constexpr size_t WS_P = 303 * MiB;
constexpr size_t WS_ACT = WS_P;
constexpr size_t WS_Y = WS_P + 24 * MiB;
constexpr size_t WS_END = 510 * MiB;
static_assert(WS_P + (size_t)MPAD * LDP * 2 <= WS_END && WS_Y + (size_t)2 * MREAL * DM * 2 <= WS_END && (size_t)MOE_ROWS_MAX * DE * 2 <= 24 * MiB, "ws map");
constexpr int CW_TMO = 0, CW_CODE = 1;
constexpr int CW_CNT = 64;
constexpr int CW_BAR = 4096;

constexpr int RING_OFF = 0, RING_BYTES = 131072;
constexpr int LDSCTL_OFF = RING_BYTES, MISC_OFF = LDSCTL_OFF + 320;
constexpr int LDS_BYTES = 147456;

#define GAS __attribute__((address_space(1)))
#define LAS __attribute__((address_space(3)))
typedef unsigned short bf16;
typedef unsigned v4u __attribute__((ext_vector_type(4)));
typedef unsigned v2u __attribute__((ext_vector_type(2)));
typedef float f32x4 __attribute__((ext_vector_type(4)));
typedef float f32x16 __attribute__((ext_vector_type(16)));
typedef short bf16x8 __attribute__((ext_vector_type(8)));
typedef short s16x4 __attribute__((ext_vector_type(4)));
typedef GAS unsigned gu32;
#define RLX_AGENT __ATOMIC_RELAXED, __HIP_MEMORY_SCOPE_AGENT
#define LDS_WAIT() asm volatile("s_waitcnt lgkmcnt(0)" ::: "memory")
#define VM_WAIT() asm volatile("s_waitcnt vmcnt(0)" ::: "memory")
__device__ __forceinline__ unsigned f2bf(float f) { unsigned u = __builtin_bit_cast(unsigned, f); return (u + 0x7fffu + ((u >> 16) & 1u)) >> 16; }
__device__ __forceinline__ unsigned pk2(float lo, float hi) { return f2bf(lo) | (f2bf(hi) << 16); }
using pg8::bf_lo; using pg8::bf_hi; using pg8::cvt_pk_bf16;

#define XB_TMO      128
#define XB_XCNT(j)  (256  + 64 * (j))
#define XB_XSUB(j)  (1280 + 64 * (j))
#define XB_XGEN(j)  (2304 + 64 * (j))
#define XB_TOP      3328
#define XB_TOPGEN   3392
#define XCD_BAR_WORDS 3456
#define XB_SPIN_CAP (1u << 18)
__device__ __forceinline__ unsigned xb_ld(unsigned* p)              { return __hip_atomic_load(p, __ATOMIC_RELAXED, __HIP_MEMORY_SCOPE_AGENT); }
__device__ __forceinline__ unsigned xb_add(unsigned* p, unsigned v) { return __hip_atomic_fetch_add(p, v, __ATOMIC_RELAXED, __HIP_MEMORY_SCOPE_AGENT); }
__device__ __forceinline__ unsigned xb_xcc_id() { return (unsigned)__builtin_amdgcn_s_getreg((3 << 11) | 20) & 0xFu; }
#define XB_SPIN(cond, bar) do { unsigned _sp = 0; while (cond) { __builtin_amdgcn_s_sleep(1); \
    if ((++_sp & 255u) == 0u) { if (xb_ld(&(bar)[XB_TMO])) break; if (_sp > XB_SPIN_CAP) { atomicAdd(&(bar)[XB_TMO], 1u); break; } } } } while (0)
struct XcdBarrier { unsigned* bar; unsigned x; volatile LAS unsigned* st; int wave; };
__device__ __forceinline__ XcdBarrier xcd_barrier_post(unsigned* bar, volatile LAS unsigned* st) {
    XcdBarrier b; b.bar = bar; b.x = xb_xcc_id(); b.st = st; b.wave = 0;
    if (threadIdx.x == 0) (void)xb_add(&bar[XB_XCNT(b.x)], 1u);
    return b;
}
__device__ __forceinline__ void xcd_barrier_complete(unsigned* bar, unsigned x, unsigned& nloc, unsigned& nx) {
    const unsigned G = gridDim.x * gridDim.y * gridDim.z;
    unsigned sum, cnt, mine, sp = 0u;
    for (;;) {
        sum = 0u; cnt = 0u; mine = 0u;
#pragma unroll
        for (unsigned j = 0; j < 16; ++j) { const unsigned c = xb_ld(&bar[XB_XCNT(j)]); sum += c; cnt += (c > 0u) ? 1u : 0u; mine = (j == x) ? c : mine; }
        if (sum == G) break;
        __builtin_amdgcn_s_sleep(1);
        if ((++sp & 255u) == 0u) { if (xb_ld(&bar[XB_TMO])) break; if (sp > XB_SPIN_CAP) { atomicAdd(&bar[XB_TMO], 1u); break; } }
    }
    nloc = mine > 0u ? mine : 1u; nx = cnt > 0u ? cnt : 1u;
}
__device__ __forceinline__ void xcd_barrier(const XcdBarrier& b) {
    asm volatile("s_waitcnt vmcnt(0)" ::: "memory");
    __syncthreads();
    if (b.wave == 0 && lane_id() == 0) {
        unsigned* bar = b.bar;
        __builtin_amdgcn_s_waitcnt(0);
        unsigned nloc = b.st[0], nx = b.st[1];
        if (nloc == 0u) { xcd_barrier_complete(bar, b.x, nloc, nx); b.st[0] = nloc; b.st[1] = nx; }
        const unsigned old = xb_add(&bar[XB_XSUB(b.x)], 1u);
        const unsigned gen = old / nloc;
        if (old + 1u == (gen + 1u) * nloc) {
            __builtin_amdgcn_fence(__ATOMIC_RELEASE, "agent");
            asm volatile("s_waitcnt vmcnt(0)" ::: "memory");
            const unsigned og = xb_add(&bar[XB_TOP], 1u);
            const unsigned tg = og / nx;
            if (og + 1u == (tg + 1u) * nx) xb_add(&bar[XB_TOPGEN], 1u);
            else XB_SPIN(xb_ld(&bar[XB_TOPGEN]) == tg, bar);
            __builtin_amdgcn_fence(__ATOMIC_ACQUIRE, "agent");
            xb_add(&bar[XB_XGEN(b.x)], 1u);
            asm volatile("s_waitcnt vmcnt(0)" ::: "memory");
        } else {
            XB_SPIN(xb_ld(&bar[XB_XGEN(b.x)]) == gen, bar);
            __builtin_amdgcn_fence(__ATOMIC_ACQUIRE, "agent");
            asm volatile("s_waitcnt vmcnt(0)" ::: "memory");
        }
    }
    __syncthreads();
}

struct Frame {
    LAS unsigned char* lds;
    volatile LAS unsigned* MISC;
    gu32* ctl;
    int wave;
    int vcu, G;
    float* out;
    unsigned char* ws;
};
struct Args { const float* in[21]; float* out; unsigned char* ws; int ph_lo, ph_hi, li, pad; };
__device__ __forceinline__ float wave_sum(float v) {
#pragma unroll
    for (int o = 1; o < 64; o <<= 1) v += __shfl_xor(v, o);
    return v;
}

struct DenseOrder {
    static constexpr bool GATHER = false;
    int nM, nN, nwg, G, c, extra, ex0, wave; long a_tile, b_tile;
    __device__ void init(int wave_, int nM_, int nN_, int G_, int c_, long a_tile_, long b_tile_, int extra_ = 0, int ex0_ = 0) { wave = wave_; nM = nM_; nN = nN_; nwg = nM * nN; G = G_; c = c_; a_tile = a_tile_; b_tile = b_tile_; extra = extra_; ex0 = ex0_; }
    __device__ bool next(int i, pg8::Unit& u) const {
        const long L = (long)i * G + c; if (L >= nwg + extra) return false;
        if (L >= nwg) { u.pm = nM; u.pn = ex0 + (int)(L - nwg); }
        else {
            int wgid = (int)L; { const int q = nwg / pg8::NXCD, r = nwg % pg8::NXCD, xcd = wgid % pg8::NXCD, off = wgid / pg8::NXCD; wgid = (xcd < r ? xcd * (q + 1) : r * (q + 1) + (xcd - r) * q) + off; }
            const int nig = pg8::WGM * nN, gid = wgid / nig, fm = gid * pg8::WGM, gsz = (nM - fm) < pg8::WGM ? (nM - fm) : pg8::WGM;
            u.pm = fm + ((wgid % nig) % gsz); u.pn = (wgid % nig) / gsz;
        }
        u.a_byte = (long)u.pm * a_tile; u.b_byte = (long)u.pn * b_tile; u.e = 0; u.mt = 0; u.cnt = 0; return true;
    }
    __device__ __forceinline__ unsigned row_byte(const pg8::Unit&, int) const { return 0u; }
};
template <int NT, bool GATH>
struct MoeOrder {
    static constexpr bool GATHER = GATH;
    int wave; volatile LAS int* tp; volatile LAS int* cn; int G, c; long b_exp, b_tile, a_tile; const int* rowidx; unsigned row_bytes;
    __device__ bool next(int i, pg8::Unit& u) const {
        const int total = __builtin_amdgcn_readfirstlane(tp[32]) * NT;
        const long L = (long)i * G + c; if (L >= total) return false;
        const int T = (int)(L / NT), n = (int)(L % NT);
        int e = 0;
        for (int j = 1; j < 32; ++j) e += (__builtin_amdgcn_readfirstlane(tp[j]) <= T) ? 1 : 0;
        u.e = e; u.mt = T - __builtin_amdgcn_readfirstlane(tp[e]); u.cnt = __builtin_amdgcn_readfirstlane(cn[e]); u.pm = T; u.pn = n;
        u.a_byte = GATH ? 0 : (long)T * a_tile; u.b_byte = (long)e * b_exp + (long)n * b_tile; return true;
    }
    __device__ __forceinline__ unsigned row_byte(const pg8::Unit& u, int r) const {
        const int pos = u.mt * 256 + r;
        int tk = 0; if (pos < u.cnt) tk = rowidx[u.e * MREAL + pos];
        return (unsigned)(tk >> 1) * row_bytes;
    }
};

using pg8::Unit; using pg8::HALF; using pg8::BM;
struct EpiBf16 {
    static constexpr bool PERM = true, MID = false;
    bf16* O; int ldc;
    __device__ __forceinline__ void mid(f32x4 (&)[2][2][4][2], const Unit&, int, int, int, int) const {}
    __device__ __forceinline__ void operator()(const f32x4 (&acc)[2][2][4][2], const Unit& u, int wr, int wc, int fr, int fq) const {
        const int row0 = u.pm * BM + wr * 64 + fr, col0 = u.pn * BM + wc * 32 + 8 * fq;
#pragma unroll
        for (int ai = 0; ai < 2; ++ai)
#pragma unroll
            for (int m = 0; m < 4; ++m) { bf16* rowp = O + (size_t)(row0 + ai * HALF + m * 16) * ldc + col0;
#pragma unroll
                for (int bj = 0; bj < 2; ++bj) { const f32x4 v0 = acc[ai][bj][m][0], v1 = acc[ai][bj][m][1];
                    v4u w; w.x = cvt_pk_bf16(v0[0], v0[1]); w.y = cvt_pk_bf16(v0[2], v0[3]); w.z = cvt_pk_bf16(v1[0], v1[1]); w.w = cvt_pk_bf16(v1[2], v1[3]);
                    *(v4u*)(rowp + bj * HALF) = w; } }
    }
};
__device__ __forceinline__ float sigm(float x) { return __builtin_amdgcn_rcpf(1.0f + __expf(-x)); }
struct EpiGate {
    static constexpr bool PERM = true, MID = true;
    bf16* P;
    __device__ __forceinline__ void mid(f32x4 (&acc)[2][2][4][2], const Unit& u, int wr, int wc, int fr, int fq) const {
        int row0 = u.pm * BM + wr * 64 + fr, col0 = u.pn * BM + wc * 32 + 8 * fq;
        asm volatile("" : "+v"(row0), "+v"(col0));
#pragma unroll
        for (int ai = 0; ai < 2; ++ai)
#pragma unroll
            for (int m = 0; m < 4; ++m) { const bf16* rowp = P + (size_t)(row0 + ai * HALF + m * 16) * LDP + col0;
#pragma unroll
                for (int bj = 0; bj < 2; ++bj) { const v4u a = *(const v4u*)(rowp + PC_GA + bj * HALF), c = *(const v4u*)(rowp + PC_GC + bj * HALF);
                    const unsigned aw[4] = {a.x, a.y, a.z, a.w}, cw[4] = {c.x, c.y, c.z, c.w};
#pragma unroll
                    for (int q = 0; q < 4; ++q) {
                        const float r0 = (1.0f + __expf(-bf_lo(cw[q]))) * __builtin_amdgcn_rcpf(1.0f + __expf(-bf_lo(aw[q])));
                        const float r1 = (1.0f + __expf(-bf_hi(cw[q]))) * __builtin_amdgcn_rcpf(1.0f + __expf(-bf_hi(aw[q])));
                        acc[ai][bj][m][q >> 1][(q & 1) * 2] *= r0; acc[ai][bj][m][q >> 1][(q & 1) * 2 + 1] *= r1; } }
                asm volatile("" ::: "memory"); }
    }
    __device__ __forceinline__ void operator()(const f32x4 (&acc)[2][2][4][2], const Unit& u, int wr, int wc, int fr, int fq) const {
        const int row0 = u.pm * BM + wr * 64 + fr, col0 = u.pn * BM + wc * 32 + 8 * fq;
#pragma unroll
        for (int ai = 0; ai < 2; ++ai)
#pragma unroll
            for (int m = 0; m < 4; ++m) { bf16* rowp = P + (size_t)(row0 + ai * HALF + m * 16) * LDP + col0;
#pragma unroll
                for (int bj = 0; bj < 2; ++bj) { const v4u c = *(const v4u*)(rowp + PC_GC + bj * HALF); const unsigned cw[4] = {c.x, c.y, c.z, c.w};
                    const f32x4 v0 = acc[ai][bj][m][0], v1 = acc[ai][bj][m][1];
                    v4u w;
                    w.x = cvt_pk_bf16(v0[0] * sigm(bf_lo(cw[0])), v0[1] * sigm(bf_hi(cw[0]))); w.y = cvt_pk_bf16(v0[2] * sigm(bf_lo(cw[1])), v0[3] * sigm(bf_hi(cw[1])));
                    w.z = cvt_pk_bf16(v1[0] * sigm(bf_lo(cw[2])), v1[1] * sigm(bf_hi(cw[2]))); w.w = cvt_pk_bf16(v1[2] * sigm(bf_lo(cw[3])), v1[3] * sigm(bf_hi(cw[3])));
                    *(v4u*)(rowp + PC_CC + bj * HALF) = w; }
                asm volatile("" ::: "memory"); }
    }
};
struct EpiPre {
    static constexpr bool PERM = false, MID = false;
    const bf16* XN; float* pre; int ldo;
    __device__ __forceinline__ void mid(f32x4 (&)[2][2][4][2], const Unit&, int, int, int, int) const {}
    __device__ __forceinline__ void operator()(const f32x4 (&acc)[2][2][4][2], const Unit& u, int wr, int wc, int fr, int fq) const {
        const int row0 = u.pm * BM + wr * 64 + fr, col0 = u.pn * BM + wc * 32 + 4 * fq;
#pragma unroll
        for (int ai = 0; ai < 2; ++ai)
#pragma unroll
            for (int m = 0; m < 4; ++m) { const int r = row0 + ai * HALF + m * 16; const bf16* xr = XN + (size_t)r * DM + col0; float* orow = pre + (size_t)r * ldo + col0;
#pragma unroll
                for (int bj = 0; bj < 2; ++bj)
#pragma unroll
                    for (int n = 0; n < 2; ++n) { const v2u h = *(const v2u*)(xr + bj * HALF + n * 16); const f32x4 a = acc[ai][bj][m][n];
                        f32x4 o; o[0] = ALPHA * bf_lo(h.x) + a[0]; o[1] = ALPHA * bf_hi(h.x) + a[1]; o[2] = ALPHA * bf_lo(h.y) + a[2]; o[3] = ALPHA * bf_hi(h.y) + a[3];
                        *(f32x4*)(orow + bj * HALF + n * 16) = o; } }
    }
};
struct EpiAct {
    static constexpr bool PERM = true, MID = false;
    bf16* act;
    __device__ __forceinline__ void mid(f32x4 (&)[2][2][4][2], const Unit&, int, int, int, int) const {}
    __device__ __forceinline__ void operator()(const f32x4 (&acc)[2][2][4][2], const Unit& u, int wr, int wc, int fr, int fq) const {
        const int row0 = u.pm * BM + wr * 64 + fr, col0 = u.pn * HALF + wc * 32 + 8 * fq;
#pragma unroll
        for (int ai = 0; ai < 2; ++ai)
#pragma unroll
            for (int m = 0; m < 4; ++m) { bf16* rowp = act + (size_t)(row0 + ai * HALF + m * 16) * DE + col0;
                float o[8];
#pragma unroll
                for (int n = 0; n < 2; ++n)
#pragma unroll
                    for (int j = 0; j < 4; ++j) { const float gt = acc[ai][0][m][n][j], up = acc[ai][1][m][n][j]; o[n * 4 + j] = gt * sigm(gt) * up; }
                v4u w; w.x = cvt_pk_bf16(o[0], o[1]); w.y = cvt_pk_bf16(o[2], o[3]); w.z = cvt_pk_bf16(o[4], o[5]); w.w = cvt_pk_bf16(o[6], o[7]);
                *(v4u*)rowp = w; }
    }
};
struct EpiDown {
    static constexpr bool PERM = true, MID = false;
    bf16* Y; const int* rowidx; const float* tokw;
    __device__ __forceinline__ void mid(f32x4 (&)[2][2][4][2], const Unit&, int, int, int, int) const {}
    __device__ __forceinline__ void operator()(const f32x4 (&acc)[2][2][4][2], const Unit& u, int wr, int wc, int fr, int fq) const {
        const int col0 = u.pn * BM + wc * 32 + 8 * fq;
#pragma unroll
        for (int ai = 0; ai < 2; ++ai)
#pragma unroll
            for (int m = 0; m < 4; ++m) { const int pos = u.mt * 256 + ai * HALF + wr * 64 + m * 16 + fr;
                if (pos < u.cnt) { const int tk = rowidx[u.e * MREAL + pos]; const float w = tokw[tk];
                    bf16* rowp = Y + ((size_t)(tk & 1) * MREAL + (size_t)(tk >> 1)) * DM + col0;
#pragma unroll
                    for (int bj = 0; bj < 2; ++bj) { const f32x4 v0 = acc[ai][bj][m][0] * w, v1 = acc[ai][bj][m][1] * w;
                        v4u o; o.x = cvt_pk_bf16(v0[0], v0[1]); o.y = cvt_pk_bf16(v0[2], v0[3]); o.z = cvt_pk_bf16(v1[0], v1[1]); o.w = cvt_pk_bf16(v1[2], v1[3]);
                        *(v4u*)(rowp + bj * HALF) = o; } } }
    }
};

__device__ __forceinline__ void transpose_item(const float* src, int ld_src, bf16* dst, int ld_dst, LAS float* scr, int lane) {
#pragma unroll 8
    for (int i = 0; i < 32; ++i) { const int kk = 2 * i + (lane >> 5); scr[kk * 33 + (lane & 31)] = src[(size_t)kk * ld_src + (lane & 31)]; }
    LDS_WAIT(); asm volatile("" ::: "memory");
    const int c = lane & 7;
#pragma unroll
    for (int j = 0; j < 4; ++j) { const int n = (lane >> 3) + 8 * j; const LAS float* s = scr + (8 * c) * 33 + n;
        v4u o; o.x = pk2(s[0 * 33], s[1 * 33]); o.y = pk2(s[2 * 33], s[3 * 33]); o.z = pk2(s[4 * 33], s[5 * 33]); o.w = pk2(s[6 * 33], s[7 * 33]);
        *(GAS v4u*)(dst + (size_t)n * ld_dst + 8 * c) = o; }
    LDS_WAIT(); asm volatile("" ::: "memory");
}
__device__ __forceinline__ void ln_row_to_bf16(const float* xrow, const float* g, const float* b, bf16* orow, int lane) {
    asm volatile("" : "+v"(lane));
    const f32x4* xr = (const f32x4*)xrow + lane;
    f32x4 v[8]; float s = 0.f;
#pragma unroll
    for (int j = 0; j < 8; ++j) { v[j] = xr[64 * j]; s += (v[j][0] + v[j][1]) + (v[j][2] + v[j][3]); }
    const float mean = wave_sum(s) * (1.f / DM); float s2 = 0.f;
#pragma unroll
    for (int j = 0; j < 8; ++j) { v[j] = v[j] - mean; s2 += (v[j][0] * v[j][0] + v[j][1] * v[j][1]) + (v[j][2] * v[j][2] + v[j][3] * v[j][3]); }
    const float rstd = 1.f / sqrtf(wave_sum(s2) * (1.f / DM) + LN_EPS);
    v2u* o8 = (v2u*)orow + lane;
#pragma unroll
    for (int j = 0; j < 8; ++j) { const f32x4 gg = ((const f32x4*)g)[lane + 64 * j], bb = ((const f32x4*)b)[lane + 64 * j]; const f32x4 y = v[j] * rstd * gg + bb;
        v2u w; w.x = pk2(y[0], y[1]); w.y = pk2(y[2], y[3]); o8[64 * j] = w; }
}
__device__ __forceinline__ void p0_prologue(Frame& F, const Args& A) {
    LAS float* scr = (LAS float*)(F.lds + RING_OFF + F.wave * 16384);
    const int lane0 = lane_id(), tid0 = F.wave * 64 + lane0;
    const int gw = F.vcu * NWAVES + F.wave, NGW = F.G * NWAVES;
    bf16* Win_t = (bf16*)(F.ws + WS_WIN); bf16* Wb2_t = (bf16*)(F.ws + WS_WB2); bf16* Wout_t = (bf16*)(F.ws + WS_WOUT);
    bf16* Wgu_t = (bf16*)(F.ws + WS_WGU); bf16* Wd_t = (bf16*)(F.ws + WS_WD); bf16* XN = (bf16*)(F.ws + WS_XN);
    constexpr int I_IN = 32 * 400, I_SQ = 32 * 64, I_GU = 32 * 512, I_DN = 32 * 512;
    constexpr int NITEMS = I_IN + 3 * I_SQ + 2 * I_GU + I_DN;
    for (int it = gw; it < NITEMS; it += NGW) {
        int r = it;
        if (r < I_IN) { const int kb = r / 400, nb = r % 400; const int n0 = nb * 32;
            int ns = n0; if (n0 >= 2048 && n0 < 4096) ns = n0 + 512; else if (n0 >= 4096 && n0 < 4608) ns = n0 - 2048;
            transpose_item(A.in[4] + (size_t)(kb * 64) * LDP + ns, LDP, Win_t + (size_t)n0 * DM + kb * 64, DM, scr, lane0); continue; } r -= I_IN;
        if (r < I_SQ) { const int kb = r / 64, nb = r % 64; transpose_item(A.in[7] + (size_t)(kb * 64) * DM + nb * 32, DM, Wb2_t + (size_t)(nb * 32) * 4096 + kb * 64, 4096, scr, lane0); continue; } r -= I_SQ;
        if (r < I_SQ) { const int kb = r / 64, nb = r % 64; transpose_item(A.in[8] + (size_t)(kb * 64) * DM + nb * 32, DM, Wb2_t + (size_t)(nb * 32) * 4096 + 2048 + kb * 64, 4096, scr, lane0); continue; } r -= I_SQ;
        if (r < I_SQ) { const int kb = r / 64, nb = r % 64; transpose_item(A.in[9] + (size_t)(kb * 64) * DM + nb * 32, DM, Wout_t + (size_t)(nb * 32) * DM + kb * 64, DM, scr, lane0); continue; } r -= I_SQ;
        if (r < 2 * I_GU) { const int up = r >= I_GU ? 1 : 0; r -= up * I_GU; const int e = r / 512, q = r % 512, kb = q / 16, nb = q % 16, n0 = nb * 32;
            const float* src = A.in[16 + up] + (size_t)e * DM * DE + (size_t)(kb * 64) * DE + n0;
            bf16* dst = Wgu_t + ((size_t)e * 1024 + (size_t)(n0 >> 7) * 256 + up * 128 + (n0 & 127)) * DM + kb * 64;
            transpose_item(src, DE, dst, DM, scr, lane0); continue; } r -= 2 * I_GU;
        { const int e = r / 512, q = r % 512, kb = q / 64, nb = q % 64;
            transpose_item(A.in[18] + (size_t)e * DE * DM + (size_t)(kb * 64) * DM + nb * 32, DM, Wd_t + ((size_t)e * DM + nb * 32) * DE + kb * 64, DE, scr, lane0); }
    }
    { float* rewg = (float*)(F.ws + WS_REWG); const float* rew = A.in[14];
      for (int i = (F.vcu * NWAVES * 64) + tid0; i < NGRP * DM * EPG; i += F.G * NWAVES * 64) { const int g = i / (DM * EPG), k = (i / EPG) % DM, j = i % EPG; rewg[i] = rew[k * NEXP + g * EPG + j]; } }
    for (int m = gw; m < MPAD; m += NGW) {
        if (m < MREAL) ln_row_to_bf16(A.in[0] + (size_t)m * DM, A.in[2], A.in[3], XN + (size_t)m * DM, lane0);
        else if (m < MREAL + NMETA) ln_row_to_bf16(A.in[1] + (size_t)(m - MREAL) * DM, A.in[2], A.in[3], XN + (size_t)m * DM, lane0);
        else { v2u* o8 = (v2u*)(XN + (size_t)m * DM) + lane0;
#pragma unroll
            for (int j = 0; j < 8; ++j) o8[64 * j] = (v2u){0u, 0u}; }
    }
}

constexpr int KS_PITCH = 144;
constexpr int VT_PITCH = 584;
constexpr int KROWS = 288;
constexpr int ATT_KS = 0, ATT_VT = KROWS * KS_PITCH, ATT_LDS = ATT_VT + 64 * VT_PITCH;
static_assert(ATT_LDS <= RING_BYTES, "attention LDS");
constexpr float LOG2E = 1.4426950408889634f;

template <int R>
__device__ __forceinline__ void attn_qblock(LAS const unsigned char* lds, bf16* P, int qrow0, int head, float sink_l2, bool has_prev, int lane) {
    const int ql = lane & 31, hh = lane >> 5;
    bf16* qp = P + (size_t)(qrow0 + 32 * R + ql) * LDP + PC_Q + head * HD;
    bf16x8 qf[4];
#pragma unroll
    for (int s = 0; s < 4; ++s) qf[s] = *(const bf16x8*)(qp + 16 * s + 8 * hh);
    f32x16 S[6];
#define KB_ROW(i) ((i) == 0 ? 0 : ((i) <= 4 - R ? 32 + 32 * (R + (i) - 1) : 160 + 32 * ((i) - (5 - R))))
#pragma unroll
    for (int i = 0; i < 6; ++i) {
        const int kr = KB_ROW(i);
        f32x16 a = {0.f, 0.f, 0.f, 0.f, 0.f, 0.f, 0.f, 0.f, 0.f, 0.f, 0.f, 0.f, 0.f, 0.f, 0.f, 0.f};
        const LAS unsigned char* kp = lds + ATT_KS + (kr + ql) * KS_PITCH + 16 * hh;
#pragma unroll
        for (int s = 0; s < 4; ++s) { const bf16x8 kf = *(const LAS bf16x8*)(kp + 32 * s); a = __builtin_amdgcn_mfma_f32_32x32x16_bf16(kf, qf[s], a, 0, 0, 0); }
        S[i] = a;
    }
    const float NEG = -INFINITY; const float sc = 0.125f * LOG2E;
    float mx = sink_l2;
#pragma unroll
    for (int i = 0; i < 6; ++i)
#pragma unroll
        for (int r = 0; r < 16; ++r) {
            const int kvl = (r & 3) + 8 * (r >> 2) + 4 * hh;
            float t = S[i][r] * sc;
            bool ok = true;
            if (i == 0) ok = kvl < NMETA;
            else if (i <= 4 - R) { ok = has_prev; if (i == 1) ok = ok && (kvl > ql); }
            else { if (i == 5) ok = (kvl <= ql); }
            t = ok ? t : NEG; S[i][r] = t; mx = fmaxf(mx, t);
        }
    mx = fmaxf(mx, __shfl_xor(mx, 32));
    float l = 0.f;
#pragma unroll
    for (int i = 0; i < 6; ++i)
#pragma unroll
        for (int r = 0; r < 16; ++r) { const float p = __builtin_amdgcn_exp2f(S[i][r] - mx); S[i][r] = p; l += p; }
    l += __shfl_xor(l, 32);
    l += __builtin_amdgcn_exp2f(sink_l2 - mx);
    const float inv = 1.0f / l;
    f32x16 O[2];
#pragma unroll
    for (int d = 0; d < 2; ++d) O[d] = (f32x16){0.f, 0.f, 0.f, 0.f, 0.f, 0.f, 0.f, 0.f, 0.f, 0.f, 0.f, 0.f, 0.f, 0.f, 0.f, 0.f};
#pragma unroll
    for (int i = 0; i < 6; ++i) {
        const int kr = KB_ROW(i);
#pragma unroll
        for (int s2 = 0; s2 < 2; ++s2) {
            unsigned pw[4];
#pragma unroll
            for (int j = 0; j < 4; ++j) pw[j] = cvt_pk_bf16(S[i][8 * s2 + 2 * j] * inv, S[i][8 * s2 + 2 * j + 1] * inv);
            const v4u pv = {pw[0], pw[1], pw[2], pw[3]};
            const bf16x8 pf = __builtin_bit_cast(bf16x8, pv);
#pragma unroll
            for (int d = 0; d < 2; ++d) {
                const LAS unsigned char* vp = lds + ATT_VT + (ql + 32 * d) * VT_PITCH + (kr + 16 * s2 + 4 * hh) * 2;
                const v2u lo = *(const LAS v2u*)vp, hi = *(const LAS v2u*)(vp + 16);
                const v4u vv = {lo.x, lo.y, hi.x, hi.y};
                O[d] = __builtin_amdgcn_mfma_f32_32x32x16_bf16(pf, __builtin_bit_cast(bf16x8, vv), O[d], 0, 0, 0);
            }
        }
    }
#undef KB_ROW
#pragma unroll
    for (int d = 0; d < 2; ++d)
#pragma unroll
        for (int r = 0; r < 16; ++r) { const int q = (r & 3) + 8 * (r >> 2) + 4 * hh;
            P[(size_t)(qrow0 + 32 * R + q) * LDP + PC_Q + head * HD + 32 * d + ql] = (bf16)f2bf(O[d][r]); }
}

__device__ __forceinline__ void p2_attention_conv(Frame& F, const Args& A) {
    bf16* P = (bf16*)(F.ws + WS_P);
    const float* sinks = A.in[5];
    const int lane0 = lane_id(), tid0 = F.wave * 64 + lane0;
    for (int it = blockIdx.x; it < BATCH * NKVH * (SEQ / WIN); it += F.G) {
        const int b = it / (NKVH * 16), kvh = (it / 16) % NKVH, nb = it % 16;
        const int row_own = b * SEQ + nb * WIN, row_prev = row_own - WIN;
        __syncthreads();
        for (int q = tid0; q < KROWS * 8; q += NWAVES * 64) {
            const int row = q >> 3, c = q & 7;
            int grow = -1;
            if (row < NMETA) grow = MREAL + row;
            else if (row >= 32 && row < 160) { if (nb > 0) grow = row_prev + (row - 32); }
            else if (row >= 160) grow = row_own + (row - 160);
            v4u kv = {0u, 0u, 0u, 0u}, vv = {0u, 0u, 0u, 0u};
            if (grow >= 0) { const bf16* rp = P + (size_t)grow * LDP; kv = *(const v4u*)(rp + PC_K + kvh * HD + 8 * c); vv = *(const v4u*)(rp + PC_V + kvh * HD + 8 * c); }
            *(LAS v4u*)(F.lds + ATT_KS + row * KS_PITCH + c * 16) = kv;
            const unsigned vw[4] = {vv.x, vv.y, vv.z, vv.w};
#pragma unroll
            for (int e = 0; e < 4; ++e) {
                *(LAS unsigned short*)(F.lds + ATT_VT + (8 * c + 2 * e) * VT_PITCH + row * 2) = (unsigned short)(vw[e] & 0xffffu);
                *(LAS unsigned short*)(F.lds + ATT_VT + (8 * c + 2 * e + 1) * VT_PITCH + row * 2) = (unsigned short)(vw[e] >> 16);
            }
        }
        __syncthreads();
        const int head = kvh * 8 + F.wave;
        const float sink_l2 = sinks[head] * LOG2E;
        attn_qblock<0>((LAS const unsigned char*)F.lds, P, row_own, head, sink_l2, nb > 0, lane0);
        attn_qblock<1>((LAS const unsigned char*)F.lds, P, row_own, head, sink_l2, nb > 0, lane0);
        attn_qblock<2>((LAS const unsigned char*)F.lds, P, row_own, head, sink_l2, nb > 0, lane0);
        attn_qblock<3>((LAS const unsigned char*)F.lds, P, row_own, head, sink_l2, nb > 0, lane0);
    }
    const float* cw = A.in[6];
    const int c0 = 4 * tid0;
    const f32x4 w0 = *(const f32x4*)(cw + c0), w1 = *(const f32x4*)(cw + DM + c0), w2 = *(const f32x4*)(cw + 2 * DM + c0);
    for (int it = blockIdx.x; it < MREAL / 32; it += F.G) {
        const int r0 = it * 32, s0 = r0 % SEQ;
        const int rm2 = (s0 == 0) ? MREAL + NMETA - 2 : r0 - 2, rm1 = (s0 == 0) ? MREAL + NMETA - 1 : r0 - 1;
        f32x4 pm2, pm1;
        { const v2u a = *(const v2u*)(P + (size_t)rm2 * LDP + PC_CC + c0), h = *(const v2u*)(P + (size_t)rm2 * LDP + PC_CH + c0);
          pm2 = (f32x4){bf_lo(a.x) * bf_lo(h.x), bf_hi(a.x) * bf_hi(h.x), bf_lo(a.y) * bf_lo(h.y), bf_hi(a.y) * bf_hi(h.y)}; }
        { const v2u a = *(const v2u*)(P + (size_t)rm1 * LDP + PC_CC + c0), h = *(const v2u*)(P + (size_t)rm1 * LDP + PC_CH + c0);
          pm1 = (f32x4){bf_lo(a.x) * bf_lo(h.x), bf_hi(a.x) * bf_hi(h.x), bf_lo(a.y) * bf_lo(h.y), bf_hi(a.y) * bf_hi(h.y)}; }
#pragma unroll 4
        for (int i = 0; i < 32; ++i) {
            bf16* rp = P + (size_t)(r0 + i) * LDP;
            const v2u a = *(const v2u*)(rp + PC_CC + c0), h = *(const v2u*)(rp + PC_CH + c0), bb = *(const v2u*)(rp + PC_CB + c0);
            const f32x4 p = {bf_lo(a.x) * bf_lo(h.x), bf_hi(a.x) * bf_hi(h.x), bf_lo(a.y) * bf_lo(h.y), bf_hi(a.y) * bf_hi(h.y)};
            const f32x4 cbv = {bf_lo(bb.x), bf_hi(bb.x), bf_lo(bb.y), bf_hi(bb.y)};
            const f32x4 uu = cbv * (w0 * pm2 + w1 * pm1 + w2 * p);
            v2u o; o.x = pk2(uu[0], uu[1]); o.y = pk2(uu[2], uu[3]);
            *(v2u*)(rp + PC_CB + c0) = o;
            pm2 = pm1; pm1 = p;
        }
    }
}

__device__ __forceinline__ void p5_ln1_router(Frame& F, const Args& A) {
    const int gw = F.vcu * NWAVES + F.wave, NGW = F.G * NWAVES;
    bf16* P = (bf16*)(F.ws + WS_P); bf16* XN = (bf16*)(F.ws + WS_XN);
    const float* g1 = A.in[10]; const float* b1 = A.in[11];
    const float* rgw = A.in[12]; const float* rgb = A.in[13]; const float* reb = A.in[15];
    const float* rewg = (const float*)(F.ws + WS_REWG);
    int* rowidx = (int*)(F.ws + WS_ROWIDX); float* tokw = (float*)(F.ws + WS_TOKW);
    unsigned* cnt = (unsigned*)(F.ctl + CW_CNT);
    for (int m = gw; m < MREAL; m += NGW) {
        int lane = lane_id();
        const f32x4* xr = (const f32x4*)((const float*)(P + (size_t)m * LDP + PC_GA)) + lane;
        f32x4 v[8]; float s = 0.f;
#pragma unroll
        for (int j = 0; j < 8; ++j) { v[j] = xr[64 * j]; s += (v[j][0] + v[j][1]) + (v[j][2] + v[j][3]); }
        const float mean = wave_sum(s) * (1.f / DM); float s2 = 0.f;
#pragma unroll
        for (int j = 0; j < 8; ++j) { v[j] = v[j] - mean; s2 += (v[j][0] * v[j][0] + v[j][1] * v[j][1]) + (v[j][2] * v[j][2] + v[j][3] * v[j][3]); }
        const float rstd = 1.f / sqrtf(wave_sum(s2) * (1.f / DM) + LN_EPS);
        v2u* o8 = (v2u*)(XN + (size_t)m * DM) + lane;
        float gl[4] = {0.f, 0.f, 0.f, 0.f};
#pragma unroll
        for (int j = 0; j < 8; ++j) { const f32x4 gg = ((const f32x4*)g1)[lane + 64 * j], bb = ((const f32x4*)b1)[lane + 64 * j]; v[j] = v[j] * rstd * gg + bb;
            v2u w; w.x = pk2(v[j][0], v[j][1]); w.y = pk2(v[j][2], v[j][3]); o8[64 * j] = w;
            const f32x4* wp = (const f32x4*)(rgw + (size_t)(4 * lane + 256 * j) * NGRP);
#pragma unroll
            for (int i = 0; i < 4; ++i) { const f32x4 w4 = wp[i]; gl[0] += v[j][i] * w4[0]; gl[1] += v[j][i] * w4[1]; gl[2] += v[j][i] * w4[2]; gl[3] += v[j][i] * w4[3]; }
            if (j & 1) asm volatile("" ::: "memory"); }
#pragma unroll
        for (int c = 0; c < 4; ++c) gl[c] = wave_sum(gl[c]) + rgb[c];
        int gsel = 0; float gmax = gl[0];
#pragma unroll
        for (int c = 1; c < 4; ++c) if (gl[c] > gmax) { gmax = gl[c]; gsel = c; }
        float gden = 0.f;
#pragma unroll
        for (int c = 0; c < 4; ++c) gden += __expf(gl[c] - gmax);
        const float pgroup = 1.0f / gden;
        gsel = __builtin_amdgcn_readfirstlane(gsel);
        float el[8] = {0.f, 0.f, 0.f, 0.f, 0.f, 0.f, 0.f, 0.f};
        const float* wg = rewg + (size_t)gsel * DM * EPG;
#pragma unroll
        for (int j = 0; j < 8; ++j) { const f32x4* wp = (const f32x4*)(wg + (size_t)(4 * lane + 256 * j) * EPG);
#pragma unroll
            for (int i = 0; i < 4; ++i) { const f32x4 wa = wp[2 * i], wb = wp[2 * i + 1]; const float h = v[j][i];
                el[0] += h * wa[0]; el[1] += h * wa[1]; el[2] += h * wa[2]; el[3] += h * wa[3]; el[4] += h * wb[0]; el[5] += h * wb[1]; el[6] += h * wb[2]; el[7] += h * wb[3]; }
            if (j & 1) asm volatile("" ::: "memory"); }
#pragma unroll
        for (int c = 0; c < 8; ++c) el[c] = wave_sum(el[c]) + reb[gsel * EPG + c];
        int i0 = 0; float l0 = el[0];
#pragma unroll
        for (int c = 1; c < 8; ++c) if (el[c] > l0) { l0 = el[c]; i0 = c; }
        int i1 = -1; float l1 = -INFINITY;
#pragma unroll
        for (int c = 0; c < 8; ++c) if (c != i0 && el[c] > l1) { l1 = el[c]; i1 = c; }
        const float e10 = __expf(l1 - l0);
        const float w0 = pgroup / (1.0f + e10), w1 = pgroup * e10 / (1.0f + e10);
        if (lane == 0) {
            const int e0 = gsel * EPG + i0, e1 = gsel * EPG + i1;
            const unsigned p0 = __hip_atomic_fetch_add(cnt + e0, 1u, RLX_AGENT), p1 = __hip_atomic_fetch_add(cnt + e1, 1u, RLX_AGENT);
            rowidx[e0 * MREAL + p0] = m * 2; rowidx[e1 * MREAL + p1] = m * 2 + 1;
            tokw[m * 2] = w0; tokw[m * 2 + 1] = w1;
        }
    }
}

__device__ __forceinline__ void p8_ln2(Frame& F, const Args& A) {
    const int gw = F.vcu * NWAVES + F.wave, NGW = F.G * NWAVES;
    const bf16* XN = (const bf16*)(F.ws + WS_XN); const bf16* Y = (const bf16*)(F.ws + WS_Y);
    const float* g2 = A.in[19]; const float* b2 = A.in[20];
    for (int m = gw; m < MREAL; m += NGW) {
        int lane = lane_id();
        const v2u* hp = (const v2u*)(XN + (size_t)m * DM) + lane; const v2u* y0 = (const v2u*)(Y + (size_t)m * DM) + lane; const v2u* y1 = (const v2u*)(Y + (size_t)(MREAL + m) * DM) + lane;
        f32x4 v[8]; float s = 0.f;
#pragma unroll
        for (int j = 0; j < 8; ++j) { const v2u h = hp[64 * j], a = y0[64 * j], c = y1[64 * j];
            v[j] = (f32x4){ALPHA * bf_lo(h.x) + (bf_lo(a.x) + bf_lo(c.x)), ALPHA * bf_hi(h.x) + (bf_hi(a.x) + bf_hi(c.x)), ALPHA * bf_lo(h.y) + (bf_lo(a.y) + bf_lo(c.y)), ALPHA * bf_hi(h.y) + (bf_hi(a.y) + bf_hi(c.y))};
            s += (v[j][0] + v[j][1]) + (v[j][2] + v[j][3]); }
        const float mean = wave_sum(s) * (1.f / DM); float s2 = 0.f;
#pragma unroll
        for (int j = 0; j < 8; ++j) { v[j] = v[j] - mean; s2 += (v[j][0] * v[j][0] + v[j][1] * v[j][1]) + (v[j][2] * v[j][2] + v[j][3] * v[j][3]); }
        const float rstd = 1.f / sqrtf(wave_sum(s2) * (1.f / DM) + LN_EPS);
        f32x4* op = (f32x4*)(F.out + (size_t)m * DM) + lane;
#pragma unroll
        for (int j = 0; j < 8; ++j) { const f32x4 gg = ((const f32x4*)g2)[lane + 64 * j], bb = ((const f32x4*)b2)[lane + 64 * j]; op[64 * j] = v[j] * rstd * gg + bb; }
    }
}

__global__ void __launch_bounds__(NWAVES * 64, 2) mk_fwd(Args args) {
    extern __shared__ __attribute__((aligned(16))) unsigned char lds[];
    Frame F;
    F.lds = (LAS unsigned char*)lds;
    F.MISC = (volatile LAS unsigned*)(F.lds + MISC_OFF);
    F.wave = __builtin_amdgcn_readfirstlane((int)(threadIdx.x >> 6));
    F.G = gridDim.x; { const int bx = blockIdx.x; F.vcu = (F.G % 8 == 0) ? (bx % 8) * (F.G / 8) + bx / 8 : bx; }
    F.ws = args.ws; F.out = args.out;
    F.ctl = (gu32*)(F.ws + WS_CTL);
    for (int u = threadIdx.x; u < (LDS_BYTES - LDSCTL_OFF) / 4; u += NWAVES * 64) ((LAS unsigned*)(F.lds + LDSCTL_OFF))[u] = 0u;
    __syncthreads();
    XcdBarrier bar; bar.bar = (unsigned*)(F.ctl + CW_BAR); bar.x = 0; bar.st = nullptr; bar.wave = F.wave;
    if (N_LAUNCHES == 1) { bar = xcd_barrier_post((unsigned*)(F.ctl + CW_BAR), F.MISC + 8); bar.wave = F.wave; }
#define GRID_BAR() do { if (N_LAUNCHES == 1) xcd_barrier(bar); } while (0)
    const int lo = args.ph_lo, hi = args.ph_hi;
#ifndef MK_PH_MASK
#define MK_PH_MASK 0x1ff
#endif
#define IN(k) (((MK_PH_MASK >> (k)) & 1) && lo <= (k) && (k) < hi)
    bf16* P = (bf16*)(F.ws + WS_P); bf16* XN = (bf16*)(F.ws + WS_XN);

    if (IN(0)) { p0_prologue(F, args); GRID_BAR(); }

    if (IN(1)) {
        pg8::Gemm g{XN, (const bf16*)(F.ws + WS_WIN), DM, DM, -1};
        DenseOrder S; S.init(F.wave, MREAL / 256, LDP / 256, F.G, (int)blockIdx.x, (long)256 * DM * 2, (long)256 * DM * 2, (PC_GA - PC_K) / 256, PC_K / 256);
        EpiBf16 E{P, LDP};
        pg8::gemm_phase<EpiBf16, DenseOrder, true>(F.lds + RING_OFF, g, S, E);
        GRID_BAR();
    }
    if (IN(2)) { p2_attention_conv(F, args); GRID_BAR(); }
    if (IN(3)) {
        pg8::Gemm g{P, (const bf16*)(F.ws + WS_WB2), LDP, 2 * DM, DM / 64};
        DenseOrder S; S.init(F.wave, MREAL / 256, DM / 256, F.G, (int)blockIdx.x, (long)256 * LDP * 2, (long)256 * 2 * DM * 2);
        EpiGate E{P};
        pg8::gemm_phase<EpiGate, DenseOrder, true>(F.lds + RING_OFF, g, S, E);
        GRID_BAR();
    }
    if (IN(4)) {
        pg8::Gemm g{P + PC_CC, (const bf16*)(F.ws + WS_WOUT), LDP, DM, -1};
        DenseOrder S; S.init(F.wave, MREAL / 256, DM / 256, F.G, (int)blockIdx.x, (long)256 * LDP * 2, (long)256 * DM * 2);
        EpiPre E{XN, (float*)(P + PC_GA), LDP / 2};
        pg8::gemm_phase<EpiPre, DenseOrder, true>(F.lds + RING_OFF, g, S, E);
        GRID_BAR();
    }
    if (IN(5)) { p5_ln1_router(F, args); GRID_BAR(); }
    volatile LAS int* tp = (volatile LAS int*)(F.MISC + 32);
    volatile LAS int* cn = (volatile LAS int*)(F.MISC + 72);
    if (IN(6) || IN(7)) {
        if (F.wave == 0 && lane_id() == 0) { int acc = 0; for (int e = 0; e < NEXP; ++e) { const int c = (int)__hip_atomic_load(F.ctl + CW_CNT + e, RLX_AGENT); tp[e] = acc; cn[e] = c; acc += (c + 255) >> 8; } tp[32] = acc; }
        __syncthreads();
    }
    if (IN(6)) {
        pg8::Gemm g{XN, (const bf16*)(F.ws + WS_WGU), DM, DM, -1};
        MoeOrder<4, true> S{F.wave, tp, cn, F.G, (int)blockIdx.x, (long)1024 * DM * 2, (long)256 * DM * 2, 0, (const int*)(F.ws + WS_ROWIDX), (unsigned)(DM * 2)};
        EpiAct E{(bf16*)(F.ws + WS_ACT)};
        pg8::gemm_phase<EpiAct, MoeOrder<4, true>, true>(F.lds + RING_OFF, g, S, E);
        GRID_BAR();
    }
    if (IN(7)) {
        pg8::Gemm g{(const bf16*)(F.ws + WS_ACT), (const bf16*)(F.ws + WS_WD), DE, DE, -1};
        MoeOrder<8, false> S{F.wave, tp, cn, F.G, (int)blockIdx.x, (long)DM * DE * 2, (long)256 * DE * 2, (long)256 * DE * 2, (const int*)(F.ws + WS_ROWIDX), 0u};
        EpiDown E{(bf16*)(F.ws + WS_Y), (const int*)(F.ws + WS_ROWIDX), (const float*)(F.ws + WS_TOKW)};
        pg8::gemm_phase<EpiDown, MoeOrder<8, false>, true>(F.lds + RING_OFF, g, S, E);
        GRID_BAR();
    }
    if (IN(8)) { p8_ln2(F, args); }
#undef IN
#undef GRID_BAR
}

extern "C" void kernel_launch(void* const* d_in, const int* in_sizes, int n_in, void* d_out, int out_size, void* d_ws, size_t ws_size, hipStream_t stream) {
    static int grid = 0;
    if (grid == 0) {
        if (n_in != 21 || in_sizes[0] != MREAL * DM || out_size != MREAL * DM || ws_size < WS_END) { fprintf(stderr, "kernel_launch: unexpected shapes / workspace (n_in %d, ws %zu); nothing launched\n", n_in, ws_size); grid = -1; return; }
        int dev = 0, cus = 0, per_cu = 0;
        if (hipGetDevice(&dev) != hipSuccess || hipDeviceGetAttribute(&cus, hipDeviceAttributeMultiprocessorCount, dev) != hipSuccess) { grid = -1; return; }
        if (hipFuncSetAttribute((const void*)mk_fwd, hipFuncAttributeMaxDynamicSharedMemorySize, LDS_BYTES) != hipSuccess) { fprintf(stderr, "kernel_launch: hipFuncSetAttribute failed\n"); grid = -1; return; }
        if (hipOccupancyMaxActiveBlocksPerMultiprocessor(&per_cu, (const void*)mk_fwd, NWAVES * 64, LDS_BYTES) != hipSuccess || per_cu < 1) { fprintf(stderr, "kernel_launch: occupancy query reports %d\n", per_cu); }
        (void)hipGetLastError();
        grid = cus;
    }
    if (grid < 0) return;
    if (hipMemsetAsync((char*)d_ws + WS_CTL, 0, CTL_ZERO_BYTES, stream) != hipSuccess) return;
    Args a{};
    for (int i = 0; i < 21; ++i) a.in[i] = (const float*)d_in[i];
    a.out = (float*)d_out; a.ws = (unsigned char*)d_ws;
    for (int li = 0; li < N_LAUNCHES; ++li) {
        a.ph_lo = (N_LAUNCHES == 1) ? 0 : li; a.ph_hi = (N_LAUNCHES == 1) ? PER_PHASE : li + 1; a.li = li;
        hipLaunchKernelGGL(mk_fwd, dim3(grid), dim3(NWAVES * 64), LDS_BYTES, stream, a);
    }
}
```

```cpp
#include <hip/hip_runtime.h>
#include <cstdio>
#include <cstdint>

#ifndef MK_N_LAUNCHES
#define MK_N_LAUNCHES 1
#endif

__device__ __forceinline__ int lane_id() { int l = (int)__builtin_amdgcn_mbcnt_hi(~0u, __builtin_amdgcn_mbcnt_lo(~0u, 0u)); asm volatile("" : "+v"(l)); return l; }
namespace pg8 {
#define PG8_LAS __attribute__((address_space(3)))
typedef unsigned short bf16_t;
typedef short bf16x8 __attribute__((ext_vector_type(8)));
typedef float f32x4 __attribute__((ext_vector_type(4)));
typedef float f32x2 __attribute__((ext_vector_type(2)));
typedef unsigned u32x4 __attribute__((ext_vector_type(4)));
typedef unsigned u32x2 __attribute__((ext_vector_type(2)));
constexpr int BM = 256, BK = 64, HALF = 128, HTB = HALF * BK * 2  , STAGE_BYTES = 8 * HTB, NXCD = 8, WGM = 8;

__host__ __device__ __forceinline__ int lds_byte(int r, int c) { const int st = (r >> 4) * 2 + (c >> 5), rr = r & 15, cc = c & 31, ob = rr * 64 + cc * 2; return st * 1024 + (ob ^ (((ob >> 9) & 1) << 5)); }
__host__ __device__ __forceinline__ void stage_rc(int b, int& R, int& C) { const int st = b / 1024, sb = b % 1024, swz = sb ^ (((sb >> 9) & 1) << 5); R = (st >> 1) * 16 + swz / 64; C = (st & 1) * 32 + (swz % 64) / 2; }
__host__ __device__ __forceinline__ int perm32(int rho) { const int n = rho >> 4, i = rho & 15; return 8 * (i >> 2) + 4 * n + (i & 3); }

struct Unit { int pm, pn; long a_byte, b_byte; int e, mt, cnt; };
struct Gemm { const bf16_t* A; const bf16_t* Bt; int lda; int K; int tmid; };

__device__ __forceinline__ unsigned cvt_pk_bf16(float lo, float hi) { unsigned r; asm volatile("v_cvt_pk_bf16_f32 %0, %1, %2" : "=v"(r) : "v"(lo), "v"(hi)); return r; }
__device__ __forceinline__ float bf_lo(unsigned u) { return __builtin_bit_cast(float, u << 16); }
__device__ __forceinline__ float bf_hi(unsigned u) { return __builtin_bit_cast(float, u & 0xffff0000u); }

template <class Epi, class Sched, bool ALIGN_EPI>
__device__ __forceinline__ void gemm_phase(PG8_LAS unsigned char* lds, const Gemm g, const Sched& S, const Epi& E) {
    constexpr bool GATHER = Sched::GATHER;
    const int lane = lane_id(), wid = S.wave, tid = wid * 64 + lane, wr = wid >> 2, wc = wid & 3, fr = lane & 15, fq = lane >> 4;
    const int K = g.K, nt = K / BK, lda = g.lda;
    unsigned voffA[2], voffB[2]; int rA[2]; unsigned cA2[2];
#pragma unroll
    for (int i = 0; i < 2; ++i) { int R, C; stage_rc(tid * 16 + i * 8192, R, C); const int Rb = Epi::PERM ? ((R & ~31) + perm32(R & 31)) : R;
        voffA[i] = (unsigned)(R * lda + C) * 2u; voffB[i] = (unsigned)(Rb * K + C) * 2u; rA[i] = R; cA2[i] = (unsigned)C * 2u; }
    const size_t kstep = (size_t)(BK * 2);
    const size_t hstepA = (size_t)HALF * lda * 2, hstepB = (size_t)HALF * K * 2;
    const unsigned ldsw = (unsigned)wid * 1024u;
    const int aoff = lds_byte(wr * 64 + fr, fq * 8), boff = lds_byte(wc * 32 + fr, fq * 8);
#define PG8_SA(b, h) (((b) * 2 + (h)) * HTB)
#define PG8_SB(b, h) ((4 + (b) * 2 + (h)) * HTB)
#define PG8_GLDS(gp, ldsoff) __builtin_amdgcn_global_load_lds((const unsigned*)(gp), (PG8_LAS unsigned*)(lds + (ldsoff)), 16, 0, 0)
#define PG8_STAGE_O(bufoff, gbase, o0, o1) do { PG8_GLDS((const char*)(gbase) + (o0), (bufoff) + ldsw); PG8_GLDS((const char*)(gbase) + (o1), (bufoff) + ldsw + 8192); } while (0)
#define PG8_STB(bufoff, gbase) PG8_STAGE_O(bufoff, gbase, voffB[0], voffB[1])
#define PG8_STA(bufoff, ap, h, V) do { if constexpr (GATHER) PG8_STAGE_O(bufoff, ap, V[h][0], V[h][1]); else PG8_STAGE_O(bufoff, (ap) + (h) * hstepA, voffA[0], voffA[1]); } while (0)
#define PG8_LDA(dst, b, h) do { _Pragma("unroll") for (int m = 0; m < 4; ++m) _Pragma("unroll") for (int k = 0; k < 2; ++k) dst[m][k] = *(const PG8_LAS bf16x8*)(lds + PG8_SA(b, h) + aoff + m * 2048 + k * 1024); } while (0)
#define PG8_LDB(dst, b, h) do { _Pragma("unroll") for (int n = 0; n < 2; ++n) _Pragma("unroll") for (int k = 0; k < 2; ++k) dst[n][k] = *(const PG8_LAS bf16x8*)(lds + PG8_SB(b, h) + boff + n * 2048 + k * 1024); } while (0)
#define PG8_MMA(ai, bj, At, Bt) do { __builtin_amdgcn_s_setprio(1); _Pragma("unroll") for (int m = 0; m < 4; ++m) _Pragma("unroll") for (int n = 0; n < 2; ++n) _Pragma("unroll") for (int k = 0; k < 2; ++k) \
        acc[ai][bj][m][n] = __builtin_amdgcn_mfma_f32_16x16x32_bf16(Bt[n][k], At[m][k], acc[ai][bj][m][n], 0, 0, 0); __builtin_amdgcn_s_setprio(0); } while (0)
#define PG8_WAIT_V(n) asm volatile("s_waitcnt vmcnt(" #n ")" ::: "memory")
#define PG8_WAIT_L(n) asm volatile("s_waitcnt lgkmcnt(" #n ")" ::: "memory")
#define PG8_BAR __builtin_amdgcn_s_barrier()
#define PG8_SCHED __builtin_amdgcn_sched_barrier(0)
    Unit cur, nxt; int ui = 0;
    if (!S.next(0, cur)) return;
    f32x4 acc[2][2][4][2];
#pragma unroll
    for (int a = 0; a < 2; ++a)
#pragma unroll
        for (int b = 0; b < 2; ++b)
#pragma unroll
            for (int m = 0; m < 4; ++m)
#pragma unroll
                for (int n = 0; n < 2; ++n) acc[a][b][m][n] = (f32x4){0.f, 0.f, 0.f, 0.f};
    bf16x8 At[4][2], B0[2][2], B1[2][2];
    unsigned va[2][2], nva[2][2];
    if constexpr (GATHER) {
#pragma unroll
        for (int h = 0; h < 2; ++h)
#pragma unroll
            for (int i = 0; i < 2; ++i) { va[h][i] = S.row_byte(cur, h * HALF + rA[i]) + cA2[i]; nva[h][i] = va[h][i]; }
    } else { va[0][0] = va[0][1] = va[1][0] = va[1][1] = 0u; nva[0][0] = nva[0][1] = nva[1][0] = nva[1][1] = 0u; }
    const char* cA = (const char*)g.A + cur.a_byte; const char* cB = (const char*)g.Bt + cur.b_byte;
    PG8_STB(PG8_SB(0, 0), cB); PG8_STB(PG8_SB(0, 1), cB + hstepB); PG8_STA(PG8_SA(0, 0), cA, 0, va); PG8_STA(PG8_SA(0, 1), cA, 1, va);
    if (wr == 1) PG8_BAR;
    PG8_WAIT_V(2); PG8_BAR;
    PG8_STB(PG8_SB(1, 0), cB + kstep); PG8_STA(PG8_SA(1, 0), cA + kstep, 0, va); PG8_STB(PG8_SB(1, 1), cB + hstepB + kstep);
    PG8_WAIT_V(6); PG8_BAR;
    for (;;) {
        const bool has_next = S.next(ui + 1, nxt);
        const char* nA = has_next ? (const char*)g.A + nxt.a_byte : cA; const char* nB = has_next ? (const char*)g.Bt + nxt.b_byte : cB;
        if constexpr (GATHER) {
            if (has_next) {
#pragma unroll
                for (int h = 0; h < 2; ++h)
#pragma unroll
                    for (int i = 0; i < 2; ++i) nva[h][i] = S.row_byte(nxt, h * HALF + rA[i]) + cA2[i];
            }
            asm volatile("" : "+v"(nva[0][0]), "+v"(nva[0][1]), "+v"(nva[1][0]), "+v"(nva[1][1]));
        }
        for (int t = 0; t < nt; t += 2) {
            const bool last = (t == nt - 2);
            if constexpr (Epi::MID) { if (t == g.tmid) E.mid(acc, cur, wr, wc, fr, fq); }
            const char* a1 = cA + (size_t)(t + 1) * kstep;
            const char* a2 = last ? nA : cA + (size_t)(t + 2) * kstep; const char* b2 = last ? nB : cB + (size_t)(t + 2) * kstep;
            const char* a3 = a2 + kstep; const char* b3 = b2 + kstep;
            unsigned xa[2][2];
#pragma unroll
            for (int h = 0; h < 2; ++h)
#pragma unroll
                for (int i = 0; i < 2; ++i) xa[h][i] = last ? nva[h][i] : va[h][i];
            PG8_LDB(B0, 0, 0); PG8_LDB(B1, 0, 1); PG8_SCHED; PG8_LDA(At, 0, 0); PG8_STA(PG8_SA(1, 1), a1, 1, va);
            PG8_WAIT_V(8); PG8_WAIT_L(0); PG8_BAR; PG8_MMA(0, 0, At, B0); PG8_MMA(0, 1, At, B1); PG8_BAR; PG8_SCHED;
            PG8_LDA(At, 0, 1); PG8_STB(PG8_SB(0, 0), b2); PG8_STB(PG8_SB(0, 1), b2 + hstepB); PG8_STA(PG8_SA(0, 0), a2, 0, xa);
            PG8_WAIT_V(8); PG8_WAIT_L(0); PG8_BAR; PG8_MMA(1, 0, At, B0); PG8_MMA(1, 1, At, B1); PG8_BAR; PG8_SCHED;
            PG8_LDB(B0, 1, 0); PG8_LDB(B1, 1, 1); PG8_SCHED; PG8_LDA(At, 1, 0); PG8_STA(PG8_SA(0, 1), a2, 1, xa);
            PG8_WAIT_V(8); PG8_WAIT_L(0); PG8_BAR; PG8_MMA(0, 0, At, B0); PG8_MMA(0, 1, At, B1); PG8_BAR; PG8_SCHED;
            PG8_LDA(At, 1, 1); PG8_STB(PG8_SB(1, 0), b3); PG8_STB(PG8_SB(1, 1), b3 + hstepB); PG8_STA(PG8_SA(1, 0), a3, 0, xa);
            PG8_WAIT_V(8); PG8_WAIT_L(0); PG8_BAR; PG8_MMA(1, 0, At, B0); PG8_MMA(1, 1, At, B1); PG8_BAR; PG8_SCHED;
        }
        if constexpr (ALIGN_EPI) { if (wr == 0) PG8_BAR; }
        E(acc, cur, wr, wc, fr, fq);
        if (!has_next) break;
#pragma unroll
        for (int a = 0; a < 2; ++a)
#pragma unroll
            for (int b = 0; b < 2; ++b)
#pragma unroll
                for (int m = 0; m < 4; ++m)
#pragma unroll
                    for (int n = 0; n < 2; ++n) acc[a][b][m][n] = (f32x4){0.f, 0.f, 0.f, 0.f};
        cur = nxt; cA = nA; cB = nB; ++ui;
        if constexpr (GATHER) {
#pragma unroll
            for (int h = 0; h < 2; ++h)
#pragma unroll
                for (int i = 0; i < 2; ++i) va[h][i] = nva[h][i];
        }
        if constexpr (ALIGN_EPI) { if (wr == 1) PG8_BAR; }
    }
    PG8_WAIT_V(0);
    if constexpr (!ALIGN_EPI) { if (wr == 0) PG8_BAR; }
    PG8_BAR;
#undef PG8_SA
#undef PG8_SB
#undef PG8_GLDS
#undef PG8_STAGE_O
#undef PG8_STB
#undef PG8_STA
#undef PG8_LDA
#undef PG8_LDB
#undef PG8_MMA
#undef PG8_WAIT_V
#undef PG8_WAIT_L
#undef PG8_BAR
#undef PG8_SCHED
}
}

constexpr int NWAVES = 8;
constexpr int N_LAUNCHES = MK_N_LAUNCHES;
constexpr int PER_PHASE = 9;
constexpr int BATCH = 4, SEQ = 2048, DM = 2048, NMETA = 16;
constexpr int MREAL = BATCH * SEQ;
constexpr int MPAD = MREAL + 256;
constexpr int LDP = 12800;
constexpr int PC_Q = 0, PC_CB = 2048, PC_K = 4096, PC_V = 4352, PC_CC = 4608, PC_CH = 6656, PC_GA = 8704, PC_GC = 10752;
constexpr int NQH = 32, NKVH = 4, HD = 64, WIN = 128;
constexpr int NEXP = 32, NGRP = 4, EPG = 8, DE = 512;
constexpr float LN_EPS = 1e-5f;
constexpr float ALPHA = 1.189207115002721f;
constexpr int MOE_ROWS_MAX = 2 * MREAL + NEXP * 256;

constexpr size_t MiB = 1u << 20;
constexpr size_t WS_CTL = 0, CTL_ZERO_BYTES = 1 * MiB;
constexpr size_t WS_ROWIDX = 1 * MiB;
constexpr size_t WS_TOKW = 2 * MiB;
constexpr size_t WS_REWG = 3 * MiB;
constexpr size_t WS_WIN = 4 * MiB;
constexpr size_t WS_WB2 = 54 * MiB;
constexpr size_t WS_WOUT = 70 * MiB;
constexpr size_t WS_WGU = 78 * MiB;
constexpr size_t WS_WD = 206 * MiB;
constexpr size_t WS_XN = 270 * MiB;
constexpr size_t WS_P = 303 * MiB;
constexpr size_t WS_ACT = WS_P;
constexpr size_t WS_Y = WS_P + 24 * MiB;
constexpr size_t WS_END = 510 * MiB;
static_assert(WS_P + (size_t)MPAD * LDP * 2 <= WS_END && WS_Y + (size_t)2 * MREAL * DM * 2 <= WS_END && (size_t)MOE_ROWS_MAX * DE * 2 <= 24 * MiB, "ws map");
constexpr int CW_TMO = 0, CW_CODE = 1;
constexpr int CW_CNT = 64;
constexpr int CW_Q = 128;
constexpr int CW_BAR = 4096;

constexpr int RING_OFF = 0, RING_BYTES = 131072;
constexpr int LDSCTL_OFF = RING_BYTES, MISC_OFF = LDSCTL_OFF + 320;
constexpr int LDS_BYTES = 147456;

#define GAS __attribute__((address_space(1)))
#define LAS __attribute__((address_space(3)))
typedef unsigned short bf16;
typedef unsigned v4u __attribute__((ext_vector_type(4)));
typedef unsigned v2u __attribute__((ext_vector_type(2)));
typedef float f32x4 __attribute__((ext_vector_type(4)));
typedef float f32x16 __attribute__((ext_vector_type(16)));
typedef short bf16x8 __attribute__((ext_vector_type(8)));
typedef short s16x4 __attribute__((ext_vector_type(4)));
typedef GAS unsigned gu32;
#define RLX_AGENT __ATOMIC_RELAXED, __HIP_MEMORY_SCOPE_AGENT
#define LDS_WAIT() asm volatile("s_waitcnt lgkmcnt(0)" ::: "memory")
#define VM_WAIT() asm volatile("s_waitcnt vmcnt(0)" ::: "memory")
__device__ __forceinline__ unsigned f2bf(float f) { unsigned u = __builtin_bit_cast(unsigned, f); return (u + 0x7fffu + ((u >> 16) & 1u)) >> 16; }
__device__ __forceinline__ unsigned pk2(float lo, float hi) { return f2bf(lo) | (f2bf(hi) << 16); }
using pg8::bf_lo; using pg8::bf_hi; using pg8::cvt_pk_bf16;

#define XB_TMO      128
#define XB_XCNT(j)  (256  + 64 * (j))
#define XB_XSUB(j)  (1280 + 64 * (j))
#define XB_XGEN(j)  (2304 + 64 * (j))
#define XB_TOP      3328
#define XB_TOPGEN   3392
#define XCD_BAR_WORDS 3456
#define XB_SPIN_CAP (1u << 18)
__device__ __forceinline__ unsigned xb_ld(unsigned* p)              { return __hip_atomic_load(p, __ATOMIC_RELAXED, __HIP_MEMORY_SCOPE_AGENT); }
__device__ __forceinline__ unsigned xb_add(unsigned* p, unsigned v) { return __hip_atomic_fetch_add(p, v, __ATOMIC_RELAXED, __HIP_MEMORY_SCOPE_AGENT); }
__device__ __forceinline__ unsigned xb_xcc_id() { return (unsigned)__builtin_amdgcn_s_getreg((3 << 11) | 20) & 0xFu; }
#define XB_SPIN(cond, bar) do { unsigned _sp = 0; while (cond) { __builtin_amdgcn_s_sleep(1); \
    if ((++_sp & 255u) == 0u) { if (xb_ld(&(bar)[XB_TMO])) break; if (_sp > XB_SPIN_CAP) { atomicAdd(&(bar)[XB_TMO], 1u); break; } } } } while (0)
struct XcdBarrier { unsigned* bar; unsigned x; volatile LAS unsigned* st; int wave; };
__device__ __forceinline__ XcdBarrier xcd_barrier_post(unsigned* bar, volatile LAS unsigned* st) {
    XcdBarrier b; b.bar = bar; b.x = xb_xcc_id(); b.st = st; b.wave = 0;
    if (threadIdx.x == 0) (void)xb_add(&bar[XB_XCNT(b.x)], 1u);
    return b;
}
__device__ __forceinline__ void xcd_barrier_complete(unsigned* bar, unsigned x, unsigned& nloc, unsigned& nx) {
    const unsigned G = gridDim.x * gridDim.y * gridDim.z;
    unsigned sum, cnt, mine, sp = 0u;
    for (;;) {
        sum = 0u; cnt = 0u; mine = 0u;
#pragma unroll
        for (unsigned j = 0; j < 16; ++j) { const unsigned c = xb_ld(&bar[XB_XCNT(j)]); sum += c; cnt += (c > 0u) ? 1u : 0u; mine = (j == x) ? c : mine; }
        if (sum == G) break;
        __builtin_amdgcn_s_sleep(1);
        if ((++sp & 255u) == 0u) { if (xb_ld(&bar[XB_TMO])) break; if (sp > XB_SPIN_CAP) { atomicAdd(&bar[XB_TMO], 1u); break; } }
    }
    nloc = mine > 0u ? mine : 1u; nx = cnt > 0u ? cnt : 1u;
}
__device__ __forceinline__ void xcd_barrier(const XcdBarrier& b) {
    asm volatile("s_waitcnt vmcnt(0)" ::: "memory");
    __syncthreads();
    if (b.wave == 0 && lane_id() == 0) {
        unsigned* bar = b.bar;
        __builtin_amdgcn_s_waitcnt(0);
        unsigned nloc = b.st[0], nx = b.st[1];
        if (nloc == 0u) { xcd_barrier_complete(bar, b.x, nloc, nx); b.st[0] = nloc; b.st[1] = nx; }
        const unsigned old = xb_add(&bar[XB_XSUB(b.x)], 1u);
        const unsigned gen = old / nloc;
        if (old + 1u == (gen + 1u) * nloc) {
            __builtin_amdgcn_fence(__ATOMIC_RELEASE, "agent");
            asm volatile("s_waitcnt vmcnt(0)" ::: "memory");
            const unsigned og = xb_add(&bar[XB_TOP], 1u);
            const unsigned tg = og / nx;
            if (og + 1u == (tg + 1u) * nx) xb_add(&bar[XB_TOPGEN], 1u);
            else XB_SPIN(xb_ld(&bar[XB_TOPGEN]) == tg, bar);
            __builtin_amdgcn_fence(__ATOMIC_ACQUIRE, "agent");
            xb_add(&bar[XB_XGEN(b.x)], 1u);
            asm volatile("s_waitcnt vmcnt(0)" ::: "memory");
        } else {
            XB_SPIN(xb_ld(&bar[XB_XGEN(b.x)]) == gen, bar);
            __builtin_amdgcn_fence(__ATOMIC_ACQUIRE, "agent");
            asm volatile("s_waitcnt vmcnt(0)" ::: "memory");
        }
    }
    __syncthreads();
}

struct Frame {
    LAS unsigned char* lds;
    volatile LAS unsigned* MISC;
    gu32* ctl;
    int wave;
    int vcu, G;
    float* out;
    unsigned char* ws;
};
struct Args { const float* in[21]; float* out; unsigned char* ws; int ph_lo, ph_hi, li, pad; };
__device__ __forceinline__ const float* arg_in(int i) {
    const __attribute__((address_space(4))) char* ka = (const __attribute__((address_space(4))) char*)__builtin_amdgcn_kernarg_segment_ptr();
    unsigned off = (unsigned)i * 8u; asm volatile("" : "+s"(off));
    return *(const float* const __attribute__((address_space(4)))*)(ka + off);
}
__device__ __forceinline__ float wave_sum(float v) {
#pragma unroll
    for (int o = 1; o < 64; o <<= 1) v += __shfl_xor(v, o);
    return v;
}

struct DenseOrder {
    static constexpr bool GATHER = false;
    int nM, nN, nwg, G, c, extra, ex0, wave; long a_tile, b_tile;
    __device__ void init(int wave_, int nM_, int nN_, int G_, int c_, long a_tile_, long b_tile_, int extra_ = 0, int ex0_ = 0) { wave = wave_; nM = nM_; nN = nN_; nwg = nM * nN; G = G_; c = c_; a_tile = a_tile_; b_tile = b_tile_; extra = extra_; ex0 = ex0_; }
    __device__ bool next(int i, pg8::Unit& u) const {
        const long L = (long)i * G + c; if (L >= nwg + extra) return false;
        if (L >= nwg) { u.pm = nM; u.pn = ex0 + (int)(L - nwg); }
        else {
            int wgid = (int)L; { const int q = nwg / pg8::NXCD, r = nwg % pg8::NXCD, xcd = wgid % pg8::NXCD, off = wgid / pg8::NXCD; wgid = (xcd < r ? xcd * (q + 1) : r * (q + 1) + (xcd - r) * q) + off; }
            const int nig = pg8::WGM * nN, gid = wgid / nig, fm = gid * pg8::WGM, gsz = (nM - fm) < pg8::WGM ? (nM - fm) : pg8::WGM;
            u.pm = fm + ((wgid % nig) % gsz); u.pn = (wgid % nig) / gsz;
        }
        u.a_byte = (long)u.pm * a_tile; u.b_byte = (long)u.pn * b_tile; u.e = 0; u.mt = 0; u.cnt = 0; return true;
    }
    __device__ __forceinline__ unsigned row_byte(const pg8::Unit&, int) const { return 0u; }
};
template <int NT, bool GATH>
struct MoeOrder {
    static constexpr bool GATHER = GATH;
    int wave; volatile LAS int* tp; volatile LAS int* cn; int G, c; long b_exp, b_tile, a_tile; const int* rowidx; unsigned row_bytes;
    __device__ bool next(int i, pg8::Unit& u) const {
        const int total = __builtin_amdgcn_readfirstlane(tp[32]) * NT;
        const long L = (long)i * G + c; if (L >= total) return false;
        const int T = (int)(L / NT), n = (int)(L % NT);
        int e = 0;
        for (int j = 1; j < 32; ++j) e += (__builtin_amdgcn_readfirstlane(tp[j]) <= T) ? 1 : 0;
        u.e = e; u.mt = T - __builtin_amdgcn_readfirstlane(tp[e]); u.cnt = __builtin_amdgcn_readfirstlane(cn[e]); u.pm = T; u.pn = n;
        u.a_byte = GATH ? 0 : (long)T * a_tile; u.b_byte = (long)e * b_exp + (long)n * b_tile; return true;
    }
    __device__ __forceinline__ unsigned row_byte(const pg8::Unit& u, int r) const {
        const int pos = u.mt * 256 + r;
        int tk = 0; if (pos < u.cnt) tk = rowidx[u.e * MREAL + pos];
        return (unsigned)(tk >> 1) * row_bytes;
    }
};

using pg8::Unit; using pg8::HALF; using pg8::BM;
struct EpiBf16 {
    static constexpr bool PERM = true, MID = false;
    bf16* O; int ldc;
    __device__ __forceinline__ void mid(f32x4 (&)[2][2][4][2], const Unit&, int, int, int, int) const {}
    __device__ __forceinline__ void operator()(const f32x4 (&acc)[2][2][4][2], const Unit& u, int wr, int wc, int fr, int fq) const {
        const int row0 = u.pm * BM + wr * 64 + fr, col0 = u.pn * BM + wc * 32 + 8 * fq;
#pragma unroll
        for (int ai = 0; ai < 2; ++ai)
#pragma unroll
            for (int m = 0; m < 4; ++m) { bf16* rowp = O + (size_t)(row0 + ai * HALF + m * 16) * ldc + col0;
#pragma unroll
                for (int bj = 0; bj < 2; ++bj) { const f32x4 v0 = acc[ai][bj][m][0], v1 = acc[ai][bj][m][1];
                    v4u w; w.x = cvt_pk_bf16(v0[0], v0[1]); w.y = cvt_pk_bf16(v0[2], v0[3]); w.z = cvt_pk_bf16(v1[0], v1[1]); w.w = cvt_pk_bf16(v1[2], v1[3]);
                    *(v4u*)(rowp + bj * HALF) = w; } }
    }
};
__device__ __forceinline__ float sigm(float x) { return __builtin_amdgcn_rcpf(1.0f + __expf(-x)); }
struct EpiGate {
    static constexpr bool PERM = true, MID = true;
    bf16* P;
    __device__ __forceinline__ void mid(f32x4 (&acc)[2][2][4][2], const Unit& u, int wr, int wc, int fr, int fq) const {
        int row0 = u.pm * BM + wr * 64 + fr, col0 = u.pn * BM + wc * 32 + 8 * fq;
        asm volatile("" : "+v"(row0), "+v"(col0));
#pragma unroll
        for (int ai = 0; ai < 2; ++ai)
#pragma unroll
            for (int m = 0; m < 4; ++m) { const bf16* rowp = P + (size_t)(row0 + ai * HALF + m * 16) * LDP + col0;
#pragma unroll
                for (int bj = 0; bj < 2; ++bj) { const v4u a = *(const v4u*)(rowp + PC_GA + bj * HALF), c = *(const v4u*)(rowp + PC_GC + bj * HALF);
                    const unsigned aw[4] = {a.x, a.y, a.z, a.w}, cw[4] = {c.x, c.y, c.z, c.w};
#pragma unroll
                    for (int q = 0; q < 4; ++q) {
                        const float r0 = (1.0f + __expf(-bf_lo(cw[q]))) * __builtin_amdgcn_rcpf(1.0f + __expf(-bf_lo(aw[q])));
                        const float r1 = (1.0f + __expf(-bf_hi(cw[q]))) * __builtin_amdgcn_rcpf(1.0f + __expf(-bf_hi(aw[q])));
                        acc[ai][bj][m][q >> 1][(q & 1) * 2] *= r0; acc[ai][bj][m][q >> 1][(q & 1) * 2 + 1] *= r1; } }
                asm volatile("" ::: "memory"); }
    }
    __device__ __forceinline__ void operator()(const f32x4 (&acc)[2][2][4][2], const Unit& u, int wr, int wc, int fr, int fq) const {
        const int row0 = u.pm * BM + wr * 64 + fr, col0 = u.pn * BM + wc * 32 + 8 * fq;
#pragma unroll
        for (int ai = 0; ai < 2; ++ai)
#pragma unroll
            for (int m = 0; m < 4; ++m) { bf16* rowp = P + (size_t)(row0 + ai * HALF + m * 16) * LDP + col0;
#pragma unroll
                for (int bj = 0; bj < 2; ++bj) { const v4u c = *(const v4u*)(rowp + PC_GC + bj * HALF); const unsigned cw[4] = {c.x, c.y, c.z, c.w};
                    const f32x4 v0 = acc[ai][bj][m][0], v1 = acc[ai][bj][m][1];
                    v4u w;
                    w.x = cvt_pk_bf16(v0[0] * sigm(bf_lo(cw[0])), v0[1] * sigm(bf_hi(cw[0]))); w.y = cvt_pk_bf16(v0[2] * sigm(bf_lo(cw[1])), v0[3] * sigm(bf_hi(cw[1])));
                    w.z = cvt_pk_bf16(v1[0] * sigm(bf_lo(cw[2])), v1[1] * sigm(bf_hi(cw[2]))); w.w = cvt_pk_bf16(v1[2] * sigm(bf_lo(cw[3])), v1[3] * sigm(bf_hi(cw[3])));
                    *(v4u*)(rowp + PC_CC + bj * HALF) = w; }
                asm volatile("" ::: "memory"); }
    }
};
struct EpiPre {
    static constexpr bool PERM = false, MID = false;
    const bf16* XN; float* pre; int ldo;
    __device__ __forceinline__ void mid(f32x4 (&)[2][2][4][2], const Unit&, int, int, int, int) const {}
    __device__ __forceinline__ void operator()(const f32x4 (&acc)[2][2][4][2], const Unit& u, int wr, int wc, int fr, int fq) const {
        const int row0 = u.pm * BM + wr * 64 + fr, col0 = u.pn * BM + wc * 32 + 4 * fq;
#pragma unroll
        for (int ai = 0; ai < 2; ++ai)
#pragma unroll
            for (int m = 0; m < 4; ++m) { const int r = row0 + ai * HALF + m * 16; const bf16* xr = XN + (size_t)r * DM + col0; float* orow = pre + (size_t)r * ldo + col0;
#pragma unroll
                for (int bj = 0; bj < 2; ++bj)
#pragma unroll
                    for (int n = 0; n < 2; ++n) { const v2u h = *(const v2u*)(xr + bj * HALF + n * 16); const f32x4 a = acc[ai][bj][m][n];
                        f32x4 o; o[0] = ALPHA * bf_lo(h.x) + a[0]; o[1] = ALPHA * bf_hi(h.x) + a[1]; o[2] = ALPHA * bf_lo(h.y) + a[2]; o[3] = ALPHA * bf_hi(h.y) + a[3];
                        *(f32x4*)(orow + bj * HALF + n * 16) = o; } }
    }
};
struct EpiAct {
    static constexpr bool PERM = true, MID = false;
    bf16* act;
    __device__ __forceinline__ void mid(f32x4 (&)[2][2][4][2], const Unit&, int, int, int, int) const {}
    __device__ __forceinline__ void operator()(const f32x4 (&acc)[2][2][4][2], const Unit& u, int wr, int wc, int fr, int fq) const {
        const int row0 = u.pm * BM + wr * 64 + fr, col0 = u.pn * HALF + wc * 32 + 8 * fq;
#pragma unroll
        for (int ai = 0; ai < 2; ++ai)
#pragma unroll
            for (int m = 0; m < 4; ++m) { bf16* rowp = act + (size_t)(row0 + ai * HALF + m * 16) * DE + col0;
                float o[8];
#pragma unroll
                for (int n = 0; n < 2; ++n)
#pragma unroll
                    for (int j = 0; j < 4; ++j) { const float gt = acc[ai][0][m][n][j], up = acc[ai][1][m][n][j]; o[n * 4 + j] = gt * sigm(gt) * up; }
                v4u w; w.x = cvt_pk_bf16(o[0], o[1]); w.y = cvt_pk_bf16(o[2], o[3]); w.z = cvt_pk_bf16(o[4], o[5]); w.w = cvt_pk_bf16(o[6], o[7]);
                *(v4u*)rowp = w; }
    }
};
struct EpiDown {
    static constexpr bool PERM = true, MID = false;
    bf16* Y; const int* rowidx; const float* tokw;
    __device__ __forceinline__ void mid(f32x4 (&)[2][2][4][2], const Unit&, int, int, int, int) const {}
    __device__ __forceinline__ void operator()(const f32x4 (&acc)[2][2][4][2], const Unit& u, int wr, int wc, int fr, int fq) const {
        const int col0 = u.pn * BM + wc * 32 + 8 * fq;
#pragma unroll
        for (int ai = 0; ai < 2; ++ai)
#pragma unroll
            for (int m = 0; m < 4; ++m) { const int pos = u.mt * 256 + ai * HALF + wr * 64 + m * 16 + fr;
                if (pos < u.cnt) { const int tk = rowidx[u.e * MREAL + pos]; const float w = tokw[tk];
                    bf16* rowp = Y + ((size_t)(tk & 1) * MREAL + (size_t)(tk >> 1)) * DM + col0;
#pragma unroll
                    for (int bj = 0; bj < 2; ++bj) { const f32x4 v0 = acc[ai][bj][m][0] * w, v1 = acc[ai][bj][m][1] * w;
                        v4u o; o.x = cvt_pk_bf16(v0[0], v0[1]); o.y = cvt_pk_bf16(v0[2], v0[3]); o.z = cvt_pk_bf16(v1[0], v1[1]); o.w = cvt_pk_bf16(v1[2], v1[3]);
                        *(v4u*)(rowp + bj * HALF) = o; } } }
    }
};

struct ConvItem { const float* src; bf16* dst; int ld_src, ld_dst; };
constexpr int CV_IN = 32 * 400, CV_SQ = 32 * 64, CV_GU = 32 * 512, CV_DN = 32 * 512;
constexpr int CV_A = CV_IN;
constexpr int CV_B = 3 * CV_SQ + 2 * CV_GU + CV_DN;
__device__ __forceinline__ ConvItem conv_item_a(int r, unsigned char* ws) {
    const int kb = r / 400, nb = r % 400; const int n0 = nb * 32;
    int ns = n0; if (n0 >= 2048 && n0 < 4096) ns = n0 + 512; else if (n0 >= 4096 && n0 < 4608) ns = n0 - 2048;
    return ConvItem{arg_in(4) + (size_t)(kb * 64) * LDP + ns, (bf16*)(ws + WS_WIN) + (size_t)n0 * DM + kb * 64, LDP, DM};
}
__device__ __forceinline__ ConvItem conv_item_b(int r, unsigned char* ws) {
    bf16* Wb2_t = (bf16*)(ws + WS_WB2); bf16* Wout_t = (bf16*)(ws + WS_WOUT); bf16* Wgu_t = (bf16*)(ws + WS_WGU); bf16* Wd_t = (bf16*)(ws + WS_WD);
    if (r < 2 * CV_SQ) { const int cv = r >= CV_SQ ? 1 : 0; r -= cv * CV_SQ; const int kb = r / 64, nb = r % 64;
        return ConvItem{arg_in(7 + cv) + (size_t)(kb * 64) * DM + nb * 32, Wb2_t + (size_t)(nb * 32) * 4096 + cv * 2048 + kb * 64, DM, 4096}; }
    r -= 2 * CV_SQ;
    if (r < CV_SQ) { const int kb = r / 64, nb = r % 64; return ConvItem{arg_in(9) + (size_t)(kb * 64) * DM + nb * 32, Wout_t + (size_t)(nb * 32) * DM + kb * 64, DM, DM}; }
    r -= CV_SQ;
    if (r < 2 * CV_GU) { const int up = r >= CV_GU ? 1 : 0; r -= up * CV_GU; const int e = r / 512, q = r % 512, kb = q / 16, nb = q % 16, n0 = nb * 32;
        return ConvItem{arg_in(16 + up) + (size_t)e * DM * DE + (size_t)(kb * 64) * DE + n0, Wgu_t + ((size_t)e * 1024 + (size_t)(n0 >> 7) * 256 + up * 128 + (n0 & 127)) * DM + kb * 64, DE, DM}; }
    r -= 2 * CV_GU;
    { const int e = r / 512, q = r % 512, kb = q / 64, nb = q % 64;
      return ConvItem{arg_in(18) + (size_t)e * DE * DM + (size_t)(kb * 64) * DM + nb * 32, Wd_t + ((size_t)e * DM + nb * 32) * DE + kb * 64, DM, DE}; }
}
struct ConvRegs { f32x4 v[8]; };
__device__ __forceinline__ void conv_load(ConvRegs& R, const ConvItem& it, int lane) {
    const float* p = it.src + (size_t)(lane >> 3) * it.ld_src + 4 * (lane & 7);
#pragma unroll
    for (int i = 0; i < 8; ++i) R.v[i] = __builtin_nontemporal_load((const f32x4*)(p + (size_t)(8 * i) * it.ld_src));
}
__device__ __forceinline__ void conv_lds_write(const ConvRegs& R, LAS float* scr, int lane) {
    LAS float* q = scr + (lane >> 3) * 33 + 4 * (lane & 7);
#pragma unroll
    for (int i = 0; i < 8; ++i) { q[(8 * i) * 33 + 0] = R.v[i][0]; q[(8 * i) * 33 + 1] = R.v[i][1]; q[(8 * i) * 33 + 2] = R.v[i][2]; q[(8 * i) * 33 + 3] = R.v[i][3]; }
}
__device__ __forceinline__ void conv_store(const ConvItem& it, LAS float* scr, int lane) {
    const int c = lane & 7;
#pragma unroll
    for (int j = 0; j < 4; ++j) { const int n = (lane >> 3) + 8 * j; const LAS float* s = scr + (8 * c) * 33 + n;
        v4u o; o.x = pk2(s[0 * 33], s[1 * 33]); o.y = pk2(s[2 * 33], s[3 * 33]); o.z = pk2(s[4 * 33], s[5 * 33]); o.w = pk2(s[6 * 33], s[7 * 33]);
        *(GAS v4u*)(it.dst + (size_t)n * it.ld_dst + 8 * c) = o; }
}
template <int LIST>
__device__ __forceinline__ void conv_run(int first, int last, int stride, unsigned char* ws, LAS float* scr, int lane) {
    if (first >= last) return;
    ConvItem i0 = LIST ? conv_item_b(first, ws) : conv_item_a(first, ws), i1 = i0, i2 = i0;
    ConvRegs r0, r1;
    conv_load(r0, i0, lane);
    const bool h1 = first + stride < last;
    if (h1) { i1 = LIST ? conv_item_b(first + stride, ws) : conv_item_a(first + stride, ws); conv_load(r1, i1, lane); } else r1 = r0;
    for (int it = first; it < last; it += stride) {
        conv_lds_write(r0, scr, lane);
        r0 = r1;
        const int i2x = it + 2 * stride;
        if (i2x < last) { i2 = LIST ? conv_item_b(i2x, ws) : conv_item_a(i2x, ws); conv_load(r1, i2, lane); }
        LDS_WAIT(); asm volatile("" ::: "memory");
        conv_store(i0, scr, lane);
        LDS_WAIT(); asm volatile("" ::: "memory");
        i0 = i1; i1 = i2;
    }
}
constexpr int CV_CHUNK = 8;
__device__ __forceinline__ void conv_queue(unsigned* qhead, unsigned char* ws, LAS float* scr, int lane) {
    for (;;) {
        unsigned base = 0u;
        if (lane == 0) base = __hip_atomic_fetch_add(qhead, (unsigned)CV_CHUNK, RLX_AGENT);
        base = (unsigned)__builtin_amdgcn_readfirstlane((int)base);
        if (base >= (unsigned)CV_B) break;
        conv_run<1>((int)base, (int)base + CV_CHUNK < CV_B ? (int)base + CV_CHUNK : CV_B, 1, ws, scr, lane);
    }
}
__device__ __forceinline__ void ln_row_to_bf16(const float* xrow, const float* g, const float* b, bf16* orow, int lane) {
    asm volatile("" : "+v"(lane));
    const f32x4* xr = (const f32x4*)xrow + lane;
    f32x4 v[8]; float s = 0.f;
#pragma unroll
    for (int j = 0; j < 8; ++j) { v[j] = xr[64 * j]; s += (v[j][0] + v[j][1]) + (v[j][2] + v[j][3]); }
    const float mean = wave_sum(s) * (1.f / DM); float s2 = 0.f;
#pragma unroll
    for (int j = 0; j < 8; ++j) { v[j] = v[j] - mean; s2 += (v[j][0] * v[j][0] + v[j][1] * v[j][1]) + (v[j][2] * v[j][2] + v[j][3] * v[j][3]); }
    const float rstd = 1.f / sqrtf(wave_sum(s2) * (1.f / DM) + LN_EPS);
    v2u* o8 = (v2u*)orow + lane;
#pragma unroll
    for (int j = 0; j < 8; ++j) { const f32x4 gg = ((const f32x4*)g)[lane + 64 * j], bb = ((const f32x4*)b)[lane + 64 * j]; const f32x4 y = v[j] * rstd * gg + bb;
        v2u w; w.x = pk2(y[0], y[1]); w.y = pk2(y[2], y[3]); o8[64 * j] = w; }
}
__device__ __forceinline__ void p0_prologue(Frame& F, const Args& A) {
    LAS float* scr = (LAS float*)(F.lds + RING_OFF + F.wave * 16384);
    const int lane0 = lane_id(), tid0 = F.wave * 64 + lane0;
    const int gw = F.vcu * NWAVES + F.wave, NGW = F.G * NWAVES;
    bf16* XN = (bf16*)(F.ws + WS_XN);
    conv_run<0>(gw, CV_A, NGW, F.ws, scr, lane0);
    { bf16* whi = (bf16*)(F.ws + WS_REWG); bf16* wlo = whi + 48 * DM; const float* rgw = arg_in(12); const float* rew = arg_in(14);
      for (int i = (F.vcu * NWAVES * 64) + tid0; i < 48 * DM; i += F.G * NWAVES * 64) { const int n = i / DM, k = i % DM;
          const float w = n < NGRP ? rgw[k * NGRP + n] : (n < NGRP + NEXP ? rew[k * NEXP + (n - NGRP)] : 0.f);
          const unsigned hi = f2bf(w); const float rem = w - __builtin_bit_cast(float, hi << 16);
          whi[i] = (bf16)hi; wlo[i] = (bf16)f2bf(rem); } }
    for (int m = gw; m < MPAD; m += NGW) {
        if (m < MREAL) ln_row_to_bf16(arg_in(0) + (size_t)m * DM, arg_in(2), arg_in(3), XN + (size_t)m * DM, lane0);
        else if (m < MREAL + NMETA) ln_row_to_bf16(arg_in(1) + (size_t)(m - MREAL) * DM, arg_in(2), arg_in(3), XN + (size_t)m * DM, lane0);
        else { v2u* o8 = (v2u*)(XN + (size_t)m * DM) + lane0;
#pragma unroll
            for (int j = 0; j < 8; ++j) o8[64 * j] = (v2u){0u, 0u}; }
    }
}

constexpr int KS_PITCH = 144;
constexpr int VT_PITCH = 584;
constexpr int KROWS = 288;
constexpr int ATT_KS = 0, ATT_VT = KROWS * KS_PITCH, ATT_LDS = ATT_VT + 64 * VT_PITCH;
static_assert(ATT_LDS <= RING_BYTES, "attention LDS");
constexpr float LOG2E = 1.4426950408889634f;

template <int R>
__device__ __forceinline__ void attn_qblock(LAS const unsigned char* lds, bf16* P, int qrow0, int head, float sink_l2, bool has_prev, int lane) {
    const int ql = lane & 31, hh = lane >> 5;
    bf16* qp = P + (size_t)(qrow0 + 32 * R + ql) * LDP + PC_Q + head * HD;
    bf16x8 qf[4];
#pragma unroll
    for (int s = 0; s < 4; ++s) qf[s] = *(const bf16x8*)(qp + 16 * s + 8 * hh);
    f32x16 S[6];
#define KB_ROW(i) ((i) == 0 ? 0 : ((i) <= 4 - R ? 32 + 32 * (R + (i) - 1) : 160 + 32 * ((i) - (5 - R))))
#pragma unroll
    for (int i = 0; i < 6; ++i) {
        const int kr = KB_ROW(i);
        f32x16 a = {0.f, 0.f, 0.f, 0.f, 0.f, 0.f, 0.f, 0.f, 0.f, 0.f, 0.f, 0.f, 0.f, 0.f, 0.f, 0.f};
        const LAS unsigned char* kp = lds + ATT_KS + (kr + ql) * KS_PITCH + 16 * hh;
#pragma unroll
        for (int s = 0; s < 4; ++s) { const bf16x8 kf = *(const LAS bf16x8*)(kp + 32 * s); a = __builtin_amdgcn_mfma_f32_32x32x16_bf16(kf, qf[s], a, 0, 0, 0); }
        S[i] = a;
    }
    const float NEG = -INFINITY; const float sc = 0.125f * LOG2E;
    float mx = sink_l2;
#pragma unroll
    for (int i = 0; i < 6; ++i)
#pragma unroll
        for (int r = 0; r < 16; ++r) {
            const int kvl = (r & 3) + 8 * (r >> 2) + 4 * hh;
            float t = S[i][r] * sc;
            bool ok = true;
            if (i == 0) ok = kvl < NMETA;
            else if (i <= 4 - R) { ok = has_prev; if (i == 1) ok = ok && (kvl > ql); }
            else { if (i == 5) ok = (kvl <= ql); }
            t = ok ? t : NEG; S[i][r] = t; mx = fmaxf(mx, t);
        }
    mx = fmaxf(mx, __shfl_xor(mx, 32));
    float l = 0.f;
#pragma unroll
    for (int i = 0; i < 6; ++i)
#pragma unroll
        for (int r = 0; r < 16; ++r) { const float p = __builtin_amdgcn_exp2f(S[i][r] - mx); S[i][r] = p; l += p; }
    l += __shfl_xor(l, 32);
    l += __builtin_amdgcn_exp2f(sink_l2 - mx);
    const float inv = 1.0f / l;
    f32x16 O[2];
#pragma unroll
    for (int d = 0; d < 2; ++d) O[d] = (f32x16){0.f, 0.f, 0.f, 0.f, 0.f, 0.f, 0.f, 0.f, 0.f, 0.f, 0.f, 0.f, 0.f, 0.f, 0.f, 0.f};
#pragma unroll
    for (int i = 0; i < 6; ++i) {
        const int kr = KB_ROW(i);
#pragma unroll
        for (int s2 = 0; s2 < 2; ++s2) {
            unsigned pw[4];
#pragma unroll
            for (int j = 0; j < 4; ++j) pw[j] = cvt_pk_bf16(S[i][8 * s2 + 2 * j] * inv, S[i][8 * s2 + 2 * j + 1] * inv);
            const v4u pv = {pw[0], pw[1], pw[2], pw[3]};
            const bf16x8 pf = __builtin_bit_cast(bf16x8, pv);
#pragma unroll
            for (int d = 0; d < 2; ++d) {
                const LAS unsigned char* vp = lds + ATT_VT + (ql + 32 * d) * VT_PITCH + (kr + 16 * s2 + 4 * hh) * 2;
                const v2u lo = *(const LAS v2u*)vp, hi = *(const LAS v2u*)(vp + 16);
                const v4u vv = {lo.x, lo.y, hi.x, hi.y};
                O[d] = __builtin_amdgcn_mfma_f32_32x32x16_bf16(pf, __builtin_bit_cast(bf16x8, vv), O[d], 0, 0, 0);
            }
        }
    }
#undef KB_ROW
#pragma unroll
    for (int d = 0; d < 2; ++d)
#pragma unroll
        for (int r = 0; r < 16; ++r) { const int q = (r & 3) + 8 * (r >> 2) + 4 * hh;
            P[(size_t)(qrow0 + 32 * R + q) * LDP + PC_Q + head * HD + 32 * d + ql] = (bf16)f2bf(O[d][r]); }
}

__device__ __forceinline__ void p2_attention_conv(Frame& F, const Args& A) {
    bf16* P = (bf16*)(F.ws + WS_P);
    const float* sinks = arg_in(5);
    const int lane0 = lane_id(), tid0 = F.wave * 64 + lane0;
    for (int it = blockIdx.x; it < BATCH * NKVH * (SEQ / WIN); it += F.G) {
        const int b = it / (NKVH * 16), kvh = (it / 16) % NKVH, nb = it % 16;
        const int row_own = b * SEQ + nb * WIN, row_prev = row_own - WIN;
        __syncthreads();
        for (int q = tid0; q < KROWS * 8; q += NWAVES * 64) {
            const int row = q >> 3, c = q & 7;
            int grow = -1;
            if (row < NMETA) grow = MREAL + row;
            else if (row >= 32 && row < 160) { if (nb > 0) grow = row_prev + (row - 32); }
            else if (row >= 160) grow = row_own + (row - 160);
            v4u kv = {0u, 0u, 0u, 0u}, vv = {0u, 0u, 0u, 0u};
            if (grow >= 0) { const bf16* rp = P + (size_t)grow * LDP; kv = *(const v4u*)(rp + PC_K + kvh * HD + 8 * c); vv = *(const v4u*)(rp + PC_V + kvh * HD + 8 * c); }
            *(LAS v4u*)(F.lds + ATT_KS + row * KS_PITCH + c * 16) = kv;
            const unsigned vw[4] = {vv.x, vv.y, vv.z, vv.w};
#pragma unroll
            for (int e = 0; e < 4; ++e) {
                *(LAS unsigned short*)(F.lds + ATT_VT + (8 * c + 2 * e) * VT_PITCH + row * 2) = (unsigned short)(vw[e] & 0xffffu);
                *(LAS unsigned short*)(F.lds + ATT_VT + (8 * c + 2 * e + 1) * VT_PITCH + row * 2) = (unsigned short)(vw[e] >> 16);
            }
        }
        __syncthreads();
        const int head = kvh * 8 + F.wave;
        const float sink_l2 = sinks[head] * LOG2E;
        attn_qblock<0>((LAS const unsigned char*)F.lds, P, row_own, head, sink_l2, nb > 0, lane0);
        attn_qblock<1>((LAS const unsigned char*)F.lds, P, row_own, head, sink_l2, nb > 0, lane0);
        attn_qblock<2>((LAS const unsigned char*)F.lds, P, row_own, head, sink_l2, nb > 0, lane0);
        attn_qblock<3>((LAS const unsigned char*)F.lds, P, row_own, head, sink_l2, nb > 0, lane0);
    }
    const float* cw = arg_in(6);
    const int c0 = 4 * tid0;
    const f32x4 w0 = *(const f32x4*)(cw + c0), w1 = *(const f32x4*)(cw + DM + c0), w2 = *(const f32x4*)(cw + 2 * DM + c0);
    for (int it = blockIdx.x; it < MREAL / 32; it += F.G) {
        const int r0 = it * 32, s0 = r0 % SEQ;
        const int rm2 = (s0 == 0) ? MREAL + NMETA - 2 : r0 - 2, rm1 = (s0 == 0) ? MREAL + NMETA - 1 : r0 - 1;
        f32x4 pm2, pm1;
        { const v2u a = *(const v2u*)(P + (size_t)rm2 * LDP + PC_CC + c0), h = *(const v2u*)(P + (size_t)rm2 * LDP + PC_CH + c0);
          pm2 = (f32x4){bf_lo(a.x) * bf_lo(h.x), bf_hi(a.x) * bf_hi(h.x), bf_lo(a.y) * bf_lo(h.y), bf_hi(a.y) * bf_hi(h.y)}; }
        { const v2u a = *(const v2u*)(P + (size_t)rm1 * LDP + PC_CC + c0), h = *(const v2u*)(P + (size_t)rm1 * LDP + PC_CH + c0);
          pm1 = (f32x4){bf_lo(a.x) * bf_lo(h.x), bf_hi(a.x) * bf_hi(h.x), bf_lo(a.y) * bf_lo(h.y), bf_hi(a.y) * bf_hi(h.y)}; }
#pragma unroll 4
        for (int i = 0; i < 32; ++i) {
            bf16* rp = P + (size_t)(r0 + i) * LDP;
            const v2u a = *(const v2u*)(rp + PC_CC + c0), h = *(const v2u*)(rp + PC_CH + c0), bb = *(const v2u*)(rp + PC_CB + c0);
            const f32x4 p = {bf_lo(a.x) * bf_lo(h.x), bf_hi(a.x) * bf_hi(h.x), bf_lo(a.y) * bf_lo(h.y), bf_hi(a.y) * bf_hi(h.y)};
            const f32x4 cbv = {bf_lo(bb.x), bf_hi(bb.x), bf_lo(bb.y), bf_hi(bb.y)};
            const f32x4 uu = cbv * (w0 * pm2 + w1 * pm1 + w2 * p);
            v2u o; o.x = pk2(uu[0], uu[1]); o.y = pk2(uu[2], uu[3]);
            *(v2u*)(rp + PC_CB + c0) = o;
            pm2 = pm1; pm1 = p;
        }
    }
}

typedef float f32x4_t __attribute__((ext_vector_type(4)));
__device__ __forceinline__ void p5_ln1_router(Frame& F, const Args& A) {
    const int lane = lane_id(), w = F.wave, tid = w * 64 + lane;
    const int rl = lane & 15, kq = lane >> 4;
    bf16* P = (bf16*)(F.ws + WS_P); bf16* XN = (bf16*)(F.ws + WS_XN);
    const float* g1 = arg_in(10); const float* b1 = arg_in(11);
    const float* rgb = arg_in(13); const float* reb = arg_in(15);
    const bf16* whi = (const bf16*)(F.ws + WS_REWG); const bf16* wlo = whi + 48 * DM;
    int* rowidx = (int*)(F.ws + WS_ROWIDX); float* tokw = (float*)(F.ws + WS_TOKW);
    unsigned* cnt = (unsigned*)(F.ctl + CW_CNT);
    LAS float* red = (LAS float*)(F.lds + RING_OFF);
    LAS float* plog = (LAS float*)(F.lds + RING_OFF + 2048);
    LAS float* flog = (LAS float*)(F.lds + RING_OFF + 2048 + 24576);
    for (int rg = blockIdx.x; rg < MREAL / 16; rg += F.G) {
        const int row = rg * 16 + rl, kbase = 256 * w + 8 * kq;
        const float* xp = (const float*)(P + (size_t)row * LDP + PC_GA) + kbase;
        f32x4 x[8][2];
#pragma unroll
        for (int s = 0; s < 8; ++s) { x[s][0] = *(const f32x4*)(xp + 32 * s); x[s][1] = *(const f32x4*)(xp + 32 * s + 4); }
        float sm = 0.f;
#pragma unroll
        for (int s = 0; s < 8; ++s) sm += ((x[s][0][0] + x[s][0][1]) + (x[s][0][2] + x[s][0][3])) + ((x[s][1][0] + x[s][1][1]) + (x[s][1][2] + x[s][1][3]));
        sm += __shfl_xor(sm, 16); sm += __shfl_xor(sm, 32);
        if (kq == 0) red[w * 16 + rl] = sm;
        __syncthreads();
        float tot = 0.f;
#pragma unroll
        for (int j = 0; j < 8; ++j) tot += red[j * 16 + rl];
        const float mean = tot * (1.f / DM);
        float sq = 0.f;
#pragma unroll
        for (int s = 0; s < 8; ++s)
#pragma unroll
            for (int h = 0; h < 2; ++h) { x[s][h] = x[s][h] - mean; sq += (x[s][h][0] * x[s][h][0] + x[s][h][1] * x[s][h][1]) + (x[s][h][2] * x[s][h][2] + x[s][h][3] * x[s][h][3]); }
        sq += __shfl_xor(sq, 16); sq += __shfl_xor(sq, 32);
        if (kq == 0) red[128 + w * 16 + rl] = sq;
        __syncthreads();
        float tq = 0.f;
#pragma unroll
        for (int j = 0; j < 8; ++j) tq += red[128 + j * 16 + rl];
        const float rstd = 1.f / sqrtf(tq * (1.f / DM) + LN_EPS);
        f32x4 acc[3];
#pragma unroll
        for (int nb = 0; nb < 3; ++nb) acc[nb] = (f32x4){0.f, 0.f, 0.f, 0.f};
#pragma unroll
        for (int s = 0; s < 8; ++s) {
            const int k0 = kbase + 32 * s;
            const f32x4 ga = *(const f32x4*)(g1 + k0), gb = *(const f32x4*)(g1 + k0 + 4), ba = *(const f32x4*)(b1 + k0), bb = *(const f32x4*)(b1 + k0 + 4);
            const f32x4 ha = x[s][0] * rstd * ga + ba, hb = x[s][1] * rstd * gb + bb;
            v4u uh; uh.x = cvt_pk_bf16(ha[0], ha[1]); uh.y = cvt_pk_bf16(ha[2], ha[3]); uh.z = cvt_pk_bf16(hb[0], hb[1]); uh.w = cvt_pk_bf16(hb[2], hb[3]);
            *(v4u*)(XN + (size_t)row * DM + k0) = uh;
            v4u ul; ul.x = cvt_pk_bf16(ha[0] - bf_lo(uh.x), ha[1] - bf_hi(uh.x)); ul.y = cvt_pk_bf16(ha[2] - bf_lo(uh.y), ha[3] - bf_hi(uh.y));
            ul.z = cvt_pk_bf16(hb[0] - bf_lo(uh.z), hb[1] - bf_hi(uh.z)); ul.w = cvt_pk_bf16(hb[2] - bf_lo(uh.w), hb[3] - bf_hi(uh.w));
            const bf16x8 ahi = __builtin_bit_cast(bf16x8, uh), alo = __builtin_bit_cast(bf16x8, ul);
#pragma unroll
            for (int nb = 0; nb < 3; ++nb) {
                const bf16x8 bh = *(const bf16x8*)(whi + (size_t)(16 * nb + rl) * DM + k0), bl = *(const bf16x8*)(wlo + (size_t)(16 * nb + rl) * DM + k0);
                acc[nb] = __builtin_amdgcn_mfma_f32_16x16x32_bf16(ahi, bh, acc[nb], 0, 0, 0);
                acc[nb] = __builtin_amdgcn_mfma_f32_16x16x32_bf16(alo, bh, acc[nb], 0, 0, 0);
                acc[nb] = __builtin_amdgcn_mfma_f32_16x16x32_bf16(ahi, bl, acc[nb], 0, 0, 0);
            }
        }
#pragma unroll
        for (int nb = 0; nb < 3; ++nb)
#pragma unroll
            for (int i = 0; i < 4; ++i) plog[(w * 16 + 4 * kq + i) * 48 + 16 * nb + rl] = acc[nb][i];
        __syncthreads();
        for (int o = tid; o < 16 * 48; o += NWAVES * 64) { float t = 0.f;
#pragma unroll
            for (int j = 0; j < 8; ++j) t += plog[j * 768 + o];
            flog[o] = t; }
        __syncthreads();
        if (tid < 16) {
            const LAS float* fl = flog + tid * 48; const int m = rg * 16 + tid;
            float gl[4];
#pragma unroll
            for (int c = 0; c < 4; ++c) gl[c] = fl[c] + rgb[c];
            int gsel = 0; float gmax = gl[0];
#pragma unroll
            for (int c = 1; c < 4; ++c) if (gl[c] > gmax) { gmax = gl[c]; gsel = c; }
            float gden = 0.f;
#pragma unroll
            for (int c = 0; c < 4; ++c) gden += __expf(gl[c] - gmax);
            const float pgroup = 1.0f / gden;
            float el[8];
#pragma unroll
            for (int c = 0; c < 8; ++c) el[c] = fl[4 + gsel * EPG + c] + reb[gsel * EPG + c];
            int i0 = 0; float l0 = el[0];
#pragma unroll
            for (int c = 1; c < 8; ++c) if (el[c] > l0) { l0 = el[c]; i0 = c; }
            int i1 = -1; float l1 = -INFINITY;
#pragma unroll
            for (int c = 0; c < 8; ++c) if (c != i0 && el[c] > l1) { l1 = el[c]; i1 = c; }
            const float e10 = __expf(l1 - l0);
            const float w0 = pgroup / (1.0f + e10), w1 = pgroup * e10 / (1.0f + e10);
            const int e0 = gsel * EPG + i0, e1 = gsel * EPG + i1;
            const unsigned p0 = __hip_atomic_fetch_add(cnt + e0, 1u, RLX_AGENT), p1 = __hip_atomic_fetch_add(cnt + e1, 1u, RLX_AGENT);
            rowidx[e0 * MREAL + p0] = m * 2; rowidx[e1 * MREAL + p1] = m * 2 + 1;
            tokw[m * 2] = w0; tokw[m * 2 + 1] = w1;
        }
    }
}

__device__ __forceinline__ void p8_ln2(Frame& F, const Args& A) {
    const int gw = F.vcu * NWAVES + F.wave, NGW = F.G * NWAVES;
    const bf16* XN = (const bf16*)(F.ws + WS_XN); const bf16* Y = (const bf16*)(F.ws + WS_Y);
    const float* g2 = arg_in(19); const float* b2 = arg_in(20);
    for (int m = gw; m < MREAL; m += NGW) {
        int lane = lane_id();
        const v2u* hp = (const v2u*)(XN + (size_t)m * DM) + lane; const v2u* y0 = (const v2u*)(Y + (size_t)m * DM) + lane; const v2u* y1 = (const v2u*)(Y + (size_t)(MREAL + m) * DM) + lane;
        f32x4 v[8]; float s = 0.f;
#pragma unroll
        for (int j = 0; j < 8; ++j) { const v2u h = hp[64 * j], a = y0[64 * j], c = y1[64 * j];
            v[j] = (f32x4){ALPHA * bf_lo(h.x) + (bf_lo(a.x) + bf_lo(c.x)), ALPHA * bf_hi(h.x) + (bf_hi(a.x) + bf_hi(c.x)), ALPHA * bf_lo(h.y) + (bf_lo(a.y) + bf_lo(c.y)), ALPHA * bf_hi(h.y) + (bf_hi(a.y) + bf_hi(c.y))};
            s += (v[j][0] + v[j][1]) + (v[j][2] + v[j][3]); }
        const float mean = wave_sum(s) * (1.f / DM); float s2 = 0.f;
#pragma unroll
        for (int j = 0; j < 8; ++j) { v[j] = v[j] - mean; s2 += (v[j][0] * v[j][0] + v[j][1] * v[j][1]) + (v[j][2] * v[j][2] + v[j][3] * v[j][3]); }
        const float rstd = 1.f / sqrtf(wave_sum(s2) * (1.f / DM) + LN_EPS);
        f32x4* op = (f32x4*)(F.out + (size_t)m * DM) + lane;
#pragma unroll
        for (int j = 0; j < 8; ++j) { const f32x4 gg = ((const f32x4*)g2)[lane + 64 * j], bb = ((const f32x4*)b2)[lane + 64 * j]; op[64 * j] = v[j] * rstd * gg + bb; }
    }
}

__global__ void __launch_bounds__(NWAVES * 64, 2) mk_fwd(Args args) {
    extern __shared__ __attribute__((aligned(16))) unsigned char lds[];
    Frame F;
    F.lds = (LAS unsigned char*)lds;
    F.MISC = (volatile LAS unsigned*)(F.lds + MISC_OFF);
    F.wave = __builtin_amdgcn_readfirstlane((int)(threadIdx.x >> 6));
    F.G = gridDim.x; { const int bx = blockIdx.x; F.vcu = (F.G % 8 == 0) ? (bx % 8) * (F.G / 8) + bx / 8 : bx; }
    F.ws = args.ws; F.out = args.out;
    F.ctl = (gu32*)(F.ws + WS_CTL);
    for (int u = threadIdx.x; u < (LDS_BYTES - LDSCTL_OFF) / 4; u += NWAVES * 64) ((LAS unsigned*)(F.lds + LDSCTL_OFF))[u] = 0u;
    __syncthreads();
    XcdBarrier bar; bar.bar = (unsigned*)(F.ctl + CW_BAR); bar.x = 0; bar.st = nullptr; bar.wave = F.wave;
    if (N_LAUNCHES == 1) { bar = xcd_barrier_post((unsigned*)(F.ctl + CW_BAR), F.MISC + 8); bar.wave = F.wave; }
#define GRID_BAR() do { if (N_LAUNCHES == 1) xcd_barrier(bar); } while (0)
    const int lo = args.ph_lo, hi = args.ph_hi;
#ifndef MK_DUP
#define MK_DUP 0
#endif
#define REP(k) for (int rep_ = 0; rep_ < 1 + ((MK_DUP >> (k)) & 1); ++rep_)
#ifndef MK_PH_MASK
#define MK_PH_MASK 0x1ff
#endif
#define IN(k) (((MK_PH_MASK >> (k)) & 1) && lo <= (k) && (k) < hi)
    bf16* P = (bf16*)(F.ws + WS_P); bf16* XN = (bf16*)(F.ws + WS_XN);

    if (IN(0)) REP(0) { p0_prologue(F, args); GRID_BAR(); }

    if (IN(1)) REP(1) {
        const int NSPARE = (F.G == 256) ? 24 : 0;
        LAS float* scr = (LAS float*)(F.lds + RING_OFF + F.wave * 16384);
        if ((int)blockIdx.x < F.G - NSPARE) {
            pg8::Gemm g{XN, (const bf16*)(F.ws + WS_WIN), DM, DM, -1};
            DenseOrder S; S.init(F.wave, MREAL / 256, LDP / 256, F.G - NSPARE, (int)blockIdx.x, (long)256 * DM * 2, (long)256 * DM * 2, (PC_GA - PC_K) / 256, PC_K / 256);
            EpiBf16 E{P, LDP};
            pg8::gemm_phase<EpiBf16, DenseOrder, true>(F.lds + RING_OFF, g, S, E);
        }
        conv_queue((unsigned*)(F.ctl + CW_Q), F.ws, scr, lane_id());
        GRID_BAR();
    }
    if (IN(2)) { p2_attention_conv(F, args); GRID_BAR(); }
    if (IN(3)) REP(3) {
        pg8::Gemm g{P, (const bf16*)(F.ws + WS_WB2), LDP, 2 * DM, DM / 64};
        DenseOrder S; S.init(F.wave, MREAL / 256, DM / 256, F.G, (int)blockIdx.x, (long)256 * LDP * 2, (long)256 * 2 * DM * 2);
        EpiGate E{P};
        pg8::gemm_phase<EpiGate, DenseOrder, true>(F.lds + RING_OFF, g, S, E);
        GRID_BAR();
    }
    if (IN(4)) REP(4) {
        pg8::Gemm g{P + PC_CC, (const bf16*)(F.ws + WS_WOUT), LDP, DM, -1};
        DenseOrder S; S.init(F.wave, MREAL / 256, DM / 256, F.G, (int)blockIdx.x, (long)256 * LDP * 2, (long)256 * DM * 2);
        EpiPre E{XN, (float*)(P + PC_GA), LDP / 2};
        pg8::gemm_phase<EpiPre, DenseOrder, true>(F.lds + RING_OFF, g, S, E);
        GRID_BAR();
    }
    if (IN(5)) { p5_ln1_router(F, args); GRID_BAR(); }
    volatile LAS int* tp = (volatile LAS int*)(F.MISC + 32);
    volatile LAS int* cn = (volatile LAS int*)(F.MISC + 72);
    if (IN(6) || IN(7)) {
        if (F.wave == 0 && lane_id() == 0) { int acc = 0; for (int e = 0; e < NEXP; ++e) { const int c = (int)__hip_atomic_load(F.ctl + CW_CNT + e, RLX_AGENT); tp[e] = acc; cn[e] = c; acc += (c + 255) >> 8; } tp[32] = acc; }
        __syncthreads();
    }
    if (IN(6)) REP(6) {
        pg8::Gemm g{XN, (const bf16*)(F.ws + WS_WGU), DM, DM, -1};
        MoeOrder<4, true> S{F.wave, tp, cn, F.G, (int)blockIdx.x, (long)1024 * DM * 2, (long)256 * DM * 2, 0, (const int*)(F.ws + WS_ROWIDX), (unsigned)(DM * 2)};
        EpiAct E{(bf16*)(F.ws + WS_ACT)};
        pg8::gemm_phase<EpiAct, MoeOrder<4, true>, true>(F.lds + RING_OFF, g, S, E);
        GRID_BAR();
    }
    if (IN(7)) REP(7) {
        pg8::Gemm g{(const bf16*)(F.ws + WS_ACT), (const bf16*)(F.ws + WS_WD), DE, DE, -1};
        MoeOrder<8, false> S{F.wave, tp, cn, F.G, (int)blockIdx.x, (long)DM * DE * 2, (long)256 * DE * 2, (long)256 * DE * 2, (const int*)(F.ws + WS_ROWIDX), 0u};
        EpiDown E{(bf16*)(F.ws + WS_Y), (const int*)(F.ws + WS_ROWIDX), (const float*)(F.ws + WS_TOKW)};
        pg8::gemm_phase<EpiDown, MoeOrder<8, false>, true>(F.lds + RING_OFF, g, S, E);
        GRID_BAR();
    }
    if (IN(8)) REP(8) { p8_ln2(F, args); }
#undef IN
#undef GRID_BAR
}

extern "C" void kernel_launch(void* const* d_in, const int* in_sizes, int n_in, void* d_out, int out_size, void* d_ws, size_t ws_size, hipStream_t stream) {
    static int grid = 0;
    if (grid == 0) {
        if (n_in != 21 || in_sizes[0] != MREAL * DM || out_size != MREAL * DM || ws_size < WS_END) { fprintf(stderr, "kernel_launch: unexpected shapes / workspace (n_in %d, ws %zu); nothing launched\n", n_in, ws_size); grid = -1; return; }
        int dev = 0, cus = 0, per_cu = 0;
        if (hipGetDevice(&dev) != hipSuccess || hipDeviceGetAttribute(&cus, hipDeviceAttributeMultiprocessorCount, dev) != hipSuccess) { grid = -1; return; }
        if (hipFuncSetAttribute((const void*)mk_fwd, hipFuncAttributeMaxDynamicSharedMemorySize, LDS_BYTES) != hipSuccess) { fprintf(stderr, "kernel_launch: hipFuncSetAttribute failed\n"); grid = -1; return; }
        if (hipOccupancyMaxActiveBlocksPerMultiprocessor(&per_cu, (const void*)mk_fwd, NWAVES * 64, LDS_BYTES) != hipSuccess || per_cu < 1) { fprintf(stderr, "kernel_launch: occupancy query reports %d\n", per_cu); }
        (void)hipGetLastError();
        grid = cus;
    }
    if (grid < 0) return;
    if (hipMemsetAsync((char*)d_ws + WS_CTL, 0, CTL_ZERO_BYTES, stream) != hipSuccess) return;
    Args a{};
    for (int i = 0; i < 21; ++i) a.in[i] = (const float*)d_in[i];
    a.out = (float*)d_out; a.ws = (unsigned char*)d_ws;
    for (int li = 0; li < N_LAUNCHES; ++li) {
        a.ph_lo = (N_LAUNCHES == 1) ? 0 : li; a.ph_hi = (N_LAUNCHES == 1) ? PER_PHASE : li + 1; a.li = li;
        hipLaunchKernelGGL(mk_fwd, dim3(grid), dim3(NWAVES * 64), LDS_BYTES, stream, a);
    }
}
```

```cpp
#include <hip/hip_runtime.h>
#include <cstdio>
#include <cstdint>

#ifndef MK_SPIN
#define MK_SPIN -1
#endif
#ifndef MK_DUP
#define MK_DUP 0
#endif
#ifndef MK_SEAM23
#define MK_SEAM23 1
#endif
#ifndef MK_SEAM34
#define MK_SEAM34 1
#endif
#ifndef MK_MOE_MERGE
#define MK_MOE_MERGE 1
#endif
#ifndef MK_N_LAUNCHES
#define MK_N_LAUNCHES 1
#endif

__device__ __forceinline__ int lane_id() { int l = (int)__builtin_amdgcn_mbcnt_hi(~0u, __builtin_amdgcn_mbcnt_lo(~0u, 0u)); asm volatile("" : "+v"(l)); return l; }
namespace pg8 {
#define PG8_LAS __attribute__((address_space(3)))
typedef unsigned short bf16_t;
typedef short bf16x8 __attribute__((ext_vector_type(8)));
typedef float f32x4 __attribute__((ext_vector_type(4)));
typedef float f32x2 __attribute__((ext_vector_type(2)));
typedef unsigned u32x4 __attribute__((ext_vector_type(4)));
typedef unsigned u32x2 __attribute__((ext_vector_type(2)));
constexpr int BM = 256, BK = 64, HALF = 128, HTB = HALF * BK * 2  , STAGE_BYTES = 8 * HTB, NXCD = 8, WGM = 8;

__host__ __device__ __forceinline__ int lds_byte(int r, int c) { const int st = (r >> 4) * 2 + (c >> 5), rr = r & 15, cc = c & 31, ob = rr * 64 + cc * 2; return st * 1024 + (ob ^ (((ob >> 9) & 1) << 5)); }
__host__ __device__ __forceinline__ void stage_rc(int b, int& R, int& C) { const int st = b / 1024, sb = b % 1024, swz = sb ^ (((sb >> 9) & 1) << 5); R = (st >> 1) * 16 + swz / 64; C = (st & 1) * 32 + (swz % 64) / 2; }
__host__ __device__ __forceinline__ int perm32(int rho) { const int n = rho >> 4, i = rho & 15; return 8 * (i >> 2) + 4 * n + (i & 3); }

struct Unit { int pm, pn; long a_byte, b_byte; int e, mt, cnt; };
struct Gemm { const bf16_t* A; const bf16_t* Bt; int lda; int K; int tmid; };

__device__ __forceinline__ unsigned cvt_pk_bf16(float lo, float hi) { unsigned r; asm volatile("v_cvt_pk_bf16_f32 %0, %1, %2" : "=v"(r) : "v"(lo), "v"(hi)); return r; }
__device__ __forceinline__ float bf_lo(unsigned u) { return __builtin_bit_cast(float, u << 16); }
__device__ __forceinline__ float bf_hi(unsigned u) { return __builtin_bit_cast(float, u & 0xffff0000u); }

template <class Epi, class Sched, bool ALIGN_EPI>
__device__ __forceinline__ void gemm_phase(PG8_LAS unsigned char* lds, const Gemm g, const Sched& S, const Epi& E) {
    constexpr bool GATHER = Sched::GATHER;
    const int lane = lane_id(), wid = S.wave, tid = wid * 64 + lane, wr = wid >> 2, wc = wid & 3, fr = lane & 15, fq = lane >> 4;
    const int K = g.K, nt = K / BK, lda = g.lda;
    unsigned voffA[2], voffB[2]; int rA[2]; unsigned cA2[2];
#pragma unroll
    for (int i = 0; i < 2; ++i) { int R, C; stage_rc(tid * 16 + i * 8192, R, C); const int Rb = Epi::PERM ? ((R & ~31) + perm32(R & 31)) : R;
        voffA[i] = (unsigned)(R * lda + C) * 2u; voffB[i] = (unsigned)(Rb * K + C) * 2u; rA[i] = R; cA2[i] = (unsigned)C * 2u; }
    const size_t kstep = (size_t)(BK * 2);
    const size_t hstepA = (size_t)HALF * lda * 2, hstepB = (size_t)HALF * K * 2;
    const unsigned ldsw = (unsigned)wid * 1024u;
    const int aoff = lds_byte(wr * 64 + fr, fq * 8), boff = lds_byte(wc * 32 + fr, fq * 8);
#define PG8_SA(b, h) (((b) * 2 + (h)) * HTB)
#define PG8_SB(b, h) ((4 + (b) * 2 + (h)) * HTB)
#define PG8_GLDS(gp, ldsoff) __builtin_amdgcn_global_load_lds((const unsigned*)(gp), (PG8_LAS unsigned*)(lds + (ldsoff)), 16, 0, 0)
#define PG8_STAGE_O(bufoff, gbase, o0, o1) do { PG8_GLDS((const char*)(gbase) + (o0), (bufoff) + ldsw); PG8_GLDS((const char*)(gbase) + (o1), (bufoff) + ldsw + 8192); } while (0)
#define PG8_STB(bufoff, gbase) PG8_STAGE_O(bufoff, gbase, voffB[0], voffB[1])
#define PG8_STA(bufoff, ap, h, V) do { if constexpr (GATHER) PG8_STAGE_O(bufoff, ap, V[h][0], V[h][1]); else PG8_STAGE_O(bufoff, (ap) + (h) * hstepA, voffA[0], voffA[1]); } while (0)
#define PG8_LDA(dst, b, h) do { _Pragma("unroll") for (int m = 0; m < 4; ++m) _Pragma("unroll") for (int k = 0; k < 2; ++k) dst[m][k] = *(const PG8_LAS bf16x8*)(lds + PG8_SA(b, h) + aoff + m * 2048 + k * 1024); } while (0)
#define PG8_LDB(dst, b, h) do { _Pragma("unroll") for (int n = 0; n < 2; ++n) _Pragma("unroll") for (int k = 0; k < 2; ++k) dst[n][k] = *(const PG8_LAS bf16x8*)(lds + PG8_SB(b, h) + boff + n * 2048 + k * 1024); } while (0)
#define PG8_MMA(ai, bj, At, Bt) do { __builtin_amdgcn_s_setprio(1); _Pragma("unroll") for (int m = 0; m < 4; ++m) _Pragma("unroll") for (int n = 0; n < 2; ++n) _Pragma("unroll") for (int k = 0; k < 2; ++k) \
        acc[ai][bj][m][n] = __builtin_amdgcn_mfma_f32_16x16x32_bf16(Bt[n][k], At[m][k], acc[ai][bj][m][n], 0, 0, 0); __builtin_amdgcn_s_setprio(0); } while (0)
#define PG8_WAIT_V(n) asm volatile("s_waitcnt vmcnt(" #n ")" ::: "memory")
#define PG8_WAIT_L(n) asm volatile("s_waitcnt lgkmcnt(" #n ")" ::: "memory")
#define PG8_BAR __builtin_amdgcn_s_barrier()
#define PG8_SCHED __builtin_amdgcn_sched_barrier(0)
    Unit cur, nxt; int ui = 0;
    if (!S.next(0, cur)) return;
    f32x4 acc[2][2][4][2];
#pragma unroll
    for (int a = 0; a < 2; ++a)
#pragma unroll
        for (int b = 0; b < 2; ++b)
#pragma unroll
            for (int m = 0; m < 4; ++m)
#pragma unroll
                for (int n = 0; n < 2; ++n) acc[a][b][m][n] = (f32x4){0.f, 0.f, 0.f, 0.f};
    bf16x8 At[4][2], B0[2][2], B1[2][2];
    unsigned va[2][2], nva[2][2];
    if constexpr (GATHER) {
#pragma unroll
        for (int h = 0; h < 2; ++h)
#pragma unroll
            for (int i = 0; i < 2; ++i) { va[h][i] = S.row_byte(cur, h * HALF + rA[i]) + cA2[i]; nva[h][i] = va[h][i]; }
    } else { va[0][0] = va[0][1] = va[1][0] = va[1][1] = 0u; nva[0][0] = nva[0][1] = nva[1][0] = nva[1][1] = 0u; }
    const char* cA = (const char*)g.A + cur.a_byte; const char* cB = (const char*)g.Bt + cur.b_byte;
    S.a_ready(cur);
    PG8_STB(PG8_SB(0, 0), cB); PG8_STB(PG8_SB(0, 1), cB + hstepB); PG8_STA(PG8_SA(0, 0), cA, 0, va); PG8_STA(PG8_SA(0, 1), cA, 1, va);
    if (wr == 1) PG8_BAR;
    PG8_WAIT_V(2); PG8_BAR;
    PG8_STB(PG8_SB(1, 0), cB + kstep); PG8_STA(PG8_SA(1, 0), cA + kstep, 0, va); PG8_STB(PG8_SB(1, 1), cB + hstepB + kstep);
    PG8_WAIT_V(6); PG8_BAR;
    for (;;) {
        const bool has_next = S.next(ui + 1, nxt);
        const char* nA = has_next ? (const char*)g.A + nxt.a_byte : cA; const char* nB = has_next ? (const char*)g.Bt + nxt.b_byte : cB;
        if constexpr (GATHER) {
            if (has_next) {
#pragma unroll
                for (int h = 0; h < 2; ++h)
#pragma unroll
                    for (int i = 0; i < 2; ++i) nva[h][i] = S.row_byte(nxt, h * HALF + rA[i]) + cA2[i];
            }
            asm volatile("" : "+v"(nva[0][0]), "+v"(nva[0][1]), "+v"(nva[1][0]), "+v"(nva[1][1]));
        }
        for (int t = 0; t < nt; t += 2) {
            const bool last = (t == nt - 2);
            if constexpr (Epi::MID) { if (t == g.tmid) E.mid(acc, cur, wr, wc, fr, fq); }
            if (last && has_next) S.a_ready(nxt);
            const char* a1 = cA + (size_t)(t + 1) * kstep;
            const char* a2 = last ? nA : cA + (size_t)(t + 2) * kstep; const char* b2 = last ? nB : cB + (size_t)(t + 2) * kstep;
            const char* a3 = a2 + kstep; const char* b3 = b2 + kstep;
            unsigned xa[2][2];
#pragma unroll
            for (int h = 0; h < 2; ++h)
#pragma unroll
                for (int i = 0; i < 2; ++i) xa[h][i] = last ? nva[h][i] : va[h][i];
            PG8_LDB(B0, 0, 0); PG8_LDB(B1, 0, 1); PG8_SCHED; PG8_LDA(At, 0, 0); PG8_STA(PG8_SA(1, 1), a1, 1, va);
            PG8_WAIT_V(8); PG8_WAIT_L(0); PG8_BAR; PG8_MMA(0, 0, At, B0); PG8_MMA(0, 1, At, B1); PG8_BAR; PG8_SCHED;
            PG8_LDA(At, 0, 1); PG8_STB(PG8_SB(0, 0), b2); PG8_STB(PG8_SB(0, 1), b2 + hstepB); PG8_STA(PG8_SA(0, 0), a2, 0, xa);
            PG8_WAIT_V(8); PG8_WAIT_L(0); PG8_BAR; PG8_MMA(1, 0, At, B0); PG8_MMA(1, 1, At, B1); PG8_BAR; PG8_SCHED;
            PG8_LDB(B0, 1, 0); PG8_LDB(B1, 1, 1); PG8_SCHED; PG8_LDA(At, 1, 0); PG8_STA(PG8_SA(0, 1), a2, 1, xa);
            PG8_WAIT_V(8); PG8_WAIT_L(0); PG8_BAR; PG8_MMA(0, 0, At, B0); PG8_MMA(0, 1, At, B1); PG8_BAR; PG8_SCHED;
            PG8_LDA(At, 1, 1); PG8_STB(PG8_SB(1, 0), b3); PG8_STB(PG8_SB(1, 1), b3 + hstepB); PG8_STA(PG8_SA(1, 0), a3, 0, xa);
            PG8_WAIT_V(8); PG8_WAIT_L(0); PG8_BAR; PG8_MMA(1, 0, At, B0); PG8_MMA(1, 1, At, B1); PG8_BAR; PG8_SCHED;
        }
        if constexpr (ALIGN_EPI) { if (wr == 0) PG8_BAR; }
        E(acc, cur, wr, wc, fr, fq);
        if (!has_next) break;
#pragma unroll
        for (int a = 0; a < 2; ++a)
#pragma unroll
            for (int b = 0; b < 2; ++b)
#pragma unroll
                for (int m = 0; m < 4; ++m)
#pragma unroll
                    for (int n = 0; n < 2; ++n) acc[a][b][m][n] = (f32x4){0.f, 0.f, 0.f, 0.f};
        cur = nxt; cA = nA; cB = nB; ++ui;
        if constexpr (GATHER) {
#pragma unroll
            for (int h = 0; h < 2; ++h)
#pragma unroll
                for (int i = 0; i < 2; ++i) va[h][i] = nva[h][i];
        }
        if constexpr (ALIGN_EPI) { if (wr == 1) PG8_BAR; }
    }
    PG8_WAIT_V(0);
    if constexpr (!ALIGN_EPI) { if (wr == 0) PG8_BAR; }
    PG8_BAR;
#undef PG8_SA
#undef PG8_SB
#undef PG8_GLDS
#undef PG8_STAGE_O
#undef PG8_STB
#undef PG8_STA
#undef PG8_LDA
#undef PG8_LDB
#undef PG8_MMA
#undef PG8_WAIT_V
#undef PG8_WAIT_L
#undef PG8_BAR
#undef PG8_SCHED
}
}

constexpr int NWAVES = 8;
constexpr int N_LAUNCHES = MK_N_LAUNCHES;
constexpr int PER_PHASE = 9;
constexpr int BATCH = 4, SEQ = 2048, DM = 2048, NMETA = 16;
constexpr int MREAL = BATCH * SEQ;
constexpr int MPAD = MREAL + 256;
constexpr int LDP = 12800;
constexpr int PC_Q = 0, PC_CB = 2048, PC_K = 4096, PC_V = 4352, PC_CC = 4608, PC_CH = 6656, PC_GA = 8704, PC_GC = 10752;
constexpr int NQH = 32, NKVH = 4, HD = 64, WIN = 128;
constexpr int NEXP = 32, NGRP = 4, EPG = 8, DE = 512;
constexpr float LN_EPS = 1e-5f;
constexpr float ALPHA = 1.189207115002721f;
constexpr int MOE_ROWS_MAX = 2 * MREAL + NEXP * 256;

constexpr int CT_IN = 32 * 50, CT_SQ = 32 * 8, CT_GU = 32 * 64, CT_DN = 32 * 64;
constexpr size_t MiB = 1u << 20;
constexpr size_t WS_CTL = 0, CTL_ZERO_BYTES = 131072;
constexpr size_t WS_ROWIDX = 1 * MiB;
constexpr size_t WS_TOKW = 2 * MiB;
constexpr size_t WS_SLOT = 2 * MiB + 128 * 1024;
constexpr size_t WS_REWG = 3 * MiB;
constexpr size_t WS_WIN = 4 * MiB;
constexpr size_t WS_WB2 = 54 * MiB;
constexpr size_t WS_WOUT = 70 * MiB;
constexpr size_t WS_WGU = 78 * MiB;
constexpr size_t WS_WD = 206 * MiB;
constexpr size_t WS_XN = 270 * MiB;
constexpr size_t WS_P = 303 * MiB;
constexpr size_t WS_ACT = WS_P;
constexpr size_t WS_Y = WS_P + 24 * MiB;
constexpr size_t WS_MRG = 512 * MiB;
constexpr size_t WS_END = 544 * MiB;
static_assert(WS_P + (size_t)MPAD * LDP * 2 <= WS_MRG && WS_Y + (size_t)MOE_ROWS_MAX * DM * 2 <= WS_MRG && (size_t)MOE_ROWS_MAX * DE * 2 <= 24 * MiB, "ws map");
constexpr int CW_TMO = 0, CW_CODE = 1;
constexpr int CW_CNT = 256;
constexpr int CW_Q = 64;
constexpr int CW_BAR = 4096;
constexpr int CW_P2 = 16384 + 4096, CW_P3 = 16384, CW_P4 = 16384 + 2048;
constexpr int CW_WD = 192;
constexpr int CW_RDY = 8192;
static_assert((CW_RDY + 64 * 96) * 4 <= 65536 && (CW_P2 + 2048) * 4 <= 131072, "control words inside the memset");

constexpr int RING_OFF = 0, RING_BYTES = 131072;
constexpr int LDSCTL_OFF = RING_BYTES, MISC_OFF = LDSCTL_OFF + 320;
constexpr int LDS_BYTES = 147456;

#define GAS __attribute__((address_space(1)))
#define LAS __attribute__((address_space(3)))
typedef unsigned short bf16;
typedef unsigned v4u __attribute__((ext_vector_type(4)));
typedef unsigned v2u __attribute__((ext_vector_type(2)));
typedef float f32x4 __attribute__((ext_vector_type(4)));
typedef float f32x16 __attribute__((ext_vector_type(16)));
typedef short bf16x8 __attribute__((ext_vector_type(8)));
typedef short s16x4 __attribute__((ext_vector_type(4)));
typedef GAS unsigned gu32;
#define RLX_AGENT __ATOMIC_RELAXED, __HIP_MEMORY_SCOPE_AGENT
#define LDS_WAIT() asm volatile("s_waitcnt lgkmcnt(0)" ::: "memory")
#define VM_WAIT() asm volatile("s_waitcnt vmcnt(0)" ::: "memory")
__device__ __forceinline__ unsigned f2bf(float f) { unsigned u = __builtin_bit_cast(unsigned, f); return (u + 0x7fffu + ((u >> 16) & 1u)) >> 16; }
__device__ __forceinline__ unsigned pk2(float lo, float hi) { return f2bf(lo) | (f2bf(hi) << 16); }
using pg8::bf_lo; using pg8::bf_hi; using pg8::cvt_pk_bf16;

#define XB_TMO      128
#define XB_XCNT(j)  (256  + 64 * (j))
#define XB_XSUB(j)  (1280 + 64 * (j))
#define XB_XGEN(j)  (2304 + 64 * (j))
#define XB_TOP      3328
#define XB_TOPGEN   3392
#define XCD_BAR_WORDS 3456
#define XB_SPIN_CAP (1u << 18)
__device__ __forceinline__ unsigned xb_ld(unsigned* p)              { return __hip_atomic_load(p, __ATOMIC_RELAXED, __HIP_MEMORY_SCOPE_AGENT); }
__device__ __forceinline__ unsigned xb_add(unsigned* p, unsigned v) { return __hip_atomic_fetch_add(p, v, __ATOMIC_RELAXED, __HIP_MEMORY_SCOPE_AGENT); }
__device__ __forceinline__ unsigned xb_xcc_id() { return (unsigned)__builtin_amdgcn_s_getreg((3 << 11) | 20) & 0xFu; }
#define XB_SPIN(cond, bar) do { unsigned _sp = 0; while (cond) { __builtin_amdgcn_s_sleep(1); \
    if ((++_sp & 255u) == 0u) { if (xb_ld(&(bar)[XB_TMO])) break; if (_sp > XB_SPIN_CAP) { atomicAdd(&(bar)[XB_TMO], 1u); break; } } } } while (0)
struct XcdBarrier { unsigned* bar; unsigned x; volatile LAS unsigned* st; int wave; };
__device__ __forceinline__ XcdBarrier xcd_barrier_post(unsigned* bar, volatile LAS unsigned* st) {
    XcdBarrier b; b.bar = bar; b.x = xb_xcc_id(); b.st = st; b.wave = 0;
    if (threadIdx.x == 0) (void)xb_add(&bar[XB_XCNT(b.x)], 1u);
    return b;
}
__device__ __forceinline__ void xcd_barrier_complete(unsigned* bar, unsigned x, unsigned& nloc, unsigned& nx) {
    const unsigned G = gridDim.x * gridDim.y * gridDim.z;
    unsigned sum, cnt, mine, sp = 0u;
    for (;;) {
        sum = 0u; cnt = 0u; mine = 0u;
#pragma unroll
        for (unsigned j = 0; j < 16; ++j) { const unsigned c = xb_ld(&bar[XB_XCNT(j)]); sum += c; cnt += (c > 0u) ? 1u : 0u; mine = (j == x) ? c : mine; }
        if (sum == G) break;
        __builtin_amdgcn_s_sleep(1);
        if ((++sp & 255u) == 0u) { if (xb_ld(&bar[XB_TMO])) break; if (sp > XB_SPIN_CAP) { atomicAdd(&bar[XB_TMO], 1u); break; } }
    }
    nloc = mine > 0u ? mine : 1u; nx = cnt > 0u ? cnt : 1u;
}
__device__ __forceinline__ void xcd_barrier(const XcdBarrier& b) {
    asm volatile("s_waitcnt vmcnt(0)" ::: "memory");
    __syncthreads();
    if (b.wave == 0 && lane_id() == 0) {
        unsigned* bar = b.bar;
        __builtin_amdgcn_s_waitcnt(0);
        unsigned nloc = b.st[0], nx = b.st[1];
        if (nloc == 0u) { xcd_barrier_complete(bar, b.x, nloc, nx); b.st[0] = nloc; b.st[1] = nx; }
        const unsigned old = xb_add(&bar[XB_XSUB(b.x)], 1u);
        const unsigned gen = old / nloc;
        if (old + 1u == (gen + 1u) * nloc) {
            __builtin_amdgcn_fence(__ATOMIC_RELEASE, "agent");
            asm volatile("s_waitcnt vmcnt(0)" ::: "memory");
            const unsigned og = xb_add(&bar[XB_TOP], 1u);
            const unsigned tg = og / nx;
            if (og + 1u == (tg + 1u) * nx) xb_add(&bar[XB_TOPGEN], 1u);
            else XB_SPIN(xb_ld(&bar[XB_TOPGEN]) == tg, bar);
            __builtin_amdgcn_fence(__ATOMIC_ACQUIRE, "agent");
            xb_add(&bar[XB_XGEN(b.x)], 1u);
            asm volatile("s_waitcnt vmcnt(0)" ::: "memory");
        } else {
            XB_SPIN(xb_ld(&bar[XB_XGEN(b.x)]) == gen, bar);
            __builtin_amdgcn_fence(__ATOMIC_ACQUIRE, "agent");
            asm volatile("s_waitcnt vmcnt(0)" ::: "memory");
        }
    }
    __syncthreads();
}

struct Frame {
    LAS unsigned char* lds;
    volatile LAS unsigned* MISC;
    gu32* ctl;
    int wave;
    int vcu, G;
    float* out;
    unsigned char* ws;
};
struct Args { const float* in[21]; float* out; unsigned char* ws; int ph_lo, ph_hi, li, pad; };
__device__ __forceinline__ const float* arg_in(int i) {
    const __attribute__((address_space(4))) char* ka = (const __attribute__((address_space(4))) char*)__builtin_amdgcn_kernarg_segment_ptr();
    unsigned off = (unsigned)i * 8u; asm volatile("" : "+s"(off));
    return *(const float* const __attribute__((address_space(4)))*)(ka + off);
}
__device__ __forceinline__ float wave_sum(float v) {
#pragma unroll
    for (int o = 1; o < 64; o <<= 1) v += __shfl_xor(v, o);
    return v;
}

struct DenseOrder {
    static constexpr bool GATHER = false;
    int nM, nN, nwg, G, c, extra, ex0, wave; long a_tile, b_tile;
    __device__ void init(int wave_, int nM_, int nN_, int G_, int c_, long a_tile_, long b_tile_, int extra_ = 0, int ex0_ = 0) { wave = wave_; nM = nM_; nN = nN_; nwg = nM * nN; G = G_; c = c_; a_tile = a_tile_; b_tile = b_tile_; extra = extra_; ex0 = ex0_; }
    __device__ bool next(int i, pg8::Unit& u) const {
        const long L = (long)i * G + c; if (L >= nwg + extra) return false;
        if (L >= nwg) { u.pm = nM; u.pn = ex0 + (int)(L - nwg); }
        else {
            int wgid = (int)L; { const int q = nwg / pg8::NXCD, r = nwg % pg8::NXCD, xcd = wgid % pg8::NXCD, off = wgid / pg8::NXCD; wgid = (xcd < r ? xcd * (q + 1) : r * (q + 1) + (xcd - r) * q) + off; }
            const int nig = pg8::WGM * nN, gid = wgid / nig, fm = gid * pg8::WGM, gsz = (nM - fm) < pg8::WGM ? (nM - fm) : pg8::WGM;
            u.pm = fm + ((wgid % nig) % gsz); u.pn = (wgid % nig) / gsz;
        }
        u.a_byte = (long)u.pm * a_tile; u.b_byte = (long)u.pn * b_tile; u.e = 0; u.mt = 0; u.cnt = 0; return true;
    }
    __device__ __forceinline__ unsigned row_byte(const pg8::Unit&, int) const { return 0u; }
    __device__ __forceinline__ void a_ready(const pg8::Unit&) const {}
};
__device__ __forceinline__ void wait_count(unsigned* word, unsigned need, unsigned* tmo) {
    unsigned sp = 0;
    while ((unsigned)__builtin_amdgcn_readfirstlane((int)__hip_atomic_load(word, RLX_AGENT)) < need) {
        __builtin_amdgcn_s_sleep(2);
        if (++sp > (1u << 22)) { if (lane_id() == 0) __hip_atomic_store(tmo, 1u, RLX_AGENT); break; }
    }
    __builtin_amdgcn_fence(__ATOMIC_ACQUIRE, "agent");
    asm volatile("s_waitcnt vmcnt(0)" ::: "memory");
}
struct DenseOrderDep : DenseOrder {
    unsigned* rdy; unsigned need; unsigned* tmo;
    __device__ __forceinline__ void a_ready(const pg8::Unit& u) const {
        if (wave == 0) wait_count(rdy + 64 * u.pm, need, tmo);
        asm volatile("" ::: "memory"); __builtin_amdgcn_s_barrier(); asm volatile("" ::: "memory");
    }
};
template <int NT, bool GATH>
struct MoeOrder {
    static constexpr bool GATHER = GATH;
    int wave; volatile LAS int* tp; volatile LAS int* cn; int G, c; long b_exp, b_tile, a_tile; const int* rowidx; unsigned row_bytes;
    __device__ bool next(int i, pg8::Unit& u) const {
        const int total = __builtin_amdgcn_readfirstlane(tp[32]) * NT;
        const long L = (long)i * G + c; if (L >= total) return false;
        const int T = (int)(L / NT), n = (int)(L % NT);
        int e = 0;
        for (int j = 1; j < 32; ++j) e += (__builtin_amdgcn_readfirstlane(tp[j]) <= T) ? 1 : 0;
        u.e = e; u.mt = T - __builtin_amdgcn_readfirstlane(tp[e]); u.cnt = __builtin_amdgcn_readfirstlane(cn[e]); u.pm = T; u.pn = n;
        u.a_byte = GATH ? 0 : (long)T * a_tile; u.b_byte = (long)e * b_exp + (long)n * b_tile; return true;
    }
    __device__ __forceinline__ unsigned row_byte(const pg8::Unit& u, int r) const {
        const int pos = u.mt * 256 + r;
        int tk = 0; if (pos < u.cnt) tk = rowidx[u.e * MREAL + pos];
        return (unsigned)(tk >> 1) * row_bytes;
    }
    __device__ __forceinline__ void a_ready(const pg8::Unit&) const {}
};
struct MoeDownOrder {
    static constexpr bool GATHER = false;
    int wave; volatile LAS int* tp; volatile LAS int* cn; int G, c; long b_exp, b_tile, a_tile; unsigned* rdy; unsigned* wd; unsigned* tmo;
    __device__ bool next(int i, pg8::Unit& u) const {
        const int T = __builtin_amdgcn_readfirstlane(tp[32]);
        const int T1 = T < G / 4 ? T : G / 4, nb2 = 4 * T > G ? 4 * T - G : 0;
        int Tt, n;
        if (c >= nb2) { const int j = (c - nb2) + i * (G - nb2); if (j >= 8 * T1) return false; Tt = j >> 3; n = j & 7; }
        else { const int j = c + i * nb2; if (j >= 8 * (T - T1)) return false; Tt = T1 + (j >> 3); n = j & 7; }
        int e = 0;
        for (int j = 1; j < 32; ++j) e += (__builtin_amdgcn_readfirstlane(tp[j]) <= Tt) ? 1 : 0;
        u.e = e; u.mt = Tt - __builtin_amdgcn_readfirstlane(tp[e]); u.cnt = __builtin_amdgcn_readfirstlane(cn[e]); u.pm = Tt; u.pn = n;
        u.a_byte = (long)Tt * a_tile; u.b_byte = (long)e * b_exp + (long)n * b_tile; return true;
    }
    __device__ __forceinline__ unsigned row_byte(const pg8::Unit&, int) const { return 0u; }
    __device__ __forceinline__ void a_ready(const pg8::Unit& u) const {
        if (wave == 0) {
            unsigned sp = 0;
            while ((unsigned)__builtin_amdgcn_readfirstlane((int)__hip_atomic_load(rdy + 64 * u.pm, RLX_AGENT)) < 32u ||
                   (unsigned)__builtin_amdgcn_readfirstlane((int)__hip_atomic_load(wd, RLX_AGENT)) < (unsigned)CT_DN) {
                __builtin_amdgcn_s_sleep(2);
                if (++sp > (1u << 22)) { if (lane_id() == 0) __hip_atomic_store(tmo, 1u, RLX_AGENT); break; }
            }
            __builtin_amdgcn_fence(__ATOMIC_ACQUIRE, "agent");
            asm volatile("s_waitcnt vmcnt(0)" ::: "memory");
        }
        asm volatile("" ::: "memory"); __builtin_amdgcn_s_barrier(); asm volatile("" ::: "memory");
    }
};

__device__ __forceinline__ void st16_wt(void* p, v4u v) { asm volatile("global_store_dwordx4 %0, %1, off sc1\n\ts_nop 1" :: "v"(p), "v"(v) : "memory"); }
using pg8::Unit; using pg8::HALF; using pg8::BM;
struct EpiBf16 {
    static constexpr bool PERM = true, MID = false;
    bf16* O; int ldc; int pp_lo, pp_hi, pp_col, sg_lo;
    __device__ __forceinline__ void mid(f32x4 (&)[2][2][4][2], const Unit&, int, int, int, int) const {}
    __device__ __forceinline__ void operator()(const f32x4 (&acc)[2][2][4][2], const Unit& u, int wr, int wc, int fr, int fq) const {
        const int row0 = u.pm * BM + wr * 64 + fr, col0 = u.pn * BM + wc * 32 + 8 * fq;
        if (pp_lo <= u.pn && u.pn < pp_hi) {
            const int pc = pp_col + (u.pn - pp_lo) * HALF + wc * 32 + 8 * fq;
#pragma unroll
            for (int ai = 0; ai < 2; ++ai)
#pragma unroll
                for (int m = 0; m < 4; ++m) { bf16* rowp = O + (size_t)(row0 + ai * HALF + m * 16) * ldc + pc;
                    const f32x4 v0 = acc[ai][0][m][0] * acc[ai][1][m][0], v1 = acc[ai][0][m][1] * acc[ai][1][m][1];
                    v4u w; w.x = cvt_pk_bf16(v0[0], v0[1]); w.y = cvt_pk_bf16(v0[2], v0[3]); w.z = cvt_pk_bf16(v1[0], v1[1]); w.w = cvt_pk_bf16(v1[2], v1[3]);
                    *(v4u*)rowp = w; }
            return;
        }
        const bool sg = u.pn >= sg_lo;
#pragma unroll
        for (int ai = 0; ai < 2; ++ai)
#pragma unroll
            for (int m = 0; m < 4; ++m) { bf16* rowp = O + (size_t)(row0 + ai * HALF + m * 16) * ldc + col0;
#pragma unroll
                for (int bj = 0; bj < 2; ++bj) { f32x4 v0 = acc[ai][bj][m][0], v1 = acc[ai][bj][m][1];
                    if (sg) {
#pragma unroll
                        for (int j = 0; j < 4; ++j) { v0[j] = __builtin_amdgcn_rcpf(1.0f + __expf(-v0[j])); v1[j] = __builtin_amdgcn_rcpf(1.0f + __expf(-v1[j])); } }
                    v4u w; w.x = cvt_pk_bf16(v0[0], v0[1]); w.y = cvt_pk_bf16(v0[2], v0[3]); w.z = cvt_pk_bf16(v1[0], v1[1]); w.w = cvt_pk_bf16(v1[2], v1[3]);
                    *(v4u*)(rowp + bj * HALF) = w; } }
    }
};
__device__ __forceinline__ float sigm(float x) { return __builtin_amdgcn_rcpf(1.0f + __expf(-x)); }
struct EpiGate {
    static constexpr bool PERM = true, MID = true;
    bf16* P; bf16* MRG; unsigned* rdy;
    __device__ __forceinline__ void mid(f32x4 (&acc)[2][2][4][2], const Unit& u, int wr, int wc, int fr, int fq) const {
        int row0 = u.pm * BM + wr * 64 + fr, col0 = u.pn * BM + wc * 32 + 8 * fq;
        asm volatile("" : "+v"(row0), "+v"(col0));
#pragma unroll
        for (int ai = 0; ai < 2; ++ai)
#pragma unroll
            for (int m = 0; m < 4; ++m) { const bf16* rowp = P + (size_t)(row0 + ai * HALF + m * 16) * LDP + col0;
#pragma unroll
                for (int bj = 0; bj < 2; ++bj) { const v4u a = *(const v4u*)(rowp + PC_GA + bj * HALF), c = *(const v4u*)(rowp + PC_GC + bj * HALF);
                    const unsigned aw[4] = {a.x, a.y, a.z, a.w}, cw[4] = {c.x, c.y, c.z, c.w};
#pragma unroll
                    for (int q = 0; q < 4; ++q) {
                        const float r0 = bf_lo(aw[q]) * __builtin_amdgcn_rcpf(bf_lo(cw[q]));
                        const float r1 = bf_hi(aw[q]) * __builtin_amdgcn_rcpf(bf_hi(cw[q]));
                        acc[ai][bj][m][q >> 1][(q & 1) * 2] *= r0; acc[ai][bj][m][q >> 1][(q & 1) * 2 + 1] *= r1; } }
                asm volatile("" ::: "memory"); }
    }
    __device__ __forceinline__ void operator()(const f32x4 (&acc)[2][2][4][2], const Unit& u, int wr, int wc, int fr, int fq) const {
        const int row0 = u.pm * BM + wr * 64 + fr, col0 = u.pn * BM + wc * 32 + 8 * fq;
#pragma unroll
        for (int ai = 0; ai < 2; ++ai)
#pragma unroll
            for (int m = 0; m < 4; ++m) { bf16* rowp = P + (size_t)(row0 + ai * HALF + m * 16) * LDP + col0;
#pragma unroll
                for (int bj = 0; bj < 2; ++bj) { const v4u c = *(const v4u*)(rowp + PC_GC + bj * HALF); const unsigned cw[4] = {c.x, c.y, c.z, c.w};
                    const f32x4 v0 = acc[ai][bj][m][0], v1 = acc[ai][bj][m][1];
                    v4u w;
                    w.x = cvt_pk_bf16(v0[0] * bf_lo(cw[0]), v0[1] * bf_hi(cw[0])); w.y = cvt_pk_bf16(v0[2] * bf_lo(cw[1]), v0[3] * bf_hi(cw[1]));
                    w.z = cvt_pk_bf16(v1[0] * bf_lo(cw[2]), v1[1] * bf_hi(cw[2])); w.w = cvt_pk_bf16(v1[2] * bf_lo(cw[3]), v1[3] * bf_hi(cw[3]));
                    bf16* mp = MRG + (size_t)(row0 + ai * HALF + m * 16) * DM + col0 + bj * HALF;
                    if (rdy) st16_wt(mp, w); else *(v4u*)mp = w; }
                asm volatile("" ::: "memory"); }
        if (rdy) { asm volatile("s_waitcnt vmcnt(0)" ::: "memory"); if (fr == 0 && fq == 0) __hip_atomic_fetch_add(rdy + 64 * u.pm, 1u, RLX_AGENT); }
    }
};
struct EpiPre {
    static constexpr bool PERM = true, MID = false;
    const bf16* XN; bf16* pre; int ldo; unsigned* rdy;
    __device__ __forceinline__ void mid(f32x4 (&)[2][2][4][2], const Unit&, int, int, int, int) const {}
    __device__ __forceinline__ void operator()(const f32x4 (&acc)[2][2][4][2], const Unit& u, int wr, int wc, int fr, int fq) const {
        const int row0 = u.pm * BM + wr * 64 + fr, col0 = u.pn * BM + wc * 32 + 8 * fq;
#pragma unroll
        for (int ai = 0; ai < 2; ++ai)
#pragma unroll
            for (int m = 0; m < 4; ++m) { const int r = row0 + ai * HALF + m * 16; const bf16* xr = XN + (size_t)r * DM + col0; bf16* orow = pre + (size_t)r * ldo + col0;
#pragma unroll
                for (int bj = 0; bj < 2; ++bj) { const v4u h = *(const v4u*)(xr + bj * HALF); const f32x4 a0 = acc[ai][bj][m][0], a1 = acc[ai][bj][m][1];
                    v4u o; o.x = cvt_pk_bf16(ALPHA * bf_lo(h.x) + a0[0], ALPHA * bf_hi(h.x) + a0[1]); o.y = cvt_pk_bf16(ALPHA * bf_lo(h.y) + a0[2], ALPHA * bf_hi(h.y) + a0[3]);
                    o.z = cvt_pk_bf16(ALPHA * bf_lo(h.z) + a1[0], ALPHA * bf_hi(h.z) + a1[1]); o.w = cvt_pk_bf16(ALPHA * bf_lo(h.w) + a1[2], ALPHA * bf_hi(h.w) + a1[3]);
                    if (rdy) st16_wt(orow + bj * HALF, o); else *(v4u*)(orow + bj * HALF) = o; } }
        if (rdy) { asm volatile("s_waitcnt vmcnt(0)" ::: "memory"); if (fr == 0 && fq == 0) __hip_atomic_fetch_add(rdy + 64 * u.pm, 1u, RLX_AGENT); }
    }
};
struct EpiAct {
    static constexpr bool PERM = true, MID = false;
    bf16* act; unsigned* rdy;
    __device__ __forceinline__ void mid(f32x4 (&)[2][2][4][2], const Unit&, int, int, int, int) const {}
    __device__ __forceinline__ void operator()(const f32x4 (&acc)[2][2][4][2], const Unit& u, int wr, int wc, int fr, int fq) const {
        const int row0 = u.pm * BM + wr * 64 + fr, col0 = u.pn * HALF + wc * 32 + 8 * fq;
#pragma unroll
        for (int ai = 0; ai < 2; ++ai)
#pragma unroll
            for (int m = 0; m < 4; ++m) { bf16* rowp = act + (size_t)(row0 + ai * HALF + m * 16) * DE + col0;
                float o[8];
#pragma unroll
                for (int n = 0; n < 2; ++n)
#pragma unroll
                    for (int j = 0; j < 4; ++j) { const float gt = acc[ai][0][m][n][j], up = acc[ai][1][m][n][j]; o[n * 4 + j] = gt * sigm(gt) * up; }
                v4u w; w.x = cvt_pk_bf16(o[0], o[1]); w.y = cvt_pk_bf16(o[2], o[3]); w.z = cvt_pk_bf16(o[4], o[5]); w.w = cvt_pk_bf16(o[6], o[7]);
                if (MK_MOE_MERGE && N_LAUNCHES == 1) st16_wt(rowp, w); else *(v4u*)rowp = w; }
        if (MK_MOE_MERGE && N_LAUNCHES == 1) {
            asm volatile("s_waitcnt vmcnt(0)" ::: "memory");
            if (fr == 0 && fq == 0) __hip_atomic_fetch_add(rdy + 64 * u.pm, 1u, RLX_AGENT);
        }
    }
};
struct EpiDown {
    static constexpr bool PERM = true, MID = false;
    bf16* Y;
    __device__ __forceinline__ void mid(f32x4 (&)[2][2][4][2], const Unit&, int, int, int, int) const {}
    __device__ __forceinline__ void operator()(const f32x4 (&acc)[2][2][4][2], const Unit& u, int wr, int wc, int fr, int fq) const {
        const int row0 = u.pm * BM + wr * 64 + fr, col0 = u.pn * BM + wc * 32 + 8 * fq;
#pragma unroll
        for (int ai = 0; ai < 2; ++ai)
#pragma unroll
            for (int m = 0; m < 4; ++m) { bf16* rowp = Y + (size_t)(row0 + ai * HALF + m * 16) * DM + col0;
#pragma unroll
                for (int bj = 0; bj < 2; ++bj) { const f32x4 v0 = acc[ai][bj][m][0], v1 = acc[ai][bj][m][1];
                    v4u o; o.x = cvt_pk_bf16(v0[0], v0[1]); o.y = cvt_pk_bf16(v0[2], v0[3]); o.z = cvt_pk_bf16(v1[0], v1[1]); o.w = cvt_pk_bf16(v1[2], v1[3]);
                    *(v4u*)(rowp + bj * HALF) = o; } }
    }
};

struct ConvTile { const float* src; bf16* dst0; bf16* dst1; int ld_src, ld_dst; };
constexpr int CT_A = CT_IN;
constexpr int CT_B = 3 * CT_SQ + 2 * CT_GU + CT_DN;
constexpr int CT_PITCH = 144, CT_BUF = 256 * CT_PITCH;
__device__ __forceinline__ ConvTile conv_tile_a(int r, unsigned char* ws) {
    const int nt = r >> 5, kg = r & 31, ns = nt * 256, k0 = 64 * kg;
    int nn = ns; if (ns >= 2048 && ns < 2560) nn = ns + 2048; else if (ns >= 2560 && ns < 4608) nn = ns - 512;
    bf16* d = (bf16*)(ws + WS_WIN) + (size_t)nn * DM + k0; bf16* d1 = d + (size_t)128 * DM;
    if (ns >= PC_CC && ns < PC_GA) {
        const int ch = ns >= PC_CH ? 1 : 0, sidx = (ns - (ch ? PC_CH : PC_CC)) >> 8;
        d = (bf16*)(ws + WS_WIN) + (size_t)(256 * (18 + 2 * sidx) + 128 * ch) * DM + k0; d1 = d + (size_t)256 * DM; }
    return ConvTile{arg_in(4) + (size_t)k0 * LDP + ns, d, d1, LDP, DM};
}
__device__ __forceinline__ ConvTile conv_tile_b(int r, unsigned char* ws) {
    bf16* Wb2_t = (bf16*)(ws + WS_WB2); bf16* Wout_t = (bf16*)(ws + WS_WOUT); bf16* Wgu_t = (bf16*)(ws + WS_WGU); bf16* Wd_t = (bf16*)(ws + WS_WD);
    if (r < 2 * CT_SQ) { const int cv = r >= CT_SQ ? 1 : 0; r -= cv * CT_SQ; const int nt = r >> 5, k0 = 64 * (r & 31), n = nt * 256;
        bf16* d = Wb2_t + (size_t)n * 4096 + cv * 2048 + k0; return ConvTile{arg_in(7 + cv) + (size_t)k0 * DM + n, d, d + (size_t)128 * 4096, DM, 4096}; }
    r -= 2 * CT_SQ;
    if (r < CT_SQ) { const int nt = r >> 5, k0 = 64 * (r & 31), n = nt * 256; bf16* d = Wout_t + (size_t)n * DM + k0; return ConvTile{arg_in(9) + (size_t)k0 * DM + n, d, d + (size_t)128 * DM, DM, DM}; }
    r -= CT_SQ;
    if (r < 2 * CT_GU) { const int up = r >= CT_GU ? 1 : 0; r -= up * CT_GU; const int e = r >> 6, q = r & 63, nt = q >> 5, k0 = 64 * (q & 31), n = nt * 256;
        bf16* d = Wgu_t + ((size_t)e * 1024 + (size_t)(n >> 7) * 256 + up * 128) * DM + k0;
        return ConvTile{arg_in(16 + up) + (size_t)e * DM * DE + (size_t)k0 * DE + n, d, d + (size_t)256 * DM, DE, DM}; }
    r -= 2 * CT_GU;
    { const int e = r >> 6, q = r & 63, nt = q >> 3, k0 = 64 * (q & 7), n = nt * 256;
      bf16* d = Wd_t + ((size_t)e * DM + n) * DE + k0; return ConvTile{arg_in(18) + (size_t)e * DE * DM + (size_t)k0 * DM + n, d, d + (size_t)128 * DE, DM, DE}; }
}
struct ConvRegs { f32x4 v[8]; };
__device__ __forceinline__ void conv_load(ConvRegs& R, const ConvTile& t, int w, int lane) {
    const float* p = t.src + (size_t)(8 * w) * t.ld_src + 4 * lane;
#pragma unroll
    for (int i = 0; i < 8; ++i) R.v[i] = __builtin_nontemporal_load((const f32x4*)(p + (size_t)i * t.ld_src));
}
__device__ __forceinline__ void conv_lds_write(const ConvRegs& R, LAS unsigned char* buf, int w, int lane) {
#pragma unroll
    for (int j = 0; j < 4; ++j) { v4u o; o.x = cvt_pk_bf16(R.v[0][j], R.v[1][j]); o.y = cvt_pk_bf16(R.v[2][j], R.v[3][j]); o.z = cvt_pk_bf16(R.v[4][j], R.v[5][j]); o.w = cvt_pk_bf16(R.v[6][j], R.v[7][j]);
        *(LAS v4u*)(buf + (4 * lane + j) * CT_PITCH + 16 * w) = o; }
}
template <bool WT>
__device__ __forceinline__ void conv_store(const ConvTile& t, LAS const unsigned char* buf, int w, int lane) {
    const int c = lane & 7, nr = 8 * w + (lane >> 3);
#pragma unroll
    for (int p = 0; p < 4; ++p) { const int n = nr + 64 * p; const v4u o = *(LAS const v4u*)(buf + n * CT_PITCH + 16 * c);
        bf16* d = (p < 2 ? t.dst0 + (size_t)n * t.ld_dst : t.dst1 + (size_t)(n - 128) * t.ld_dst) + 8 * c;
        if (WT) st16_wt(d, o); else *(GAS v4u*)d = o; }
}
template <int LIST, bool WT = false>
__device__ __forceinline__ void conv_run(int first, int last, int stride, unsigned char* ws, LAS unsigned char* lds, int w, int lane, int& par) {
    if (first >= last) return;
    ConvTile t0 = LIST ? conv_tile_b(first, ws) : conv_tile_a(first, ws), t1 = t0;
    ConvRegs r0, r1;
    conv_load(r0, t0, w, lane);
    r1 = r0;
    for (int it = first; it < last; it += stride) {
        const int nx = it + stride;
        if (nx < last) { t1 = LIST ? conv_tile_b(nx, ws) : conv_tile_a(nx, ws); conv_load(r1, t1, w, lane); }
        LAS unsigned char* buf = lds + par * CT_BUF; par ^= 1;
        conv_lds_write(r0, buf, w, lane);
        __syncthreads();
        conv_store<WT>(t0, buf, w, lane);
        r0 = r1; t0 = t1;
    }
}
constexpr int CT_CHUNK = 4;
constexpr int CT_B1 = 3 * CT_SQ + 2 * CT_GU;
template <bool WT = false>
__device__ __forceinline__ void conv_queue(unsigned* qhead, int lo, int hi, unsigned char* ws, LAS unsigned char* lds, volatile LAS unsigned* slot, int w, int lane, unsigned* done = nullptr) {
    int par = 0;
    for (;;) {
        __syncthreads();
        if (w == 0 && lane == 0) slot[0] = __hip_atomic_fetch_add(qhead, (unsigned)CT_CHUNK, RLX_AGENT);
        __syncthreads();
        const int base = lo + __builtin_amdgcn_readfirstlane((int)slot[0]);
        if (base >= hi) break;
        const int end = base + CT_CHUNK < hi ? base + CT_CHUNK : hi;
        conv_run<1, WT>(base, end, 1, ws, lds, w, lane, par);
        if (WT) {
            asm volatile("s_waitcnt vmcnt(0)" ::: "memory");
            __syncthreads();
            if (w == 0 && lane == 0) __hip_atomic_fetch_add(done, (unsigned)(end - base), RLX_AGENT);
        }
    }
}
__device__ __forceinline__ void ln_regs_to_bf16(f32x4 (&v)[8], const float* g, const float* b, bf16* orow, int lane) {
    asm volatile("" : "+v"(lane));
    float s = 0.f;
#pragma unroll
    for (int j = 0; j < 8; ++j) s += (v[j][0] + v[j][1]) + (v[j][2] + v[j][3]);
    const float mean = wave_sum(s) * (1.f / DM); float s2 = 0.f;
#pragma unroll
    for (int j = 0; j < 8; ++j) { v[j] = v[j] - mean; s2 += (v[j][0] * v[j][0] + v[j][1] * v[j][1]) + (v[j][2] * v[j][2] + v[j][3] * v[j][3]); }
    const float rstd = 1.f / sqrtf(wave_sum(s2) * (1.f / DM) + LN_EPS);
    v2u* o8 = (v2u*)orow + lane;
#pragma unroll
    for (int j = 0; j < 8; ++j) { const f32x4 gg = ((const f32x4*)g)[lane + 64 * j], bb = ((const f32x4*)b)[lane + 64 * j]; const f32x4 y = v[j] * rstd * gg + bb;
        v2u w; w.x = pk2(y[0], y[1]); w.y = pk2(y[2], y[3]); o8[64 * j] = w; }
}
__device__ __forceinline__ void ln_row_to_bf16(const float* xrow, const float* g, const float* b, bf16* orow, int lane) {
    asm volatile("" : "+v"(lane));
    const f32x4* xr = (const f32x4*)xrow + lane;
    f32x4 v[8]; float s = 0.f;
#pragma unroll
    for (int j = 0; j < 8; ++j) { v[j] = xr[64 * j]; s += (v[j][0] + v[j][1]) + (v[j][2] + v[j][3]); }
    const float mean = wave_sum(s) * (1.f / DM); float s2 = 0.f;
#pragma unroll
    for (int j = 0; j < 8; ++j) { v[j] = v[j] - mean; s2 += (v[j][0] * v[j][0] + v[j][1] * v[j][1]) + (v[j][2] * v[j][2] + v[j][3] * v[j][3]); }
    const float rstd = 1.f / sqrtf(wave_sum(s2) * (1.f / DM) + LN_EPS);
    v2u* o8 = (v2u*)orow + lane;
#pragma unroll
    for (int j = 0; j < 8; ++j) { const f32x4 gg = ((const f32x4*)g)[lane + 64 * j], bb = ((const f32x4*)b)[lane + 64 * j]; const f32x4 y = v[j] * rstd * gg + bb;
        v2u w; w.x = pk2(y[0], y[1]); w.y = pk2(y[2], y[3]); o8[64 * j] = w; }
}
__device__ __forceinline__ void p0_prologue(Frame& F, const Args& A) {
    const int lane0 = lane_id(), tid0 = F.wave * 64 + lane0;
    const int gw = F.vcu * NWAVES + F.wave, NGW = F.G * NWAVES;
    bf16* XN = (bf16*)(F.ws + WS_XN);
    { int par = 0; conv_run<0>((int)blockIdx.x, CT_A, F.G, F.ws, F.lds + RING_OFF, F.wave, lane0, par); __syncthreads(); }
    { bf16* whi = (bf16*)(F.ws + WS_REWG); bf16* wlo = whi + 48 * DM; const float* rgw = arg_in(12); const float* rew = arg_in(14);
      for (int i = (F.vcu * NWAVES * 64) + tid0; i < 48 * DM; i += F.G * NWAVES * 64) { const int n = i / DM, k = i % DM;
          const float w = n < NGRP ? rgw[k * NGRP + n] : (n < NGRP + NEXP ? rew[k * NEXP + (n - NGRP)] : 0.f);
          const unsigned hi = f2bf(w); const float rem = w - __builtin_bit_cast(float, hi << 16);
          whi[i] = (bf16)hi; wlo[i] = (bf16)f2bf(rem); } }
    {
        const float* xin = arg_in(0); const float* g = arg_in(2); const float* b = arg_in(3);
        f32x4 va[8], vb[8];
        int m = gw;
        if (m < MREAL) {
#pragma unroll
            for (int j = 0; j < 8; ++j) va[j] = ((const f32x4*)(xin + (size_t)m * DM))[lane0 + 64 * j];
        }
        for (; m < MREAL; m += 2 * NGW) {
            const int m1 = m + NGW, m2 = m + 2 * NGW;
            if (m1 < MREAL) {
#pragma unroll
                for (int j = 0; j < 8; ++j) vb[j] = ((const f32x4*)(xin + (size_t)m1 * DM))[lane0 + 64 * j];
            }
            ln_regs_to_bf16(va, g, b, XN + (size_t)m * DM, lane0);
            if (m2 < MREAL) {
#pragma unroll
                for (int j = 0; j < 8; ++j) va[j] = ((const f32x4*)(xin + (size_t)m2 * DM))[lane0 + 64 * j];
            }
            if (m1 < MREAL) ln_regs_to_bf16(vb, g, b, XN + (size_t)m1 * DM, lane0);
        }
    }
    for (int m = MREAL + gw; m < MPAD; m += NGW) {
        if (m < MREAL + NMETA) ln_row_to_bf16(arg_in(1) + (size_t)(m - MREAL) * DM, arg_in(2), arg_in(3), XN + (size_t)m * DM, lane0);
        else { v2u* o8 = (v2u*)(XN + (size_t)m * DM) + lane0;
#pragma unroll
            for (int j = 0; j < 8; ++j) o8[64 * j] = (v2u){0u, 0u}; }
    }
}

constexpr int KS_PITCH = 144;
constexpr int VT_PITCH = 584;
constexpr int KROWS = 288;
constexpr int ATT_KS = 0, ATT_VT = KROWS * KS_PITCH, ATT_LDS = ATT_VT + 64 * VT_PITCH;
static_assert(ATT_LDS <= RING_BYTES, "attention LDS");
constexpr float LOG2E = 1.4426950408889634f;

template <int R>
__device__ __forceinline__ void attn_qblock(LAS const unsigned char* lds, bf16* P, int qrow0, int head, float sink_l2, bool has_prev, int lane) {
    asm volatile("" : "+v"(lane));
    const int ql = lane & 31, hh = lane >> 5;
    bf16* qp = P + (size_t)(qrow0 + 32 * R + ql) * LDP + PC_Q + head * HD;
    bf16x8 qf[4];
#pragma unroll
    for (int s = 0; s < 4; ++s) qf[s] = *(const bf16x8*)(qp + 16 * s + 8 * hh);
    f32x16 S[6];
#define KB_ROW(i) ((i) == 0 ? 0 : ((i) <= 4 - R ? 32 + 32 * (R + (i) - 1) : 160 + 32 * ((i) - (5 - R))))
#pragma unroll
    for (int i = 0; i < 6; ++i) {
        const int kr = KB_ROW(i);
        f32x16 a = {0.f, 0.f, 0.f, 0.f, 0.f, 0.f, 0.f, 0.f, 0.f, 0.f, 0.f, 0.f, 0.f, 0.f, 0.f, 0.f};
        const LAS unsigned char* kp = lds + ATT_KS + (kr + ql) * KS_PITCH + 16 * hh;
#pragma unroll
        for (int s = 0; s < 4; ++s) { const bf16x8 kf = *(const LAS bf16x8*)(kp + 32 * s); a = __builtin_amdgcn_mfma_f32_32x32x16_bf16(kf, qf[s], a, 0, 0, 0); }
        S[i] = a;
    }
    const float NEG = -INFINITY; const float sc = 0.125f * LOG2E;
    float mx = sink_l2;
#pragma unroll
    for (int i = 0; i < 6; ++i)
#pragma unroll
        for (int r = 0; r < 16; ++r) {
            const int kvl = (r & 3) + 8 * (r >> 2) + 4 * hh;
            float t = S[i][r] * sc;
            bool ok = true;
            if (i == 0) ok = kvl < NMETA;
            else if (i <= 4 - R) { ok = has_prev; if (i == 1) ok = ok && (kvl > ql); }
            else { if (i == 5) ok = (kvl <= ql); }
            t = ok ? t : NEG; S[i][r] = t; mx = fmaxf(mx, t);
        }
    mx = fmaxf(mx, __shfl_xor(mx, 32));
    float l = 0.f;
#pragma unroll
    for (int i = 0; i < 6; ++i)
#pragma unroll
        for (int r = 0; r < 16; ++r) { const float p = __builtin_amdgcn_exp2f(S[i][r] - mx); S[i][r] = p; l += p; }
    l += __shfl_xor(l, 32);
    l += __builtin_amdgcn_exp2f(sink_l2 - mx);
    const float inv = 1.0f / l;
    f32x16 O[2];
#pragma unroll
    for (int d = 0; d < 2; ++d) O[d] = (f32x16){0.f, 0.f, 0.f, 0.f, 0.f, 0.f, 0.f, 0.f, 0.f, 0.f, 0.f, 0.f, 0.f, 0.f, 0.f, 0.f};
#pragma unroll
    for (int i = 0; i < 6; ++i) {
        const int kr = KB_ROW(i);
#pragma unroll
        for (int s2 = 0; s2 < 2; ++s2) {
            unsigned pw[4];
#pragma unroll
            for (int j = 0; j < 4; ++j) pw[j] = cvt_pk_bf16(S[i][8 * s2 + 2 * j] * inv, S[i][8 * s2 + 2 * j + 1] * inv);
            const v4u pv = {pw[0], pw[1], pw[2], pw[3]};
            const bf16x8 pf = __builtin_bit_cast(bf16x8, pv);
#pragma unroll
            for (int d = 0; d < 2; ++d) {
                const LAS unsigned char* vp = lds + ATT_VT + (ql + 32 * d) * VT_PITCH + (kr + 16 * s2 + 4 * hh) * 2;
                const v2u lo = *(const LAS v2u*)vp, hi = *(const LAS v2u*)(vp + 16);
                const v4u vv = {lo.x, lo.y, hi.x, hi.y};
                O[d] = __builtin_amdgcn_mfma_f32_32x32x16_bf16(pf, __builtin_bit_cast(bf16x8, vv), O[d], 0, 0, 0);
            }
        }
    }
#undef KB_ROW
#pragma unroll
    for (int d = 0; d < 2; ++d)
#pragma unroll
        for (int r = 0; r < 16; ++r) { const int q = (r & 3) + 8 * (r >> 2) + 4 * hh;
            P[(size_t)(qrow0 + 32 * R + q) * LDP + PC_Q + head * HD + 32 * d + ql] = (bf16)f2bf(O[d][r]); }
}

__device__ __forceinline__ f32x4 conv_p(v2u a) { return (f32x4){bf_lo(a.x), bf_hi(a.x), bf_lo(a.y), bf_hi(a.y)}; }
__device__ __forceinline__ void p2_attention_conv(Frame& F, const Args& A) {
    bf16* P = (bf16*)(F.ws + WS_P);
    const float* sinks = arg_in(5);
    const float* cw = arg_in(6);
    const int lane0 = lane_id(), tid0 = F.wave * 64 + lane0;
    const int c0 = 4 * tid0;
    for (int it = blockIdx.x; it < BATCH * NKVH * (SEQ / WIN); it += F.G) {
        const int b = it / (NKVH * 16), kvh = (it / 16) % NKVH, nb = it % 16;
        const int row_own = b * SEQ + nb * WIN, row_prev = row_own - WIN;
        const int r0 = it * 32, s0 = r0 % SEQ;
        const int rm2 = (s0 == 0) ? MREAL + NMETA - 2 : r0 - 2, rm1 = (s0 == 0) ? MREAL + NMETA - 1 : r0 - 1;
        const f32x4 w0 = *(const f32x4*)(cw + c0), w1 = *(const f32x4*)(cw + DM + c0), w2 = *(const f32x4*)(cw + 2 * DM + c0);
        const v2u a2 = *(const v2u*)(P + (size_t)rm2 * LDP + PC_CC + c0);
        const v2u a1 = *(const v2u*)(P + (size_t)rm1 * LDP + PC_CC + c0);
        __syncthreads();
        v4u kq[5], vq[5];
#pragma unroll
        for (int i = 0; i < 5; ++i) { const int q = tid0 + i * (NWAVES * 64); const int row = q >> 3, c = q & 7;
            int grow = -1;
            if (row < NMETA) grow = MREAL + row;
            else if (row >= 32 && row < 160) { if (nb > 0) grow = row_prev + (row - 32); }
            else if (row >= 160 && row < KROWS) grow = row_own + (row - 160);
            kq[i] = (v4u){0u, 0u, 0u, 0u}; vq[i] = (v4u){0u, 0u, 0u, 0u};
            if (grow >= 0) { const bf16* rp = P + (size_t)grow * LDP; kq[i] = *(const v4u*)(rp + PC_K + kvh * HD + 8 * c); vq[i] = *(const v4u*)(rp + PC_V + kvh * HD + 8 * c); } }
#pragma unroll
        for (int i = 0; i < 5; ++i) { const int q = tid0 + i * (NWAVES * 64); const int row = q >> 3, c = q & 7;
            if (q < KROWS * 8) {
                *(LAS v4u*)(F.lds + ATT_KS + row * KS_PITCH + c * 16) = kq[i];
                const unsigned vw[4] = {vq[i].x, vq[i].y, vq[i].z, vq[i].w};
#pragma unroll
                for (int e = 0; e < 4; ++e) {
                    *(LAS unsigned short*)(F.lds + ATT_VT + (8 * c + 2 * e) * VT_PITCH + row * 2) = (unsigned short)(vw[e] & 0xffffu);
                    *(LAS unsigned short*)(F.lds + ATT_VT + (8 * c + 2 * e + 1) * VT_PITCH + row * 2) = (unsigned short)(vw[e] >> 16);
                } } }
        __syncthreads();
        const int head = kvh * 8 + F.wave;
        const float sink_l2 = sinks[head] * LOG2E;
        f32x4 pm2 = conv_p(a2), pm1 = conv_p(a1);
        const unsigned voff0 = (unsigned)c0 * 2u;
#define P2_STEP(R) do { \
            unsigned voff = voff0; asm volatile("" : "+v"(voff)); \
            v2u ca[8], cbb[8]; \
            _Pragma("unroll") for (int i = 0; i < 8; ++i) { const char* rp = (const char*)(P + (size_t)(r0 + 8 * (R) + i) * LDP);     \
                ca[i] = *(const v2u*)(rp + PC_CC * 2 + voff); cbb[i] = *(const v2u*)(rp + PC_CB * 2 + voff); } \
            asm volatile("" ::: "memory"); \
            attn_qblock<R>((LAS const unsigned char*)F.lds, P, row_own, head, sink_l2, nb > 0, lane0); \
            asm volatile("" ::: "memory"); \
            _Pragma("unroll") for (int i = 0; i < 8; ++i) { char* rp = (char*)(P + (size_t)(r0 + 8 * (R) + i) * LDP); \
                const f32x4 p = conv_p(ca[i]); const f32x4 cbv = {bf_lo(cbb[i].x), bf_hi(cbb[i].x), bf_lo(cbb[i].y), bf_hi(cbb[i].y)}; \
                const f32x4 uu = cbv * (w0 * pm2 + w1 * pm1 + w2 * p); \
                v2u o; o.x = pk2(uu[0], uu[1]); o.y = pk2(uu[2], uu[3]); *(v2u*)(rp + PC_CB * 2 + voff) = o; pm2 = pm1; pm1 = p; } } while (0)
        P2_STEP(0); P2_STEP(1); P2_STEP(2); P2_STEP(3);
        if (MK_SEAM23 && N_LAUNCHES == 1 && MK_DUP == 0) {
            asm volatile("s_waitcnt vmcnt(0)" ::: "memory"); __syncthreads();
            if (F.wave == 0 && lane0 == 0) { __builtin_amdgcn_fence(__ATOMIC_RELEASE, "agent"); asm volatile("s_waitcnt vmcnt(0)" ::: "memory");
                __hip_atomic_fetch_add(F.ctl + CW_P2 + 64 * (b * 8 + (nb >> 1)), 1u, RLX_AGENT); __hip_atomic_fetch_add(F.ctl + CW_P2 + 64 * (it >> 3), 1u, RLX_AGENT); }
        }
    }
}

#undef P2_STEP
__device__ __forceinline__ void p5_ln1_router(Frame& F, const Args& A) {
    const int lane = lane_id(), w = F.wave, tid = w * 64 + lane;
    const int rl = lane & 15, kq = lane >> 4;
    bf16* P = (bf16*)(F.ws + WS_P); bf16* XN = (bf16*)(F.ws + WS_XN);
    const float* g1 = arg_in(10); const float* b1 = arg_in(11);
    const float* rgb = arg_in(13); const float* reb = arg_in(15);
    const bf16* whi = (const bf16*)(F.ws + WS_REWG); const bf16* wlo = whi + 48 * DM;
    int* rowidx = (int*)(F.ws + WS_ROWIDX); float* tokw = (float*)(F.ws + WS_TOKW); int* slot = (int*)(F.ws + WS_SLOT);
    unsigned* cnt = (unsigned*)(F.ctl + CW_CNT);
    LAS float* red = (LAS float*)(F.lds + RING_OFF);
    LAS float* plog = (LAS float*)(F.lds + RING_OFF + 4096);
    LAS float* flog = (LAS float*)(F.lds + RING_OFF + 4096 + 49152);
    const int kbase0 = 256 * w + 8 * kq, rl0 = rl;
    for (int rg = blockIdx.x; rg < MREAL / 32; rg += F.G) {
        if (MK_SEAM34 && N_LAUNCHES == 1 && MK_DUP == 0) { if (w == 0) wait_count((unsigned*)(F.ctl + CW_P4) + 64 * (rg >> 3), 64u, (unsigned*)(F.ctl + CW_TMO)); __syncthreads(); }
        int kbase = kbase0, rl = rl0; asm volatile("" : "+v"(kbase), "+v"(rl));
        f32x4 x[2][8][2];
#pragma unroll
        for (int hq = 0; hq < 2; ++hq) { const bf16* xp = P + (size_t)(rg * 32 + 16 * hq + rl) * LDP + PC_GA + kbase;
#pragma unroll
            for (int s = 0; s < 8; ++s) { const v4u q = *(const v4u*)(xp + 32 * s);
                x[hq][s][0] = (f32x4){bf_lo(q.x), bf_hi(q.x), bf_lo(q.y), bf_hi(q.y)}; x[hq][s][1] = (f32x4){bf_lo(q.z), bf_hi(q.z), bf_lo(q.w), bf_hi(q.w)}; } }
#pragma unroll
        for (int hq = 0; hq < 2; ++hq) { float sm = 0.f;
#pragma unroll
            for (int s = 0; s < 8; ++s) sm += ((x[hq][s][0][0] + x[hq][s][0][1]) + (x[hq][s][0][2] + x[hq][s][0][3])) + ((x[hq][s][1][0] + x[hq][s][1][1]) + (x[hq][s][1][2] + x[hq][s][1][3]));
            sm += __shfl_xor(sm, 16); sm += __shfl_xor(sm, 32);
            if (kq == 0) red[w * 32 + 16 * hq + rl] = sm; }
        __syncthreads();
        float rstd[2];
#pragma unroll
        for (int hq = 0; hq < 2; ++hq) { float tot = 0.f;
#pragma unroll
            for (int j = 0; j < 8; ++j) tot += red[j * 32 + 16 * hq + rl];
            const float mean = tot * (1.f / DM); float sq = 0.f;
#pragma unroll
            for (int s = 0; s < 8; ++s)
#pragma unroll
                for (int h = 0; h < 2; ++h) { x[hq][s][h] = x[hq][s][h] - mean; sq += (x[hq][s][h][0] * x[hq][s][h][0] + x[hq][s][h][1] * x[hq][s][h][1]) + (x[hq][s][h][2] * x[hq][s][h][2] + x[hq][s][h][3] * x[hq][s][h][3]); }
            sq += __shfl_xor(sq, 16); sq += __shfl_xor(sq, 32);
            if (kq == 0) red[256 + w * 32 + 16 * hq + rl] = sq; }
        __syncthreads();
#pragma unroll
        for (int hq = 0; hq < 2; ++hq) { float tq = 0.f;
#pragma unroll
            for (int j = 0; j < 8; ++j) tq += red[256 + j * 32 + 16 * hq + rl];
            rstd[hq] = 1.f / sqrtf(tq * (1.f / DM) + LN_EPS); }
        f32x4 acc[2][3];
#pragma unroll
        for (int hq = 0; hq < 2; ++hq)
#pragma unroll
            for (int nb = 0; nb < 3; ++nb) acc[hq][nb] = (f32x4){0.f, 0.f, 0.f, 0.f};
#pragma unroll
        for (int s = 0; s < 8; ++s) {
            const int k0 = kbase + 32 * s;
            const f32x4 ga = *(const f32x4*)(g1 + k0), gb = *(const f32x4*)(g1 + k0 + 4), ba = *(const f32x4*)(b1 + k0), bb = *(const f32x4*)(b1 + k0 + 4);
            bf16x8 bh[3], bl[3];
#pragma unroll
            for (int nb = 0; nb < 3; ++nb) { bh[nb] = *(const bf16x8*)(whi + (size_t)(16 * nb + rl) * DM + k0); bl[nb] = *(const bf16x8*)(wlo + (size_t)(16 * nb + rl) * DM + k0); }
#pragma unroll
            for (int hq = 0; hq < 2; ++hq) {
                const f32x4 ha = x[hq][s][0] * rstd[hq] * ga + ba, hb = x[hq][s][1] * rstd[hq] * gb + bb;
                v4u uh; uh.x = cvt_pk_bf16(ha[0], ha[1]); uh.y = cvt_pk_bf16(ha[2], ha[3]); uh.z = cvt_pk_bf16(hb[0], hb[1]); uh.w = cvt_pk_bf16(hb[2], hb[3]);
                *(v4u*)(XN + (size_t)(rg * 32 + 16 * hq + rl) * DM + k0) = uh;
                v4u ul; ul.x = cvt_pk_bf16(ha[0] - bf_lo(uh.x), ha[1] - bf_hi(uh.x)); ul.y = cvt_pk_bf16(ha[2] - bf_lo(uh.y), ha[3] - bf_hi(uh.y));
                ul.z = cvt_pk_bf16(hb[0] - bf_lo(uh.z), hb[1] - bf_hi(uh.z)); ul.w = cvt_pk_bf16(hb[2] - bf_lo(uh.w), hb[3] - bf_hi(uh.w));
                const bf16x8 ahi = __builtin_bit_cast(bf16x8, uh), alo = __builtin_bit_cast(bf16x8, ul);
#pragma unroll
                for (int nb = 0; nb < 3; ++nb) {
                    acc[hq][nb] = __builtin_amdgcn_mfma_f32_16x16x32_bf16(ahi, bh[nb], acc[hq][nb], 0, 0, 0);
                    acc[hq][nb] = __builtin_amdgcn_mfma_f32_16x16x32_bf16(alo, bh[nb], acc[hq][nb], 0, 0, 0);
                    acc[hq][nb] = __builtin_amdgcn_mfma_f32_16x16x32_bf16(ahi, bl[nb], acc[hq][nb], 0, 0, 0);
                }
            }
            asm volatile("" ::: "memory");
        }
#pragma unroll
        for (int hq = 0; hq < 2; ++hq)
#pragma unroll
            for (int nb = 0; nb < 3; ++nb)
#pragma unroll
                for (int i = 0; i < 4; ++i) plog[(w * 32 + 16 * hq + 4 * kq + i) * 48 + 16 * nb + rl] = acc[hq][nb][i];
        __syncthreads();
        for (int o = tid; o < 32 * 48; o += NWAVES * 64) { float t = 0.f;
#pragma unroll
            for (int j = 0; j < 8; ++j) t += plog[j * 1536 + o];
            flog[o] = t; }
        __syncthreads();
        if (tid < 32) {
            const LAS float* fl = flog + tid * 48; const int m = rg * 32 + tid;
            float gl[4];
#pragma unroll
            for (int c = 0; c < 4; ++c) gl[c] = fl[c] + rgb[c];
            int gsel = 0; float gmax = gl[0];
#pragma unroll
            for (int c = 1; c < 4; ++c) if (gl[c] > gmax) { gmax = gl[c]; gsel = c; }
            float gden = 0.f;
#pragma unroll
            for (int c = 0; c < 4; ++c) gden += __expf(gl[c] - gmax);
            const float pgroup = 1.0f / gden;
            float el[8];
#pragma unroll
            for (int c = 0; c < 8; ++c) el[c] = fl[4 + gsel * EPG + c] + reb[gsel * EPG + c];
            int i0 = 0; float l0 = el[0];
#pragma unroll
            for (int c = 1; c < 8; ++c) if (el[c] > l0) { l0 = el[c]; i0 = c; }
            int i1 = -1; float l1 = -INFINITY;
#pragma unroll
            for (int c = 0; c < 8; ++c) if (c != i0 && el[c] > l1) { l1 = el[c]; i1 = c; }
            const float e10 = __expf(l1 - l0);
            const float w0 = pgroup / (1.0f + e10), w1 = pgroup * e10 / (1.0f + e10);
            const int e0 = gsel * EPG + i0, e1 = gsel * EPG + i1;
            const unsigned p0 = __hip_atomic_fetch_add(cnt + 64 * e0, 1u, RLX_AGENT), p1 = __hip_atomic_fetch_add(cnt + 64 * e1, 1u, RLX_AGENT);
            rowidx[e0 * MREAL + p0] = m * 2; rowidx[e1 * MREAL + p1] = m * 2 + 1;
            tokw[m * 2] = w0; tokw[m * 2 + 1] = w1;
            slot[m * 2] = (e0 << 16) | (int)p0; slot[m * 2 + 1] = (e1 << 16) | (int)p1;
        }
    }
}

__device__ __forceinline__ void p8_ln2(Frame& F, const Args& A, volatile LAS int* tp) {
    const int gw = F.vcu * NWAVES + F.wave, NGW = F.G * NWAVES;
    const bf16* XN = (const bf16*)(F.ws + WS_XN); const bf16* Y = (const bf16*)(F.ws + WS_Y);
    const float* g2 = arg_in(19); const float* b2 = arg_in(20);
    const int* slot = (const int*)(F.ws + WS_SLOT); const float* tokw = (const float*)(F.ws + WS_TOKW);
    for (int base = gw; base < MREAL; base += 4 * NGW) {
    int sl[4][2]; float wl[4][2];
#pragma unroll
    for (int k = 0; k < 4; ++k) { const int m = base + k * NGW; const int mm = m < MREAL ? m : 0; sl[k][0] = slot[2 * mm]; sl[k][1] = slot[2 * mm + 1]; wl[k][0] = tokw[2 * mm]; wl[k][1] = tokw[2 * mm + 1]; }
#pragma unroll
    for (int k = 0; k < 4; ++k) {
        const int m = base + k * NGW; if (m >= MREAL) break;
        int lane = lane_id();
        const int s0 = sl[k][0], s1 = sl[k][1]; const float w0 = wl[k][0], w1 = wl[k][1];
        const int r0 = __builtin_amdgcn_readfirstlane(tp[s0 >> 16]) * 256 + (s0 & 0xffff), r1 = __builtin_amdgcn_readfirstlane(tp[s1 >> 16]) * 256 + (s1 & 0xffff);
        const v2u* hp = (const v2u*)(XN + (size_t)m * DM) + lane; const v2u* y0 = (const v2u*)(Y + (size_t)r0 * DM) + lane; const v2u* y1 = (const v2u*)(Y + (size_t)r1 * DM) + lane;
        f32x4 v[8]; float s = 0.f;
#pragma unroll
        for (int j = 0; j < 8; ++j) { const v2u h = hp[64 * j], a = y0[64 * j], c = y1[64 * j];
            v[j] = (f32x4){ALPHA * bf_lo(h.x) + (w0 * bf_lo(a.x) + w1 * bf_lo(c.x)), ALPHA * bf_hi(h.x) + (w0 * bf_hi(a.x) + w1 * bf_hi(c.x)), ALPHA * bf_lo(h.y) + (w0 * bf_lo(a.y) + w1 * bf_lo(c.y)), ALPHA * bf_hi(h.y) + (w0 * bf_hi(a.y) + w1 * bf_hi(c.y))};
            s += (v[j][0] + v[j][1]) + (v[j][2] + v[j][3]); }
        const float mean = wave_sum(s) * (1.f / DM); float s2 = 0.f;
#pragma unroll
        for (int j = 0; j < 8; ++j) { v[j] = v[j] - mean; s2 += (v[j][0] * v[j][0] + v[j][1] * v[j][1]) + (v[j][2] * v[j][2] + v[j][3] * v[j][3]); }
        const float rstd = 1.f / sqrtf(wave_sum(s2) * (1.f / DM) + LN_EPS);
        f32x4* op = (f32x4*)(F.out + (size_t)m * DM) + lane;
#pragma unroll
        for (int j = 0; j < 8; ++j) { const f32x4 gg = ((const f32x4*)g2)[lane + 64 * j], bb = ((const f32x4*)b2)[lane + 64 * j]; op[64 * j] = v[j] * rstd * gg + bb; }
    }
    }
}

__global__ void __launch_bounds__(NWAVES * 64, 2) mk_fwd(Args args) {
    extern __shared__ __attribute__((aligned(16))) unsigned char lds[];
    Frame F;
    F.lds = (LAS unsigned char*)lds;
    F.MISC = (volatile LAS unsigned*)(F.lds + MISC_OFF);
    F.wave = __builtin_amdgcn_readfirstlane((int)(threadIdx.x >> 6));
    F.G = gridDim.x; { const int bx = blockIdx.x; F.vcu = (F.G % 8 == 0) ? (bx % 8) * (F.G / 8) + bx / 8 : bx; }
    F.ws = args.ws; F.out = args.out;
    F.ctl = (gu32*)(F.ws + WS_CTL);
    for (int u = threadIdx.x; u < (LDS_BYTES - LDSCTL_OFF) / 4; u += NWAVES * 64) ((LAS unsigned*)(F.lds + LDSCTL_OFF))[u] = 0u;
    __syncthreads();
    XcdBarrier bar; bar.bar = (unsigned*)(F.ctl + CW_BAR); bar.x = 0; bar.st = nullptr; bar.wave = F.wave;
    if (N_LAUNCHES == 1) { bar = xcd_barrier_post((unsigned*)(F.ctl + CW_BAR), F.MISC + 8); bar.wave = F.wave; }
#define GRID_BAR() do { if (N_LAUNCHES == 1) xcd_barrier(bar); } while (0)
    volatile LAS unsigned long long* stamps = (volatile LAS unsigned long long*)(F.lds + LDSCTL_OFF + 4096);
    int n_stamp = 0;
#define STAMP() do { if (MK_SPIN >= 0 && blockIdx.x == 0 && F.wave == 0 && lane_id() == 0) stamps[n_stamp] = __builtin_amdgcn_s_memrealtime(); ++n_stamp; } while (0)
    STAMP();
    const int lo = args.ph_lo, hi = args.ph_hi;
#define REP(k) for (int rep_ = 0; rep_ < 1 + ((MK_DUP >> (k)) & 1); ++rep_)
#ifndef MK_PH_MASK
#define MK_PH_MASK 0x1ff
#endif
#define IN(k) (((MK_PH_MASK >> (k)) & 1) && lo <= (k) && (k) < hi)
    bf16* P = (bf16*)(F.ws + WS_P); bf16* XN = (bf16*)(F.ws + WS_XN);

    if (IN(0)) REP(0) { p0_prologue(F, args); GRID_BAR(); }
    STAMP();

    if (IN(1)) REP(1) {
        const int NSPARE = (F.G == 256) ? 24 : 0;
        if ((int)blockIdx.x < F.G - NSPARE) {
            pg8::Gemm g{XN, (const bf16*)(F.ws + WS_WIN), DM, DM, -1};
            DenseOrder S; S.init(F.wave, MREAL / 256, LDP / 256, F.G - NSPARE, (int)blockIdx.x, (long)256 * DM * 2, (long)256 * DM * 2, (PC_GA - PC_K) / 256, PC_K / 256);
            EpiBf16 E{P, LDP, PC_CC / 256, PC_GA / 256, PC_CC, PC_GA / 256};
            pg8::gemm_phase<EpiBf16, DenseOrder, true>(F.lds + RING_OFF, g, S, E);
        }
        conv_queue((unsigned*)(F.ctl + CW_Q), 0, CT_B1, F.ws, F.lds + RING_OFF, F.MISC + 16, F.wave, lane_id());
        GRID_BAR();
    }
    STAMP();
    constexpr bool SEAM23 = MK_SEAM23 && N_LAUNCHES == 1 && MK_DUP == 0;
    if (IN(2)) { p2_attention_conv(F, args); if (!SEAM23) GRID_BAR(); }
    STAMP();
    constexpr bool SEAM34 = MK_SEAM34 && N_LAUNCHES == 1 && MK_DUP == 0;
    if (IN(3)) REP(3) {
        pg8::Gemm g{P, (const bf16*)(F.ws + WS_WB2), LDP, 2 * DM, DM / 64};
        EpiGate E{P, (bf16*)(F.ws + WS_MRG), SEAM34 ? (unsigned*)(F.ctl + CW_P3) : nullptr};
        if (SEAM23) {
            DenseOrderDep S; S.init(F.wave, MREAL / 256, DM / 256, F.G, (int)blockIdx.x, (long)256 * LDP * 2, (long)256 * 2 * DM * 2);
            S.rdy = (unsigned*)(F.ctl + CW_P2); S.need = 16u; S.tmo = (unsigned*)(F.ctl + CW_TMO);
            pg8::gemm_phase<EpiGate, DenseOrderDep, true>(F.lds + RING_OFF, g, S, E);
        } else {
            DenseOrder S; S.init(F.wave, MREAL / 256, DM / 256, F.G, (int)blockIdx.x, (long)256 * LDP * 2, (long)256 * 2 * DM * 2);
            pg8::gemm_phase<EpiGate, DenseOrder, true>(F.lds + RING_OFF, g, S, E);
        }
        if (!SEAM34) GRID_BAR();
    }
    STAMP();
    if (IN(4)) REP(4) {
        pg8::Gemm g{(const bf16*)(F.ws + WS_MRG), (const bf16*)(F.ws + WS_WOUT), DM, DM, -1};
        EpiPre E{XN, P + PC_GA, LDP, SEAM34 ? (unsigned*)(F.ctl + CW_P4) : nullptr};
        if (SEAM34) {
            DenseOrderDep S; S.init(F.wave, MREAL / 256, DM / 256, F.G, (int)blockIdx.x, (long)256 * DM * 2, (long)256 * DM * 2);
            S.rdy = (unsigned*)(F.ctl + CW_P3); S.need = 64u; S.tmo = (unsigned*)(F.ctl + CW_TMO);
            pg8::gemm_phase<EpiPre, DenseOrderDep, true>(F.lds + RING_OFF, g, S, E);
        } else {
            DenseOrder S; S.init(F.wave, MREAL / 256, DM / 256, F.G, (int)blockIdx.x, (long)256 * DM * 2, (long)256 * DM * 2);
            pg8::gemm_phase<EpiPre, DenseOrder, true>(F.lds + RING_OFF, g, S, E);
            GRID_BAR();
        }
    }
    STAMP();
    if (IN(5)) { p5_ln1_router(F, args); GRID_BAR(); }
    STAMP();
    volatile LAS int* tp = (volatile LAS int*)(F.MISC + 32);
    volatile LAS int* cn = (volatile LAS int*)(F.MISC + 72);
    if (IN(6) || IN(7) || IN(8)) {
        if (F.wave == 0 && lane_id() == 0) { int acc = 0; for (int e = 0; e < NEXP; ++e) { const int c = (int)__hip_atomic_load(F.ctl + CW_CNT + 64 * e, RLX_AGENT); tp[e] = acc; cn[e] = c; acc += (c + 255) >> 8; } tp[32] = acc; }
        __syncthreads();
    }
    constexpr bool MERGE = MK_MOE_MERGE && N_LAUNCHES == 1;
    if (IN(6)) REP(6) {
        pg8::Gemm g{XN, (const bf16*)(F.ws + WS_WGU), DM, DM, -1};
        MoeOrder<4, true> S{F.wave, tp, cn, F.G, (int)blockIdx.x, (long)1024 * DM * 2, (long)256 * DM * 2, 0, (const int*)(F.ws + WS_ROWIDX), (unsigned)(DM * 2)};
        EpiAct E{(bf16*)(F.ws + WS_ACT), (unsigned*)(F.ctl + CW_RDY)};
        pg8::gemm_phase<EpiAct, MoeOrder<4, true>, true>(F.lds + RING_OFF, g, S, E);
        if (MERGE) conv_queue<true>((unsigned*)(F.ctl + CW_Q + 64), CT_B1, CT_B, F.ws, F.lds + RING_OFF, F.MISC + 16, F.wave, lane_id(), (unsigned*)(F.ctl + CW_WD));
        else { conv_queue<false>((unsigned*)(F.ctl + CW_Q + 64), CT_B1, CT_B, F.ws, F.lds + RING_OFF, F.MISC + 16, F.wave, lane_id()); GRID_BAR(); }
    }
    STAMP();
    if (IN(7)) REP(7) {
        pg8::Gemm g{(const bf16*)(F.ws + WS_ACT), (const bf16*)(F.ws + WS_WD), DE, DE, -1};
        EpiDown E{(bf16*)(F.ws + WS_Y)};
        if (MERGE) {
            MoeDownOrder S{F.wave, tp, cn, F.G, (int)blockIdx.x, (long)DM * DE * 2, (long)256 * DE * 2, (long)256 * DE * 2, (unsigned*)(F.ctl + CW_RDY), (unsigned*)(F.ctl + CW_WD), (unsigned*)(F.ctl + CW_TMO)};
            pg8::gemm_phase<EpiDown, MoeDownOrder, true>(F.lds + RING_OFF, g, S, E);
        } else {
            MoeOrder<8, false> S{F.wave, tp, cn, F.G, (int)blockIdx.x, (long)DM * DE * 2, (long)256 * DE * 2, (long)256 * DE * 2, (const int*)(F.ws + WS_ROWIDX), 0u};
            pg8::gemm_phase<EpiDown, MoeOrder<8, false>, true>(F.lds + RING_OFF, g, S, E);
        }
        GRID_BAR();
    }
    STAMP();
    if (IN(8)) REP(8) { p8_ln2(F, args, tp); }
    STAMP();
    if (MK_SPIN >= 0 && blockIdx.x == 0 && F.wave == 0 && lane_id() == 0) {
        const unsigned long long t_end = __builtin_amdgcn_s_memrealtime();
        const unsigned long long span = (MK_SPIN >= 100) ? (unsigned long long)MK_SPIN * 100ull : (stamps[(MK_SPIN < 9 ? MK_SPIN : 8) + 1] - stamps[MK_SPIN < 9 ? MK_SPIN : 8]);
        while (__builtin_amdgcn_s_memrealtime() - t_end < span) __builtin_amdgcn_s_sleep(8);
    }
#undef IN
#undef GRID_BAR
}

extern "C" void kernel_launch(void* const* d_in, const int* in_sizes, int n_in, void* d_out, int out_size, void* d_ws, size_t ws_size, hipStream_t stream) {
    static int grid = 0;
    if (grid == 0) {
        if (n_in != 21 || in_sizes[0] != MREAL * DM || out_size != MREAL * DM || ws_size < WS_END) { fprintf(stderr, "kernel_launch: unexpected shapes / workspace (n_in %d, ws %zu); nothing launched\n", n_in, ws_size); grid = -1; return; }
        int dev = 0, cus = 0, per_cu = 0;
        if (hipGetDevice(&dev) != hipSuccess || hipDeviceGetAttribute(&cus, hipDeviceAttributeMultiprocessorCount, dev) != hipSuccess) { grid = -1; return; }
        if (hipFuncSetAttribute((const void*)mk_fwd, hipFuncAttributeMaxDynamicSharedMemorySize, LDS_BYTES) != hipSuccess) { fprintf(stderr, "kernel_launch: hipFuncSetAttribute failed\n"); grid = -1; return; }
        if (hipOccupancyMaxActiveBlocksPerMultiprocessor(&per_cu, (const void*)mk_fwd, NWAVES * 64, LDS_BYTES) != hipSuccess || per_cu < 1) { fprintf(stderr, "kernel_launch: occupancy query reports %d\n", per_cu); }
        (void)hipGetLastError();
        grid = cus;
    }
    if (grid < 0) return;
    if (hipMemsetAsync((char*)d_ws + WS_CTL, 0, CTL_ZERO_BYTES, stream) != hipSuccess) return;
    Args a{};
    for (int i = 0; i < 21; ++i) a.in[i] = (const float*)d_in[i];
    a.out = (float*)d_out; a.ws = (unsigned char*)d_ws;
    for (int li = 0; li < N_LAUNCHES; ++li) {
        a.ph_lo = (N_LAUNCHES == 1) ? 0 : li; a.ph_hi = (N_LAUNCHES == 1) ? PER_PHASE : li + 1; a.li = li;
        hipLaunchKernelGGL(mk_fwd, dim3(grid), dim3(NWAVES * 64), LDS_BYTES, stream, a);
    }
}
```

```cpp
#include <hip/hip_runtime.h>
#include <cstdio>
#include <cstdint>

#ifndef MK_SPIN
#define MK_SPIN -1
#endif
#ifndef MK_DUP
#define MK_DUP 0
#endif
#ifndef MK_SEAM23
#define MK_SEAM23 1
#endif
#ifndef MK_SEAM34
#define MK_SEAM34 1
#endif
#ifndef MK_MOE_MERGE
#define MK_MOE_MERGE 1
#endif
#ifndef MK_N_LAUNCHES
#define MK_N_LAUNCHES 1
#endif

__device__ __forceinline__ int lane_id() { int l = (int)__builtin_amdgcn_mbcnt_hi(~0u, __builtin_amdgcn_mbcnt_lo(~0u, 0u)); asm volatile("" : "+v"(l)); return l; }
namespace pg8 {
#define PG8_LAS __attribute__((address_space(3)))
typedef unsigned short bf16_t;
typedef short bf16x8 __attribute__((ext_vector_type(8)));
typedef float f32x4 __attribute__((ext_vector_type(4)));
typedef float f32x2 __attribute__((ext_vector_type(2)));
typedef unsigned u32x4 __attribute__((ext_vector_type(4)));
typedef unsigned u32x2 __attribute__((ext_vector_type(2)));
constexpr int BM = 256, BK = 64, HALF = 128, HTB = HALF * BK * 2  , STAGE_BYTES = 8 * HTB, NXCD = 8, WGM = 8;

__host__ __device__ __forceinline__ int lds_byte(int r, int c) { const int st = (r >> 4) * 2 + (c >> 5), rr = r & 15, cc = c & 31, ob = rr * 64 + cc * 2; return st * 1024 + (ob ^ (((ob >> 9) & 1) << 5)); }
__host__ __device__ __forceinline__ void stage_rc(int b, int& R, int& C) { const int st = b / 1024, sb = b % 1024, swz = sb ^ (((sb >> 9) & 1) << 5); R = (st >> 1) * 16 + swz / 64; C = (st & 1) * 32 + (swz % 64) / 2; }
__host__ __device__ __forceinline__ int perm32(int rho) { const int n = rho >> 4, i = rho & 15; return 8 * (i >> 2) + 4 * n + (i & 3); }

struct Unit { int pm, pn; long a_byte, b_byte; int e, mt, cnt; };
struct Gemm { const bf16_t* A; const bf16_t* Bt; int lda; int K; int tmid; };

__device__ __forceinline__ unsigned cvt_pk_bf16(float lo, float hi) { unsigned r; asm volatile("v_cvt_pk_bf16_f32 %0, %1, %2" : "=v"(r) : "v"(lo), "v"(hi)); return r; }
__device__ __forceinline__ float bf_lo(unsigned u) { return __builtin_bit_cast(float, u << 16); }
__device__ __forceinline__ float bf_hi(unsigned u) { return __builtin_bit_cast(float, u & 0xffff0000u); }

template <class Epi, class Sched, bool ALIGN_EPI>
__device__ __forceinline__ void gemm_phase(PG8_LAS unsigned char* lds, const Gemm g, const Sched& S, const Epi& E) {
    constexpr bool GATHER = Sched::GATHER;
    const int lane = lane_id(), wid = S.wave, tid = wid * 64 + lane, wr = wid >> 2, wc = wid & 3, fr = lane & 15, fq = lane >> 4;
    const int K = g.K, nt = K / BK, lda = g.lda;
    unsigned voffA[2], voffB[2]; int rA[2]; unsigned cA2[2];
#pragma unroll
    for (int i = 0; i < 2; ++i) { int R, C; stage_rc(tid * 16 + i * 8192, R, C); const int Rb = Epi::PERM ? ((R & ~31) + perm32(R & 31)) : R;
        voffA[i] = (unsigned)(R * lda + C) * 2u; voffB[i] = (unsigned)(Rb * K + C) * 2u; rA[i] = R; cA2[i] = (unsigned)C * 2u; }
    const size_t kstep = (size_t)(BK * 2);
    const size_t hstepA = (size_t)HALF * lda * 2, hstepB = (size_t)HALF * K * 2;
    const unsigned ldsw = (unsigned)wid * 1024u;
    const int aoff = lds_byte(wr * 64 + fr, fq * 8), boff = lds_byte(wc * 32 + fr, fq * 8);
#define PG8_SA(b, h) (((b) * 2 + (h)) * HTB)
#define PG8_SB(b, h) ((4 + (b) * 2 + (h)) * HTB)
#define PG8_GLDS(gp, ldsoff) __builtin_amdgcn_global_load_lds((const unsigned*)(gp), (PG8_LAS unsigned*)(lds + (ldsoff)), 16, 0, 0)
#define PG8_STAGE_O(bufoff, gbase, o0, o1) do { PG8_GLDS((const char*)(gbase) + (o0), (bufoff) + ldsw); PG8_GLDS((const char*)(gbase) + (o1), (bufoff) + ldsw + 8192); } while (0)
#define PG8_STB(bufoff, gbase) PG8_STAGE_O(bufoff, gbase, voffB[0], voffB[1])
#define PG8_STA(bufoff, ap, h, V) do { if constexpr (GATHER) PG8_STAGE_O(bufoff, ap, V[h][0], V[h][1]); else PG8_STAGE_O(bufoff, (ap) + (h) * hstepA, voffA[0], voffA[1]); } while (0)
#define PG8_LDA(dst, b, h) do { _Pragma("unroll") for (int m = 0; m < 4; ++m) _Pragma("unroll") for (int k = 0; k < 2; ++k) dst[m][k] = *(const PG8_LAS bf16x8*)(lds + PG8_SA(b, h) + aoff + m * 2048 + k * 1024); } while (0)
#define PG8_LDB(dst, b, h) do { _Pragma("unroll") for (int n = 0; n < 2; ++n) _Pragma("unroll") for (int k = 0; k < 2; ++k) dst[n][k] = *(const PG8_LAS bf16x8*)(lds + PG8_SB(b, h) + boff + n * 2048 + k * 1024); } while (0)
#define PG8_MMA(ai, bj, At, Bt) do { __builtin_amdgcn_s_setprio(1); _Pragma("unroll") for (int m = 0; m < 4; ++m) _Pragma("unroll") for (int n = 0; n < 2; ++n) _Pragma("unroll") for (int k = 0; k < 2; ++k) \
        acc[ai][bj][m][n] = __builtin_amdgcn_mfma_f32_16x16x32_bf16(Bt[n][k], At[m][k], acc[ai][bj][m][n], 0, 0, 0); __builtin_amdgcn_s_setprio(0); } while (0)
#define PG8_WAIT_V(n) asm volatile("s_waitcnt vmcnt(" #n ")" ::: "memory")
#define PG8_WAIT_L(n) asm volatile("s_waitcnt lgkmcnt(" #n ")" ::: "memory")
#define PG8_BAR __builtin_amdgcn_s_barrier()
#define PG8_SCHED __builtin_amdgcn_sched_barrier(0)
    Unit cur, nxt; int ui = 0;
    if (!S.next(0, cur)) return;
    f32x4 acc[2][2][4][2];
#pragma unroll
    for (int a = 0; a < 2; ++a)
#pragma unroll
        for (int b = 0; b < 2; ++b)
#pragma unroll
            for (int m = 0; m < 4; ++m)
#pragma unroll
                for (int n = 0; n < 2; ++n) acc[a][b][m][n] = (f32x4){0.f, 0.f, 0.f, 0.f};
    bf16x8 At[4][2], B0[2][2], B1[2][2];
    unsigned va[2][2], nva[2][2];
    if constexpr (GATHER) {
#pragma unroll
        for (int h = 0; h < 2; ++h)
#pragma unroll
            for (int i = 0; i < 2; ++i) { va[h][i] = S.row_byte(cur, h * HALF + rA[i]) + cA2[i]; nva[h][i] = va[h][i]; }
    } else { va[0][0] = va[0][1] = va[1][0] = va[1][1] = 0u; nva[0][0] = nva[0][1] = nva[1][0] = nva[1][1] = 0u; }
    const char* cA = (const char*)g.A + cur.a_byte; const char* cB = (const char*)g.Bt + cur.b_byte;
    S.a_ready(cur);
    PG8_STB(PG8_SB(0, 0), cB); PG8_STB(PG8_SB(0, 1), cB + hstepB); PG8_STA(PG8_SA(0, 0), cA, 0, va); PG8_STA(PG8_SA(0, 1), cA, 1, va);
    if (wr == 1) PG8_BAR;
    PG8_WAIT_V(2); PG8_BAR;
    PG8_STB(PG8_SB(1, 0), cB + kstep); PG8_STA(PG8_SA(1, 0), cA + kstep, 0, va); PG8_STB(PG8_SB(1, 1), cB + hstepB + kstep);
    PG8_WAIT_V(6); PG8_BAR;
    for (;;) {
        const bool has_next = S.next(ui + 1, nxt);
        const char* nA = has_next ? (const char*)g.A + nxt.a_byte : cA; const char* nB = has_next ? (const char*)g.Bt + nxt.b_byte : cB;
        if constexpr (GATHER) {
            if (has_next) {
#pragma unroll
                for (int h = 0; h < 2; ++h)
#pragma unroll
                    for (int i = 0; i < 2; ++i) nva[h][i] = S.row_byte(nxt, h * HALF + rA[i]) + cA2[i];
            }
            asm volatile("" : "+v"(nva[0][0]), "+v"(nva[0][1]), "+v"(nva[1][0]), "+v"(nva[1][1]));
        }
        for (int t = 0; t < nt; t += 2) {
            const bool last = (t == nt - 2);
            if constexpr (Epi::MID) { if (t == g.tmid) E.mid(acc, cur, wr, wc, fr, fq); }
            if (last && has_next) S.a_ready(nxt);
            const char* a1 = cA + (size_t)(t + 1) * kstep;
            const char* a2 = last ? nA : cA + (size_t)(t + 2) * kstep; const char* b2 = last ? nB : cB + (size_t)(t + 2) * kstep;
            const char* a3 = a2 + kstep; const char* b3 = b2 + kstep;
            unsigned xa[2][2];
#pragma unroll
            for (int h = 0; h < 2; ++h)
#pragma unroll
                for (int i = 0; i < 2; ++i) xa[h][i] = last ? nva[h][i] : va[h][i];
            PG8_LDB(B0, 0, 0); PG8_LDB(B1, 0, 1); PG8_SCHED; PG8_LDA(At, 0, 0); PG8_STA(PG8_SA(1, 1), a1, 1, va);
            PG8_WAIT_V(8); PG8_WAIT_L(0); PG8_BAR; PG8_MMA(0, 0, At, B0); PG8_MMA(0, 1, At, B1); PG8_BAR; PG8_SCHED;
            PG8_LDA(At, 0, 1); PG8_STB(PG8_SB(0, 0), b2); PG8_STB(PG8_SB(0, 1), b2 + hstepB); PG8_STA(PG8_SA(0, 0), a2, 0, xa);
            PG8_WAIT_V(8); PG8_WAIT_L(0); PG8_BAR; PG8_MMA(1, 0, At, B0); PG8_MMA(1, 1, At, B1); PG8_BAR; PG8_SCHED;
            PG8_LDB(B0, 1, 0); PG8_LDB(B1, 1, 1); PG8_SCHED; PG8_LDA(At, 1, 0); PG8_STA(PG8_SA(0, 1), a2, 1, xa);
            PG8_WAIT_V(8); PG8_WAIT_L(0); PG8_BAR; PG8_MMA(0, 0, At, B0); PG8_MMA(0, 1, At, B1); PG8_BAR; PG8_SCHED;
            PG8_LDA(At, 1, 1); PG8_STB(PG8_SB(1, 0), b3); PG8_STB(PG8_SB(1, 1), b3 + hstepB); PG8_STA(PG8_SA(1, 0), a3, 0, xa);
            PG8_WAIT_V(8); PG8_WAIT_L(0); PG8_BAR; PG8_MMA(1, 0, At, B0); PG8_MMA(1, 1, At, B1); PG8_BAR; PG8_SCHED;
        }
        if constexpr (ALIGN_EPI) { if (wr == 0) PG8_BAR; }
        E(acc, cur, wr, wc, fr, fq);
        if (!has_next) break;
#pragma unroll
        for (int a = 0; a < 2; ++a)
#pragma unroll
            for (int b = 0; b < 2; ++b)
#pragma unroll
                for (int m = 0; m < 4; ++m)
#pragma unroll
                    for (int n = 0; n < 2; ++n) acc[a][b][m][n] = (f32x4){0.f, 0.f, 0.f, 0.f};
        cur = nxt; cA = nA; cB = nB; ++ui;
        if constexpr (GATHER) {
#pragma unroll
            for (int h = 0; h < 2; ++h)
#pragma unroll
                for (int i = 0; i < 2; ++i) va[h][i] = nva[h][i];
        }
        if constexpr (ALIGN_EPI) { if (wr == 1) PG8_BAR; }
    }
    PG8_WAIT_V(0);
    if constexpr (!ALIGN_EPI) { if (wr == 0) PG8_BAR; }
    PG8_BAR;
#undef PG8_SA
#undef PG8_SB
#undef PG8_GLDS
#undef PG8_STAGE_O
#undef PG8_STB
#undef PG8_STA
#undef PG8_LDA
#undef PG8_LDB
#undef PG8_MMA
#undef PG8_WAIT_V
#undef PG8_WAIT_L
#undef PG8_BAR
#undef PG8_SCHED
}
}

constexpr int NWAVES = 8;
constexpr int N_LAUNCHES = MK_N_LAUNCHES;
constexpr int PER_PHASE = 9;
constexpr int BATCH = 4, SEQ = 2048, DM = 2048, NMETA = 16;
constexpr int MREAL = BATCH * SEQ;
constexpr int MPAD = MREAL + 256;
constexpr int LDP = 12800;
constexpr int PC_Q = 0, PC_CB = 2048, PC_K = 4096, PC_V = 4352, PC_CC = 4608, PC_CH = 6656, PC_GA = 8704, PC_GC = 10752;
constexpr int NQH = 32, NKVH = 4, HD = 64, WIN = 128;
constexpr int NEXP = 32, NGRP = 4, EPG = 8, DE = 512;
constexpr float LN_EPS = 1e-5f;
constexpr float ALPHA = 1.189207115002721f;
constexpr int MOE_ROWS_MAX = 2 * MREAL + NEXP * 256;

constexpr int CT_IN = 32 * 50, CT_SQ = 32 * 8, CT_GU = 32 * 64, CT_DN = 32 * 64;
constexpr size_t MiB = 1u << 20;
constexpr size_t WS_CTL = 0, CTL_ZERO_BYTES = 131072;
constexpr size_t WS_ROWIDX = 1 * MiB;
constexpr size_t WS_TOKW = 2 * MiB;
constexpr size_t WS_SLOT = 2 * MiB + 128 * 1024;
constexpr size_t WS_REWG = 3 * MiB;
constexpr size_t WS_WIN = 4 * MiB;
constexpr size_t WS_WB2 = 54 * MiB;
constexpr size_t WS_WOUT = 70 * MiB;
constexpr size_t WS_WGU = 78 * MiB;
constexpr size_t WS_WD = 206 * MiB;
constexpr size_t WS_XN = 270 * MiB;
constexpr size_t WS_P = 303 * MiB;
constexpr size_t WS_ACT = WS_P;
constexpr size_t WS_Y = WS_P + 24 * MiB;
constexpr size_t WS_MRG = 512 * MiB;
constexpr size_t WS_END = 544 * MiB;
static_assert(WS_P + (size_t)MPAD * LDP * 2 <= WS_MRG && WS_Y + (size_t)MOE_ROWS_MAX * DM * 2 <= WS_MRG && (size_t)MOE_ROWS_MAX * DE * 2 <= 24 * MiB, "ws map");
constexpr int CW_TMO = 0, CW_CODE = 1;
constexpr int CW_CNT = 256;
constexpr int CW_Q = 64;
constexpr int CW_BAR = 4096;
constexpr int CW_P2 = 16384 + 4096, CW_P3 = 16384, CW_P4 = 16384 + 2048;
constexpr int CW_WD = 192;
constexpr int CW_RDY = 8192;
static_assert((CW_RDY + 64 * 96) * 4 <= 65536 && (CW_P2 + 2048) * 4 <= 131072, "control words inside the memset");

constexpr int RING_OFF = 0, RING_BYTES = 131072;
constexpr int LDSCTL_OFF = RING_BYTES, MISC_OFF = LDSCTL_OFF + 320;
constexpr int LDS_BYTES = 147456;

#define GAS __attribute__((address_space(1)))
#define LAS __attribute__((address_space(3)))
typedef unsigned short bf16;
typedef unsigned v4u __attribute__((ext_vector_type(4)));
typedef unsigned v2u __attribute__((ext_vector_type(2)));
typedef float f32x4 __attribute__((ext_vector_type(4)));
typedef float f32x16 __attribute__((ext_vector_type(16)));
typedef short bf16x8 __attribute__((ext_vector_type(8)));
typedef short s16x4 __attribute__((ext_vector_type(4)));
typedef GAS unsigned gu32;
#define RLX_AGENT __ATOMIC_RELAXED, __HIP_MEMORY_SCOPE_AGENT
#define LDS_WAIT() asm volatile("s_waitcnt lgkmcnt(0)" ::: "memory")
#define VM_WAIT() asm volatile("s_waitcnt vmcnt(0)" ::: "memory")
__device__ __forceinline__ unsigned f2bf(float f) { unsigned u = __builtin_bit_cast(unsigned, f); return (u + 0x7fffu + ((u >> 16) & 1u)) >> 16; }
__device__ __forceinline__ unsigned pk2(float lo, float hi) { return f2bf(lo) | (f2bf(hi) << 16); }
using pg8::bf_lo; using pg8::bf_hi; using pg8::cvt_pk_bf16;

#define XB_TMO      128
#define XB_XCNT(j)  (256  + 64 * (j))
#define XB_XSUB(j)  (1280 + 64 * (j))
#define XB_XGEN(j)  (2304 + 64 * (j))
#define XB_TOP      3328
#define XB_TOPGEN   3392
#define XCD_BAR_WORDS 3456
#define XB_SPIN_CAP (1u << 18)
__device__ __forceinline__ unsigned xb_ld(unsigned* p)              { return __hip_atomic_load(p, __ATOMIC_RELAXED, __HIP_MEMORY_SCOPE_AGENT); }
__device__ __forceinline__ unsigned xb_add(unsigned* p, unsigned v) { return __hip_atomic_fetch_add(p, v, __ATOMIC_RELAXED, __HIP_MEMORY_SCOPE_AGENT); }
__device__ __forceinline__ unsigned xb_xcc_id() { return (unsigned)__builtin_amdgcn_s_getreg((3 << 11) | 20) & 0xFu; }
#define XB_SPIN(cond, bar) do { unsigned _sp = 0; while (cond) { __builtin_amdgcn_s_sleep(1); \
    if ((++_sp & 255u) == 0u) { if (xb_ld(&(bar)[XB_TMO])) break; if (_sp > XB_SPIN_CAP) { atomicAdd(&(bar)[XB_TMO], 1u); break; } } } } while (0)
struct XcdBarrier { unsigned* bar; unsigned x; volatile LAS unsigned* st; int wave; };
__device__ __forceinline__ XcdBarrier xcd_barrier_post(unsigned* bar, volatile LAS unsigned* st) {
    XcdBarrier b; b.bar = bar; b.x = xb_xcc_id(); b.st = st; b.wave = 0;
    if (threadIdx.x == 0) (void)xb_add(&bar[XB_XCNT(b.x)], 1u);
    return b;
}
__device__ __forceinline__ void xcd_barrier_complete(unsigned* bar, unsigned x, unsigned& nloc, unsigned& nx) {
    const unsigned G = gridDim.x * gridDim.y * gridDim.z;
    unsigned sum, cnt, mine, sp = 0u;
    for (;;) {
        sum = 0u; cnt = 0u; mine = 0u;
#pragma unroll
        for (unsigned j = 0; j < 16; ++j) { const unsigned c = xb_ld(&bar[XB_XCNT(j)]); sum += c; cnt += (c > 0u) ? 1u : 0u; mine = (j == x) ? c : mine; }
        if (sum == G) break;
        __builtin_amdgcn_s_sleep(1);
        if ((++sp & 255u) == 0u) { if (xb_ld(&bar[XB_TMO])) break; if (sp > XB_SPIN_CAP) { atomicAdd(&bar[XB_TMO], 1u); break; } }
    }
    nloc = mine > 0u ? mine : 1u; nx = cnt > 0u ? cnt : 1u;
}
__device__ __forceinline__ void xcd_barrier(const XcdBarrier& b) {
    asm volatile("s_waitcnt vmcnt(0)" ::: "memory");
    __syncthreads();
    if (b.wave == 0 && lane_id() == 0) {
        unsigned* bar = b.bar;
        __builtin_amdgcn_s_waitcnt(0);
        unsigned nloc = b.st[0], nx = b.st[1];
        if (nloc == 0u) { xcd_barrier_complete(bar, b.x, nloc, nx); b.st[0] = nloc; b.st[1] = nx; }
        const unsigned old = xb_add(&bar[XB_XSUB(b.x)], 1u);
        const unsigned gen = old / nloc;
        if (old + 1u == (gen + 1u) * nloc) {
            __builtin_amdgcn_fence(__ATOMIC_RELEASE, "agent");
            asm volatile("s_waitcnt vmcnt(0)" ::: "memory");
            const unsigned og = xb_add(&bar[XB_TOP], 1u);
            const unsigned tg = og / nx;
            if (og + 1u == (tg + 1u) * nx) xb_add(&bar[XB_TOPGEN], 1u);
            else XB_SPIN(xb_ld(&bar[XB_TOPGEN]) == tg, bar);
            __builtin_amdgcn_fence(__ATOMIC_ACQUIRE, "agent");
            xb_add(&bar[XB_XGEN(b.x)], 1u);
            asm volatile("s_waitcnt vmcnt(0)" ::: "memory");
        } else {
            XB_SPIN(xb_ld(&bar[XB_XGEN(b.x)]) == gen, bar);
            __builtin_amdgcn_fence(__ATOMIC_ACQUIRE, "agent");
            asm volatile("s_waitcnt vmcnt(0)" ::: "memory");
        }
    }
    __syncthreads();
}

struct Frame {
    LAS unsigned char* lds;
    volatile LAS unsigned* MISC;
    gu32* ctl;
    int wave;
    int vcu, G;
    float* out;
    unsigned char* ws;
};
struct Args { const float* in[21]; float* out; unsigned char* ws; int ph_lo, ph_hi, li, pad; };
__device__ __forceinline__ const float* arg_in(int i) {
    const __attribute__((address_space(4))) char* ka = (const __attribute__((address_space(4))) char*)__builtin_amdgcn_kernarg_segment_ptr();
    unsigned off = (unsigned)i * 8u; asm volatile("" : "+s"(off));
    return *(const float* const __attribute__((address_space(4)))*)(ka + off);
}
__device__ __forceinline__ float wave_sum(float v) {
#pragma unroll
    for (int o = 1; o < 64; o <<= 1) v += __shfl_xor(v, o);
    return v;
}

struct DenseOrder {
    static constexpr bool GATHER = false;
    int nM, nN, nwg, G, c, extra, ex0, wave; long a_tile, b_tile;
    __device__ void init(int wave_, int nM_, int nN_, int G_, int c_, long a_tile_, long b_tile_, int extra_ = 0, int ex0_ = 0) { wave = wave_; nM = nM_; nN = nN_; nwg = nM * nN; G = G_; c = c_; a_tile = a_tile_; b_tile = b_tile_; extra = extra_; ex0 = ex0_; }
    __device__ bool next(int i, pg8::Unit& u) const {
        const long L = (long)i * G + c; if (L >= nwg + extra) return false;
        if (L >= nwg) { u.pm = nM; u.pn = ex0 + (int)(L - nwg); }
        else {
            int wgid = (int)L; { const int q = nwg / pg8::NXCD, r = nwg % pg8::NXCD, xcd = wgid % pg8::NXCD, off = wgid / pg8::NXCD; wgid = (xcd < r ? xcd * (q + 1) : r * (q + 1) + (xcd - r) * q) + off; }
            const int nig = pg8::WGM * nN, gid = wgid / nig, fm = gid * pg8::WGM, gsz = (nM - fm) < pg8::WGM ? (nM - fm) : pg8::WGM;
            u.pm = fm + ((wgid % nig) % gsz); u.pn = (wgid % nig) / gsz;
        }
        u.a_byte = (long)u.pm * a_tile; u.b_byte = (long)u.pn * b_tile; u.e = 0; u.mt = 0; u.cnt = 0; return true;
    }
    __device__ __forceinline__ unsigned row_byte(const pg8::Unit&, int) const { return 0u; }
    __device__ __forceinline__ void a_ready(const pg8::Unit&) const {}
};
__device__ __forceinline__ void wait_count(unsigned* word, unsigned need, unsigned* tmo) {
    unsigned sp = 0;
    while ((unsigned)__builtin_amdgcn_readfirstlane((int)__hip_atomic_load(word, RLX_AGENT)) < need) {
        __builtin_amdgcn_s_sleep(2);
        if (++sp > (1u << 22)) { if (lane_id() == 0) __hip_atomic_store(tmo, 1u, RLX_AGENT); break; }
    }
    __builtin_amdgcn_fence(__ATOMIC_ACQUIRE, "agent");
    asm volatile("s_waitcnt vmcnt(0)" ::: "memory");
}
struct DenseOrderDep : DenseOrder {
    unsigned* rdy; unsigned need; unsigned* tmo;
    __device__ __forceinline__ void a_ready(const pg8::Unit& u) const {
        if (wave == 0) wait_count(rdy + 64 * u.pm, need, tmo);
        asm volatile("" ::: "memory"); __builtin_amdgcn_s_barrier(); asm volatile("" ::: "memory");
    }
};
template <int NT, bool GATH>
struct MoeOrder {
    static constexpr bool GATHER = GATH;
    int wave; volatile LAS int* tp; volatile LAS int* cn; int G, c; long b_exp, b_tile, a_tile; const int* rowidx; unsigned row_bytes;
    __device__ bool next(int i, pg8::Unit& u) const {
        const int total = __builtin_amdgcn_readfirstlane(tp[32]) * NT;
        const long L = (long)i * G + c; if (L >= total) return false;
        const int T = (int)(L / NT), n = (int)(L % NT);
        const int l_ = lane_id(); const int tv_ = tp[l_ & 31];
        const int e = (int)__builtin_popcountll(__ballot(l_ >= 1 && l_ < 32 && tv_ <= T));
        u.e = e; u.mt = T - __builtin_amdgcn_readfirstlane(tp[e]); u.cnt = __builtin_amdgcn_readfirstlane(cn[e]); u.pm = T; u.pn = n;
        u.a_byte = GATH ? 0 : (long)T * a_tile; u.b_byte = (long)e * b_exp + (long)n * b_tile; return true;
    }
    __device__ __forceinline__ unsigned row_byte(const pg8::Unit& u, int r) const {
        const int pos = u.mt * 256 + r;
        int tk = 0; if (pos < u.cnt) tk = rowidx[u.e * MREAL + pos];
        return (unsigned)(tk >> 1) * row_bytes;
    }
    __device__ __forceinline__ void a_ready(const pg8::Unit&) const {}
};
struct MoeDownOrder {
    static constexpr bool GATHER = false;
    int wave; volatile LAS int* tp; volatile LAS int* cn; int G, c; long b_exp, b_tile, a_tile; unsigned* rdy; unsigned* wd; unsigned* tmo;
    __device__ bool next(int i, pg8::Unit& u) const {
        const int T = __builtin_amdgcn_readfirstlane(tp[32]);
        const int T1 = T < G / 4 ? T : G / 4, nb2 = 4 * T > G ? 4 * T - G : 0;
        int Tt, n;
        if (c >= nb2) { const int j = (c - nb2) + i * (G - nb2); if (j >= 8 * T1) return false; Tt = j >> 3; n = j & 7; }
        else { const int j = c + i * nb2; if (j >= 8 * (T - T1)) return false; Tt = T1 + (j >> 3); n = j & 7; }
        const int l_ = lane_id(); const int tv_ = tp[l_ & 31];
        const int e = (int)__builtin_popcountll(__ballot(l_ >= 1 && l_ < 32 && tv_ <= Tt));
        u.e = e; u.mt = Tt - __builtin_amdgcn_readfirstlane(tp[e]); u.cnt = __builtin_amdgcn_readfirstlane(cn[e]); u.pm = Tt; u.pn = n;
        u.a_byte = (long)Tt * a_tile; u.b_byte = (long)e * b_exp + (long)n * b_tile; return true;
    }
    __device__ __forceinline__ unsigned row_byte(const pg8::Unit&, int) const { return 0u; }
    __device__ __forceinline__ void a_ready(const pg8::Unit& u) const {
        if (wave == 0) {
            unsigned sp = 0;
            while ((unsigned)__builtin_amdgcn_readfirstlane((int)__hip_atomic_load(rdy + 64 * u.pm, RLX_AGENT)) < 32u) {
                __builtin_amdgcn_s_sleep(2);
                if (++sp > (1u << 22)) { if (lane_id() == 0) __hip_atomic_store(tmo, 1u, RLX_AGENT); break; }
            }
            __builtin_amdgcn_fence(__ATOMIC_ACQUIRE, "agent");
            asm volatile("s_waitcnt vmcnt(0)" ::: "memory");
        }
        asm volatile("" ::: "memory"); __builtin_amdgcn_s_barrier(); asm volatile("" ::: "memory");
    }
};

__device__ __forceinline__ void st16_wt(void* p, v4u v) { asm volatile("global_store_dwordx4 %0, %1, off sc1\n\ts_nop 1" :: "v"(p), "v"(v) : "memory"); }
using pg8::Unit; using pg8::HALF; using pg8::BM;
struct EpiBf16 {
    static constexpr bool PERM = true, MID = false;
    bf16* O; int ldc; int pp_lo, pp_hi, pp_col, sg_lo;
    __device__ __forceinline__ void mid(f32x4 (&)[2][2][4][2], const Unit&, int, int, int, int) const {}
    __device__ __forceinline__ void operator()(const f32x4 (&acc)[2][2][4][2], const Unit& u, int wr, int wc, int fr, int fq) const {
        const int row0 = u.pm * BM + wr * 64 + fr, col0 = u.pn * BM + wc * 32 + 8 * fq;
        if (pp_lo <= u.pn && u.pn < pp_hi) {
            const int pc = pp_col + (u.pn - pp_lo) * HALF + wc * 32 + 8 * fq;
#pragma unroll
            for (int ai = 0; ai < 2; ++ai)
#pragma unroll
                for (int m = 0; m < 4; ++m) { bf16* rowp = O + (size_t)(row0 + ai * HALF + m * 16) * ldc + pc;
                    const f32x4 v0 = acc[ai][0][m][0] * acc[ai][1][m][0], v1 = acc[ai][0][m][1] * acc[ai][1][m][1];
                    v4u w; w.x = cvt_pk_bf16(v0[0], v0[1]); w.y = cvt_pk_bf16(v0[2], v0[3]); w.z = cvt_pk_bf16(v1[0], v1[1]); w.w = cvt_pk_bf16(v1[2], v1[3]);
                    *(v4u*)rowp = w; }
            return;
        }
        const bool sg = u.pn >= sg_lo;
#pragma unroll
        for (int ai = 0; ai < 2; ++ai)
#pragma unroll
            for (int m = 0; m < 4; ++m) { bf16* rowp = O + (size_t)(row0 + ai * HALF + m * 16) * ldc + col0;
#pragma unroll
                for (int bj = 0; bj < 2; ++bj) { f32x4 v0 = acc[ai][bj][m][0], v1 = acc[ai][bj][m][1];
                    if (sg) {
#pragma unroll
                        for (int j = 0; j < 4; ++j) { v0[j] = __builtin_amdgcn_rcpf(1.0f + __expf(-v0[j])); v1[j] = __builtin_amdgcn_rcpf(1.0f + __expf(-v1[j])); } }
                    v4u w; w.x = cvt_pk_bf16(v0[0], v0[1]); w.y = cvt_pk_bf16(v0[2], v0[3]); w.z = cvt_pk_bf16(v1[0], v1[1]); w.w = cvt_pk_bf16(v1[2], v1[3]);
                    *(v4u*)(rowp + bj * HALF) = w; } }
    }
};
__device__ __forceinline__ float sigm(float x) { return __builtin_amdgcn_rcpf(1.0f + __expf(-x)); }
struct EpiGate {
    static constexpr bool PERM = true, MID = true;
    bf16* P; bf16* MRG; unsigned* rdy;
    __device__ __forceinline__ void mid(f32x4 (&acc)[2][2][4][2], const Unit& u, int wr, int wc, int fr, int fq) const {
        int row0 = u.pm * BM + wr * 64 + fr, col0 = u.pn * BM + wc * 32 + 8 * fq;
        asm volatile("" : "+v"(row0), "+v"(col0));
#pragma unroll
        for (int ai = 0; ai < 2; ++ai)
#pragma unroll
            for (int m = 0; m < 4; ++m) { const bf16* rowp = P + (size_t)(row0 + ai * HALF + m * 16) * LDP + col0;
#pragma unroll
                for (int bj = 0; bj < 2; ++bj) { const v4u a = *(const v4u*)(rowp + PC_GA + bj * HALF), c = *(const v4u*)(rowp + PC_GC + bj * HALF);
                    const unsigned aw[4] = {a.x, a.y, a.z, a.w}, cw[4] = {c.x, c.y, c.z, c.w};
#pragma unroll
                    for (int q = 0; q < 4; ++q) {
                        const float r0 = bf_lo(aw[q]) * __builtin_amdgcn_rcpf(bf_lo(cw[q]));
                        const float r1 = bf_hi(aw[q]) * __builtin_amdgcn_rcpf(bf_hi(cw[q]));
                        acc[ai][bj][m][q >> 1][(q & 1) * 2] *= r0; acc[ai][bj][m][q >> 1][(q & 1) * 2 + 1] *= r1; } }
                asm volatile("" ::: "memory"); }
    }
    __device__ __forceinline__ void operator()(const f32x4 (&acc)[2][2][4][2], const Unit& u, int wr, int wc, int fr, int fq) const {
        const int row0 = u.pm * BM + wr * 64 + fr, col0 = u.pn * BM + wc * 32 + 8 * fq;
#pragma unroll
        for (int ai = 0; ai < 2; ++ai)
#pragma unroll
            for (int m = 0; m < 4; ++m) { bf16* rowp = P + (size_t)(row0 + ai * HALF + m * 16) * LDP + col0;
#pragma unroll
                for (int bj = 0; bj < 2; ++bj) { const v4u c = *(const v4u*)(rowp + PC_GC + bj * HALF); const unsigned cw[4] = {c.x, c.y, c.z, c.w};
                    const f32x4 v0 = acc[ai][bj][m][0], v1 = acc[ai][bj][m][1];
                    v4u w;
                    w.x = cvt_pk_bf16(v0[0] * bf_lo(cw[0]), v0[1] * bf_hi(cw[0])); w.y = cvt_pk_bf16(v0[2] * bf_lo(cw[1]), v0[3] * bf_hi(cw[1]));
                    w.z = cvt_pk_bf16(v1[0] * bf_lo(cw[2]), v1[1] * bf_hi(cw[2])); w.w = cvt_pk_bf16(v1[2] * bf_lo(cw[3]), v1[3] * bf_hi(cw[3]));
                    bf16* mp = MRG + (size_t)(row0 + ai * HALF + m * 16) * DM + col0 + bj * HALF;
                    if (rdy) st16_wt(mp, w); else *(v4u*)mp = w; }
                asm volatile("" ::: "memory"); }
        if (rdy) { asm volatile("s_waitcnt vmcnt(0)" ::: "memory"); if (fr == 0 && fq == 0) __hip_atomic_fetch_add(rdy + 64 * u.pm, 1u, RLX_AGENT); }
    }
};
struct EpiPre {
    static constexpr bool PERM = true, MID = false;
    const bf16* XN; bf16* pre; int ldo; unsigned* rdy;
    __device__ __forceinline__ void mid(f32x4 (&)[2][2][4][2], const Unit&, int, int, int, int) const {}
    __device__ __forceinline__ void operator()(const f32x4 (&acc)[2][2][4][2], const Unit& u, int wr, int wc, int fr, int fq) const {
        const int row0 = u.pm * BM + wr * 64 + fr, col0 = u.pn * BM + wc * 32 + 8 * fq;
#pragma unroll
        for (int ai = 0; ai < 2; ++ai)
#pragma unroll
            for (int m = 0; m < 4; ++m) { const int r = row0 + ai * HALF + m * 16; const bf16* xr = XN + (size_t)r * DM + col0; bf16* orow = pre + (size_t)r * ldo + col0;
#pragma unroll
                for (int bj = 0; bj < 2; ++bj) { const v4u h = *(const v4u*)(xr + bj * HALF); const f32x4 a0 = acc[ai][bj][m][0], a1 = acc[ai][bj][m][1];
                    v4u o; o.x = cvt_pk_bf16(ALPHA * bf_lo(h.x) + a0[0], ALPHA * bf_hi(h.x) + a0[1]); o.y = cvt_pk_bf16(ALPHA * bf_lo(h.y) + a0[2], ALPHA * bf_hi(h.y) + a0[3]);
                    o.z = cvt_pk_bf16(ALPHA * bf_lo(h.z) + a1[0], ALPHA * bf_hi(h.z) + a1[1]); o.w = cvt_pk_bf16(ALPHA * bf_lo(h.w) + a1[2], ALPHA * bf_hi(h.w) + a1[3]);
                    if (rdy) st16_wt(orow + bj * HALF, o); else *(v4u*)(orow + bj * HALF) = o; } }
        if (rdy) { asm volatile("s_waitcnt vmcnt(0)" ::: "memory"); if (fr == 0 && fq == 0) __hip_atomic_fetch_add(rdy + 64 * u.pm, 1u, RLX_AGENT); }
    }
};
struct EpiAct {
    static constexpr bool PERM = true, MID = false;
    bf16* act; unsigned* rdy;
    __device__ __forceinline__ void mid(f32x4 (&)[2][2][4][2], const Unit&, int, int, int, int) const {}
    __device__ __forceinline__ void operator()(const f32x4 (&acc)[2][2][4][2], const Unit& u, int wr, int wc, int fr, int fq) const {
        const int row0 = u.pm * BM + wr * 64 + fr, col0 = u.pn * HALF + wc * 32 + 8 * fq;
#pragma unroll
        for (int ai = 0; ai < 2; ++ai)
#pragma unroll
            for (int m = 0; m < 4; ++m) { bf16* rowp = act + (size_t)(row0 + ai * HALF + m * 16) * DE + col0;
                float o[8];
#pragma unroll
                for (int n = 0; n < 2; ++n)
#pragma unroll
                    for (int j = 0; j < 4; ++j) { const float gt = acc[ai][0][m][n][j], up = acc[ai][1][m][n][j]; o[n * 4 + j] = gt * sigm(gt) * up; }
                v4u w; w.x = cvt_pk_bf16(o[0], o[1]); w.y = cvt_pk_bf16(o[2], o[3]); w.z = cvt_pk_bf16(o[4], o[5]); w.w = cvt_pk_bf16(o[6], o[7]);
                if (MK_MOE_MERGE && N_LAUNCHES == 1) st16_wt(rowp, w); else *(v4u*)rowp = w; }
        if (MK_MOE_MERGE && N_LAUNCHES == 1) {
            asm volatile("s_waitcnt vmcnt(0)" ::: "memory");
            if (fr == 0 && fq == 0) __hip_atomic_fetch_add(rdy + 64 * u.pm, 1u, RLX_AGENT);
        }
    }
};
struct EpiDown {
    static constexpr bool PERM = true, MID = false;
    bf16* Y;
    __device__ __forceinline__ void mid(f32x4 (&)[2][2][4][2], const Unit&, int, int, int, int) const {}
    __device__ __forceinline__ void operator()(const f32x4 (&acc)[2][2][4][2], const Unit& u, int wr, int wc, int fr, int fq) const {
        const int row0 = u.pm * BM + wr * 64 + fr, col0 = u.pn * BM + wc * 32 + 8 * fq;
#pragma unroll
        for (int ai = 0; ai < 2; ++ai)
#pragma unroll
            for (int m = 0; m < 4; ++m) { bf16* rowp = Y + (size_t)(row0 + ai * HALF + m * 16) * DM + col0;
#pragma unroll
                for (int bj = 0; bj < 2; ++bj) { const f32x4 v0 = acc[ai][bj][m][0], v1 = acc[ai][bj][m][1];
                    v4u o; o.x = cvt_pk_bf16(v0[0], v0[1]); o.y = cvt_pk_bf16(v0[2], v0[3]); o.z = cvt_pk_bf16(v1[0], v1[1]); o.w = cvt_pk_bf16(v1[2], v1[3]);
                    *(v4u*)(rowp + bj * HALF) = o; } }
    }
};

struct ConvTile { const float* src; bf16* dst0; bf16* dst1; int ld_src, ld_dst; };
constexpr int CT_A = CT_IN;
constexpr int CT_B = 3 * CT_SQ + 2 * CT_GU + CT_DN;
constexpr int CT_PITCH = 144, CT_BUF = 256 * CT_PITCH;
__device__ __forceinline__ ConvTile conv_tile_a(int r, unsigned char* ws) {
    const int nt = r >> 5, kg = r & 31, ns = nt * 256, k0 = 64 * kg;
    int nn = ns; if (ns >= 2048 && ns < 2560) nn = ns + 2048; else if (ns >= 2560 && ns < 4608) nn = ns - 512;
    bf16* d = (bf16*)(ws + WS_WIN) + (size_t)nn * DM + k0; bf16* d1 = d + (size_t)128 * DM;
    if (ns >= PC_CC && ns < PC_GA) {
        const int ch = ns >= PC_CH ? 1 : 0, sidx = (ns - (ch ? PC_CH : PC_CC)) >> 8;
        d = (bf16*)(ws + WS_WIN) + (size_t)(256 * (18 + 2 * sidx) + 128 * ch) * DM + k0; d1 = d + (size_t)256 * DM; }
    return ConvTile{arg_in(4) + (size_t)k0 * LDP + ns, d, d1, LDP, DM};
}
__device__ __forceinline__ ConvTile conv_tile_b(int r, unsigned char* ws) {
    bf16* Wb2_t = (bf16*)(ws + WS_WB2); bf16* Wout_t = (bf16*)(ws + WS_WOUT); bf16* Wgu_t = (bf16*)(ws + WS_WGU); bf16* Wd_t = (bf16*)(ws + WS_WD);
    if (r < 2 * CT_SQ) { const int cv = r >= CT_SQ ? 1 : 0; r -= cv * CT_SQ; const int nt = r >> 5, k0 = 64 * (r & 31), n = nt * 256;
        bf16* d = Wb2_t + (size_t)n * 4096 + cv * 2048 + k0; return ConvTile{arg_in(7 + cv) + (size_t)k0 * DM + n, d, d + (size_t)128 * 4096, DM, 4096}; }
    r -= 2 * CT_SQ;
    if (r < CT_SQ) { const int nt = r >> 5, k0 = 64 * (r & 31), n = nt * 256; bf16* d = Wout_t + (size_t)n * DM + k0; return ConvTile{arg_in(9) + (size_t)k0 * DM + n, d, d + (size_t)128 * DM, DM, DM}; }
    r -= CT_SQ;
    if (r < 2 * CT_GU) { const int up = r >= CT_GU ? 1 : 0; r -= up * CT_GU; const int e = r >> 6, q = r & 63, nt = q >> 5, k0 = 64 * (q & 31), n = nt * 256;
        bf16* d = Wgu_t + ((size_t)e * 1024 + (size_t)(n >> 7) * 256 + up * 128) * DM + k0;
        return ConvTile{arg_in(16 + up) + (size_t)e * DM * DE + (size_t)k0 * DE + n, d, d + (size_t)256 * DM, DE, DM}; }
    r -= 2 * CT_GU;
    { const int e = r >> 6, q = r & 63, nt = q >> 3, k0 = 64 * (q & 7), n = nt * 256;
      bf16* d = Wd_t + ((size_t)e * DM + n) * DE + k0; return ConvTile{arg_in(18) + (size_t)e * DE * DM + (size_t)k0 * DM + n, d, d + (size_t)128 * DE, DM, DE}; }
}
struct ConvRegs { f32x4 v[8]; };
__device__ __forceinline__ void conv_load(ConvRegs& R, const ConvTile& t, int w, int lane) {
    const float* p = t.src + (size_t)(8 * w) * t.ld_src + 4 * lane;
#pragma unroll
    for (int i = 0; i < 8; ++i) R.v[i] = __builtin_nontemporal_load((const f32x4*)(p + (size_t)i * t.ld_src));
}
__device__ __forceinline__ void conv_lds_write(const ConvRegs& R, LAS unsigned char* buf, int w, int lane) {
#pragma unroll
    for (int j = 0; j < 4; ++j) { v4u o; o.x = cvt_pk_bf16(R.v[0][j], R.v[1][j]); o.y = cvt_pk_bf16(R.v[2][j], R.v[3][j]); o.z = cvt_pk_bf16(R.v[4][j], R.v[5][j]); o.w = cvt_pk_bf16(R.v[6][j], R.v[7][j]);
        *(LAS v4u*)(buf + (4 * lane + j) * CT_PITCH + 16 * w) = o; }
}
template <bool WT>
__device__ __forceinline__ void conv_store(const ConvTile& t, LAS const unsigned char* buf, int w, int lane) {
    const int c = lane & 7, nr = 8 * w + (lane >> 3);
#pragma unroll
    for (int p = 0; p < 4; ++p) { const int n = nr + 64 * p; const v4u o = *(LAS const v4u*)(buf + n * CT_PITCH + 16 * c);
        bf16* d = (p < 2 ? t.dst0 + (size_t)n * t.ld_dst : t.dst1 + (size_t)(n - 128) * t.ld_dst) + 8 * c;
        if (WT) st16_wt(d, o); else *(GAS v4u*)d = o; }
}
template <int LIST, bool WT = false>
__device__ __forceinline__ void conv_run(int first, int last, int stride, unsigned char* ws, LAS unsigned char* lds, int w, int lane, int& par) {
    if (first >= last) return;
    ConvTile t0 = LIST ? conv_tile_b(first, ws) : conv_tile_a(first, ws), t1 = t0;
    ConvRegs r0, r1;
    conv_load(r0, t0, w, lane);
    r1 = r0;
    for (int it = first; it < last; it += stride) {
        const int nx = it + stride;
        if (nx < last) { t1 = LIST ? conv_tile_b(nx, ws) : conv_tile_a(nx, ws); conv_load(r1, t1, w, lane); }
        LAS unsigned char* buf = lds + par * CT_BUF; par ^= 1;
        conv_lds_write(r0, buf, w, lane);
        __syncthreads();
        conv_store<WT>(t0, buf, w, lane);
        r0 = r1; t0 = t1;
    }
}
constexpr int CT_CHUNK = 4;
constexpr int CT_B1 = 3 * CT_SQ + 2 * CT_GU;
template <bool WT = false>
__device__ __forceinline__ void conv_queue(unsigned* qhead, int lo, int hi, unsigned char* ws, LAS unsigned char* lds, volatile LAS unsigned* slot, int w, int lane, unsigned* done = nullptr) {
    int par = 0;
    for (;;) {
        __syncthreads();
        if (w == 0 && lane == 0) slot[0] = __hip_atomic_fetch_add(qhead, (unsigned)CT_CHUNK, RLX_AGENT);
        __syncthreads();
        const int base = lo + __builtin_amdgcn_readfirstlane((int)slot[0]);
        if (base >= hi) break;
        const int end = base + CT_CHUNK < hi ? base + CT_CHUNK : hi;
        conv_run<1, WT>(base, end, 1, ws, lds, w, lane, par);
        if (WT) {
            asm volatile("s_waitcnt vmcnt(0)" ::: "memory");
            __syncthreads();
            if (w == 0 && lane == 0) __hip_atomic_fetch_add(done, (unsigned)(end - base), RLX_AGENT);
        }
    }
}
__device__ __forceinline__ void ln_regs_to_bf16(f32x4 (&v)[8], const float* g, const float* b, bf16* orow, int lane) {
    asm volatile("" : "+v"(lane));
    float s = 0.f;
#pragma unroll
    for (int j = 0; j < 8; ++j) s += (v[j][0] + v[j][1]) + (v[j][2] + v[j][3]);
    const float mean = wave_sum(s) * (1.f / DM); float s2 = 0.f;
#pragma unroll
    for (int j = 0; j < 8; ++j) { v[j] = v[j] - mean; s2 += (v[j][0] * v[j][0] + v[j][1] * v[j][1]) + (v[j][2] * v[j][2] + v[j][3] * v[j][3]); }
    const float rstd = 1.f / sqrtf(wave_sum(s2) * (1.f / DM) + LN_EPS);
    v2u* o8 = (v2u*)orow + lane;
#pragma unroll
    for (int j = 0; j < 8; ++j) { const f32x4 gg = ((const f32x4*)g)[lane + 64 * j], bb = ((const f32x4*)b)[lane + 64 * j]; const f32x4 y = v[j] * rstd * gg + bb;
        v2u w; w.x = pk2(y[0], y[1]); w.y = pk2(y[2], y[3]); o8[64 * j] = w; }
}
__device__ __forceinline__ void ln_row_to_bf16(const float* xrow, const float* g, const float* b, bf16* orow, int lane) {
    asm volatile("" : "+v"(lane));
    const f32x4* xr = (const f32x4*)xrow + lane;
    f32x4 v[8]; float s = 0.f;
#pragma unroll
    for (int j = 0; j < 8; ++j) { v[j] = xr[64 * j]; s += (v[j][0] + v[j][1]) + (v[j][2] + v[j][3]); }
    const float mean = wave_sum(s) * (1.f / DM); float s2 = 0.f;
#pragma unroll
    for (int j = 0; j < 8; ++j) { v[j] = v[j] - mean; s2 += (v[j][0] * v[j][0] + v[j][1] * v[j][1]) + (v[j][2] * v[j][2] + v[j][3] * v[j][3]); }
    const float rstd = 1.f / sqrtf(wave_sum(s2) * (1.f / DM) + LN_EPS);
    v2u* o8 = (v2u*)orow + lane;
#pragma unroll
    for (int j = 0; j < 8; ++j) { const f32x4 gg = ((const f32x4*)g)[lane + 64 * j], bb = ((const f32x4*)b)[lane + 64 * j]; const f32x4 y = v[j] * rstd * gg + bb;
        v2u w; w.x = pk2(y[0], y[1]); w.y = pk2(y[2], y[3]); o8[64 * j] = w; }
}
__device__ __forceinline__ void p0_prologue(Frame& F, const Args& A) {
    const int lane0 = lane_id(), tid0 = F.wave * 64 + lane0;
    const int gw = F.vcu * NWAVES + F.wave, NGW = F.G * NWAVES;
    bf16* XN = (bf16*)(F.ws + WS_XN);
    { int par = 0; conv_run<0>((int)blockIdx.x, CT_A, F.G, F.ws, F.lds + RING_OFF, F.wave, lane0, par); __syncthreads(); }
    { bf16* whi = (bf16*)(F.ws + WS_REWG); bf16* wlo = whi + 48 * DM; const float* rgw = arg_in(12); const float* rew = arg_in(14);
      for (int i = (F.vcu * NWAVES * 64) + tid0; i < 48 * DM; i += F.G * NWAVES * 64) { const int n = i / DM, k = i % DM;
          const float w = n < NGRP ? rgw[k * NGRP + n] : (n < NGRP + NEXP ? rew[k * NEXP + (n - NGRP)] : 0.f);
          const unsigned hi = f2bf(w); const float rem = w - __builtin_bit_cast(float, hi << 16);
          whi[i] = (bf16)hi; wlo[i] = (bf16)f2bf(rem); } }
    {
        const float* xin = arg_in(0); const float* g = arg_in(2); const float* b = arg_in(3);
        f32x4 va[8], vb[8];
        int m = gw;
        if (m < MREAL) {
#pragma unroll
            for (int j = 0; j < 8; ++j) va[j] = ((const f32x4*)(xin + (size_t)m * DM))[lane0 + 64 * j];
        }
        for (; m < MREAL; m += 2 * NGW) {
            const int m1 = m + NGW, m2 = m + 2 * NGW;
            if (m1 < MREAL) {
#pragma unroll
                for (int j = 0; j < 8; ++j) vb[j] = ((const f32x4*)(xin + (size_t)m1 * DM))[lane0 + 64 * j];
            }
            ln_regs_to_bf16(va, g, b, XN + (size_t)m * DM, lane0);
            if (m2 < MREAL) {
#pragma unroll
                for (int j = 0; j < 8; ++j) va[j] = ((const f32x4*)(xin + (size_t)m2 * DM))[lane0 + 64 * j];
            }
            if (m1 < MREAL) ln_regs_to_bf16(vb, g, b, XN + (size_t)m1 * DM, lane0);
        }
    }
    for (int m = MREAL + gw; m < MPAD; m += NGW) {
        if (m < MREAL + NMETA) ln_row_to_bf16(arg_in(1) + (size_t)(m - MREAL) * DM, arg_in(2), arg_in(3), XN + (size_t)m * DM, lane0);
        else { v2u* o8 = (v2u*)(XN + (size_t)m * DM) + lane0;
#pragma unroll
            for (int j = 0; j < 8; ++j) o8[64 * j] = (v2u){0u, 0u}; }
    }
}

constexpr int KS_PITCH = 144;
constexpr int VT_PITCH = 584;
constexpr int KROWS = 288;
constexpr int ATT_KS = 0, ATT_VT = KROWS * KS_PITCH, ATT_LDS = ATT_VT + 64 * VT_PITCH;
static_assert(ATT_LDS <= RING_BYTES, "attention LDS");
constexpr float LOG2E = 1.4426950408889634f;

template <int R>
__device__ __forceinline__ void attn_qblock(LAS const unsigned char* lds, bf16* P, int qrow0, int head, float sink_l2, bool has_prev, int lane) {
    asm volatile("" : "+v"(lane));
    const int ql = lane & 31, hh = lane >> 5;
    bf16* qp = P + (size_t)(qrow0 + 32 * R + ql) * LDP + PC_Q + head * HD;
    bf16x8 qf[4];
#pragma unroll
    for (int s = 0; s < 4; ++s) qf[s] = *(const bf16x8*)(qp + 16 * s + 8 * hh);
    f32x16 S[6];
#define KB_ROW(i) ((i) == 0 ? 0 : ((i) <= 4 - R ? 32 + 32 * (R + (i) - 1) : 160 + 32 * ((i) - (5 - R))))
#pragma unroll
    for (int i = 0; i < 6; ++i) {
        const int kr = KB_ROW(i);
        f32x16 a = {0.f, 0.f, 0.f, 0.f, 0.f, 0.f, 0.f, 0.f, 0.f, 0.f, 0.f, 0.f, 0.f, 0.f, 0.f, 0.f};
        const LAS unsigned char* kp = lds + ATT_KS + (kr + ql) * KS_PITCH + 16 * hh;
#pragma unroll
        for (int s = 0; s < 4; ++s) { const bf16x8 kf = *(const LAS bf16x8*)(kp + 32 * s); a = __builtin_amdgcn_mfma_f32_32x32x16_bf16(kf, qf[s], a, 0, 0, 0); }
        S[i] = a;
    }
    const float NEG = -INFINITY; const float sc = 0.125f * LOG2E;
    float mx = sink_l2;
#pragma unroll
    for (int i = 0; i < 6; ++i)
#pragma unroll
        for (int r = 0; r < 16; ++r) {
            const int kvl = (r & 3) + 8 * (r >> 2) + 4 * hh;
            float t = S[i][r] * sc;
            bool ok = true;
            if (i == 0) ok = kvl < NMETA;
            else if (i <= 4 - R) { ok = has_prev; if (i == 1) ok = ok && (kvl > ql); }
            else { if (i == 5) ok = (kvl <= ql); }
            t = ok ? t : NEG; S[i][r] = t; mx = fmaxf(mx, t);
        }
    mx = fmaxf(mx, __shfl_xor(mx, 32));
    float l = 0.f;
#pragma unroll
    for (int i = 0; i < 6; ++i)
#pragma unroll
        for (int r = 0; r < 16; ++r) { const float p = __builtin_amdgcn_exp2f(S[i][r] - mx); S[i][r] = p; l += p; }
    l += __shfl_xor(l, 32);
    l += __builtin_amdgcn_exp2f(sink_l2 - mx);
    const float inv = 1.0f / l;
    f32x16 O[2];
#pragma unroll
    for (int d = 0; d < 2; ++d) O[d] = (f32x16){0.f, 0.f, 0.f, 0.f, 0.f, 0.f, 0.f, 0.f, 0.f, 0.f, 0.f, 0.f, 0.f, 0.f, 0.f, 0.f};
#pragma unroll
    for (int i = 0; i < 6; ++i) {
        const int kr = KB_ROW(i);
#pragma unroll
        for (int s2 = 0; s2 < 2; ++s2) {
            unsigned pw[4];
#pragma unroll
            for (int j = 0; j < 4; ++j) pw[j] = cvt_pk_bf16(S[i][8 * s2 + 2 * j] * inv, S[i][8 * s2 + 2 * j + 1] * inv);
            const v4u pv = {pw[0], pw[1], pw[2], pw[3]};
            const bf16x8 pf = __builtin_bit_cast(bf16x8, pv);
#pragma unroll
            for (int d = 0; d < 2; ++d) {
                const LAS unsigned char* vp = lds + ATT_VT + (ql + 32 * d) * VT_PITCH + (kr + 16 * s2 + 4 * hh) * 2;
                const v2u lo = *(const LAS v2u*)vp, hi = *(const LAS v2u*)(vp + 16);
                const v4u vv = {lo.x, lo.y, hi.x, hi.y};
                O[d] = __builtin_amdgcn_mfma_f32_32x32x16_bf16(pf, __builtin_bit_cast(bf16x8, vv), O[d], 0, 0, 0);
            }
        }
    }
#undef KB_ROW
#pragma unroll
    for (int d = 0; d < 2; ++d)
#pragma unroll
        for (int r = 0; r < 16; ++r) { const int q = (r & 3) + 8 * (r >> 2) + 4 * hh;
            P[(size_t)(qrow0 + 32 * R + q) * LDP + PC_Q + head * HD + 32 * d + ql] = (bf16)f2bf(O[d][r]); }
}

__device__ __forceinline__ f32x4 conv_p(v2u a) { return (f32x4){bf_lo(a.x), bf_hi(a.x), bf_lo(a.y), bf_hi(a.y)}; }
__device__ __forceinline__ void p2_attention_conv(Frame& F, const Args& A) {
    bf16* P = (bf16*)(F.ws + WS_P);
    const float* sinks = arg_in(5);
    const float* cw = arg_in(6);
    const int lane0 = lane_id(), tid0 = F.wave * 64 + lane0;
    const int c0 = 4 * tid0;
    for (int it = blockIdx.x; it < BATCH * NKVH * (SEQ / WIN); it += F.G) {
        const int b = it / (NKVH * 16), kvh = (it / 16) % NKVH, nb = it % 16;
        const int row_own = b * SEQ + nb * WIN, row_prev = row_own - WIN;
        const int r0 = it * 32, s0 = r0 % SEQ;
        const int rm2 = (s0 == 0) ? MREAL + NMETA - 2 : r0 - 2, rm1 = (s0 == 0) ? MREAL + NMETA - 1 : r0 - 1;
        const f32x4 w0 = *(const f32x4*)(cw + c0), w1 = *(const f32x4*)(cw + DM + c0), w2 = *(const f32x4*)(cw + 2 * DM + c0);
        const v2u a2 = *(const v2u*)(P + (size_t)rm2 * LDP + PC_CC + c0);
        const v2u a1 = *(const v2u*)(P + (size_t)rm1 * LDP + PC_CC + c0);
        __syncthreads();
        v4u kq[5], vq[5];
#pragma unroll
        for (int i = 0; i < 5; ++i) { const int q = tid0 + i * (NWAVES * 64); const int row = q >> 3, c = q & 7;
            int grow = -1;
            if (row < NMETA) grow = MREAL + row;
            else if (row >= 32 && row < 160) { if (nb > 0) grow = row_prev + (row - 32); }
            else if (row >= 160 && row < KROWS) grow = row_own + (row - 160);
            kq[i] = (v4u){0u, 0u, 0u, 0u}; vq[i] = (v4u){0u, 0u, 0u, 0u};
            if (grow >= 0) { const bf16* rp = P + (size_t)grow * LDP; kq[i] = *(const v4u*)(rp + PC_K + kvh * HD + 8 * c); vq[i] = *(const v4u*)(rp + PC_V + kvh * HD + 8 * c); } }
#pragma unroll
        for (int i = 0; i < 5; ++i) { const int q = tid0 + i * (NWAVES * 64); const int row = q >> 3, c = q & 7;
            if (q < KROWS * 8) {
                *(LAS v4u*)(F.lds + ATT_KS + row * KS_PITCH + c * 16) = kq[i];
                const unsigned vw[4] = {vq[i].x, vq[i].y, vq[i].z, vq[i].w};
#pragma unroll
                for (int e = 0; e < 4; ++e) {
                    *(LAS unsigned short*)(F.lds + ATT_VT + (8 * c + 2 * e) * VT_PITCH + row * 2) = (unsigned short)(vw[e] & 0xffffu);
                    *(LAS unsigned short*)(F.lds + ATT_VT + (8 * c + 2 * e + 1) * VT_PITCH + row * 2) = (unsigned short)(vw[e] >> 16);
                } } }
        __syncthreads();
        const int head = kvh * 8 + F.wave;
        const float sink_l2 = sinks[head] * LOG2E;
        f32x4 pm2 = conv_p(a2), pm1 = conv_p(a1);
        const unsigned voff0 = (unsigned)c0 * 2u;
#define P2_STEP(R) do { \
            unsigned voff = voff0; asm volatile("" : "+v"(voff)); \
            v2u ca[8], cbb[8]; \
            _Pragma("unroll") for (int i = 0; i < 8; ++i) { const char* rp = (const char*)(P + (size_t)(r0 + 8 * (R) + i) * LDP);     \
                ca[i] = *(const v2u*)(rp + PC_CC * 2 + voff); cbb[i] = *(const v2u*)(rp + PC_CB * 2 + voff); } \
            asm volatile("" ::: "memory"); \
            attn_qblock<R>((LAS const unsigned char*)F.lds, P, row_own, head, sink_l2, nb > 0, lane0); \
            asm volatile("" ::: "memory"); \
            _Pragma("unroll") for (int i = 0; i < 8; ++i) { char* rp = (char*)(P + (size_t)(r0 + 8 * (R) + i) * LDP); \
                const f32x4 p = conv_p(ca[i]); const f32x4 cbv = {bf_lo(cbb[i].x), bf_hi(cbb[i].x), bf_lo(cbb[i].y), bf_hi(cbb[i].y)}; \
                const f32x4 uu = cbv * (w0 * pm2 + w1 * pm1 + w2 * p); \
                v2u o; o.x = pk2(uu[0], uu[1]); o.y = pk2(uu[2], uu[3]); *(v2u*)(rp + PC_CB * 2 + voff) = o; pm2 = pm1; pm1 = p; } } while (0)
        P2_STEP(0); P2_STEP(1); P2_STEP(2); P2_STEP(3);
        if (MK_SEAM23 && N_LAUNCHES == 1 && MK_DUP == 0) {
            asm volatile("s_waitcnt vmcnt(0)" ::: "memory"); __syncthreads();
            if (F.wave == 0 && lane0 == 0) { __builtin_amdgcn_fence(__ATOMIC_RELEASE, "agent"); asm volatile("s_waitcnt vmcnt(0)" ::: "memory");
                __hip_atomic_fetch_add(F.ctl + CW_P2 + 64 * (b * 8 + (nb >> 1)), 1u, RLX_AGENT); __hip_atomic_fetch_add(F.ctl + CW_P2 + 64 * (it >> 3), 1u, RLX_AGENT); }
        }
    }
}

#undef P2_STEP
__device__ __forceinline__ void p5_ln1_router(Frame& F, const Args& A) {
    const int lane = lane_id(), w = F.wave, tid = w * 64 + lane;
    const int rl = lane & 15, kq = lane >> 4;
    bf16* P = (bf16*)(F.ws + WS_P); bf16* XN = (bf16*)(F.ws + WS_XN);
    const float* g1 = arg_in(10); const float* b1 = arg_in(11);
    const float* rgb = arg_in(13); const float* reb = arg_in(15);
    const bf16* whi = (const bf16*)(F.ws + WS_REWG); const bf16* wlo = whi + 48 * DM;
    int* rowidx = (int*)(F.ws + WS_ROWIDX); float* tokw = (float*)(F.ws + WS_TOKW); int* slot = (int*)(F.ws + WS_SLOT);
    unsigned* cnt = (unsigned*)(F.ctl + CW_CNT);
    LAS float* red = (LAS float*)(F.lds + RING_OFF);
    LAS float* plog = (LAS float*)(F.lds + RING_OFF + 4096);
    LAS float* flog = (LAS float*)(F.lds + RING_OFF + 4096 + 49152);
    LAS float* bias = (LAS float*)(F.lds + RING_OFF + 4096 + 49152 + 6144);
    if (tid < NGRP + NEXP) bias[tid] = tid < NGRP ? rgb[tid] : reb[tid - NGRP];
    __syncthreads();
    const int kbase0 = 256 * w + 8 * kq, rl0 = rl;
    for (int rg = blockIdx.x; rg < MREAL / 32; rg += F.G) {
        if (MK_SEAM34 && N_LAUNCHES == 1 && MK_DUP == 0) { if (w == 0) wait_count((unsigned*)(F.ctl + CW_P4) + 64 * (rg >> 3), 64u, (unsigned*)(F.ctl + CW_TMO)); __syncthreads(); }
        int kbase = kbase0, rl = rl0; asm volatile("" : "+v"(kbase), "+v"(rl));
        f32x4 x[2][8][2];
#pragma unroll
        for (int hq = 0; hq < 2; ++hq) { const bf16* xp = P + (size_t)(rg * 32 + 16 * hq + rl) * LDP + PC_GA + kbase;
#pragma unroll
            for (int s = 0; s < 8; ++s) { const v4u q = *(const v4u*)(xp + 32 * s);
                x[hq][s][0] = (f32x4){bf_lo(q.x), bf_hi(q.x), bf_lo(q.y), bf_hi(q.y)}; x[hq][s][1] = (f32x4){bf_lo(q.z), bf_hi(q.z), bf_lo(q.w), bf_hi(q.w)}; } }
#pragma unroll
        for (int hq = 0; hq < 2; ++hq) { float sm = 0.f;
#pragma unroll
            for (int s = 0; s < 8; ++s) sm += ((x[hq][s][0][0] + x[hq][s][0][1]) + (x[hq][s][0][2] + x[hq][s][0][3])) + ((x[hq][s][1][0] + x[hq][s][1][1]) + (x[hq][s][1][2] + x[hq][s][1][3]));
            sm += __shfl_xor(sm, 16); sm += __shfl_xor(sm, 32);
            if (kq == 0) red[w * 32 + 16 * hq + rl] = sm; }
        __syncthreads();
        float rstd[2];
#pragma unroll
        for (int hq = 0; hq < 2; ++hq) { float tot = 0.f;
#pragma unroll
            for (int j = 0; j < 8; ++j) tot += red[j * 32 + 16 * hq + rl];
            const float mean = tot * (1.f / DM); float sq = 0.f;
#pragma unroll
            for (int s = 0; s < 8; ++s)
#pragma unroll
                for (int h = 0; h < 2; ++h) { x[hq][s][h] = x[hq][s][h] - mean; sq += (x[hq][s][h][0] * x[hq][s][h][0] + x[hq][s][h][1] * x[hq][s][h][1]) + (x[hq][s][h][2] * x[hq][s][h][2] + x[hq][s][h][3] * x[hq][s][h][3]); }
            sq += __shfl_xor(sq, 16); sq += __shfl_xor(sq, 32);
            if (kq == 0) red[256 + w * 32 + 16 * hq + rl] = sq; }
        __syncthreads();
#pragma unroll
        for (int hq = 0; hq < 2; ++hq) { float tq = 0.f;
#pragma unroll
            for (int j = 0; j < 8; ++j) tq += red[256 + j * 32 + 16 * hq + rl];
            rstd[hq] = 1.f / sqrtf(tq * (1.f / DM) + LN_EPS); }
        f32x4 acc[2][3];
#pragma unroll
        for (int hq = 0; hq < 2; ++hq)
#pragma unroll
            for (int nb = 0; nb < 3; ++nb) acc[hq][nb] = (f32x4){0.f, 0.f, 0.f, 0.f};
#pragma unroll
        for (int s = 0; s < 8; ++s) {
            const int k0 = kbase + 32 * s;
            const f32x4 ga = *(const f32x4*)(g1 + k0), gb = *(const f32x4*)(g1 + k0 + 4), ba = *(const f32x4*)(b1 + k0), bb = *(const f32x4*)(b1 + k0 + 4);
            bf16x8 bh[3], bl[3];
#pragma unroll
            for (int nb = 0; nb < 3; ++nb) { bh[nb] = *(const bf16x8*)(whi + (size_t)(16 * nb + rl) * DM + k0); bl[nb] = *(const bf16x8*)(wlo + (size_t)(16 * nb + rl) * DM + k0); }
#pragma unroll
            for (int hq = 0; hq < 2; ++hq) {
                const f32x4 ha = x[hq][s][0] * rstd[hq] * ga + ba, hb = x[hq][s][1] * rstd[hq] * gb + bb;
                v4u uh; uh.x = cvt_pk_bf16(ha[0], ha[1]); uh.y = cvt_pk_bf16(ha[2], ha[3]); uh.z = cvt_pk_bf16(hb[0], hb[1]); uh.w = cvt_pk_bf16(hb[2], hb[3]);
                *(v4u*)(XN + (size_t)(rg * 32 + 16 * hq + rl) * DM + k0) = uh;
                v4u ul; ul.x = cvt_pk_bf16(ha[0] - bf_lo(uh.x), ha[1] - bf_hi(uh.x)); ul.y = cvt_pk_bf16(ha[2] - bf_lo(uh.y), ha[3] - bf_hi(uh.y));
                ul.z = cvt_pk_bf16(hb[0] - bf_lo(uh.z), hb[1] - bf_hi(uh.z)); ul.w = cvt_pk_bf16(hb[2] - bf_lo(uh.w), hb[3] - bf_hi(uh.w));
                const bf16x8 ahi = __builtin_bit_cast(bf16x8, uh), alo = __builtin_bit_cast(bf16x8, ul);
#pragma unroll
                for (int nb = 0; nb < 3; ++nb) {
                    acc[hq][nb] = __builtin_amdgcn_mfma_f32_16x16x32_bf16(ahi, bh[nb], acc[hq][nb], 0, 0, 0);
                    acc[hq][nb] = __builtin_amdgcn_mfma_f32_16x16x32_bf16(alo, bh[nb], acc[hq][nb], 0, 0, 0);
                    acc[hq][nb] = __builtin_amdgcn_mfma_f32_16x16x32_bf16(ahi, bl[nb], acc[hq][nb], 0, 0, 0);
                }
            }
            asm volatile("" ::: "memory");
        }
#pragma unroll
        for (int hq = 0; hq < 2; ++hq)
#pragma unroll
            for (int nb = 0; nb < 3; ++nb)
#pragma unroll
                for (int i = 0; i < 4; ++i) plog[(w * 32 + 16 * hq + 4 * kq + i) * 48 + 16 * nb + rl] = acc[hq][nb][i];
        __syncthreads();
        for (int o = tid; o < 32 * 48; o += NWAVES * 64) { float t = 0.f;
#pragma unroll
            for (int j = 0; j < 8; ++j) t += plog[j * 1536 + o];
            flog[o] = t; }
        __syncthreads();
        if (tid < 32) {
            const LAS float* fl = flog + tid * 48; const int m = rg * 32 + tid;
            float gl[4];
#pragma unroll
            for (int c = 0; c < 4; ++c) gl[c] = fl[c] + bias[c];
            int gsel = 0; float gmax = gl[0];
#pragma unroll
            for (int c = 1; c < 4; ++c) if (gl[c] > gmax) { gmax = gl[c]; gsel = c; }
            float gden = 0.f;
#pragma unroll
            for (int c = 0; c < 4; ++c) gden += __expf(gl[c] - gmax);
            const float pgroup = 1.0f / gden;
            float el[8];
#pragma unroll
            for (int c = 0; c < 8; ++c) el[c] = fl[4 + gsel * EPG + c] + bias[NGRP + gsel * EPG + c];
            int i0 = 0; float l0 = el[0];
#pragma unroll
            for (int c = 1; c < 8; ++c) if (el[c] > l0) { l0 = el[c]; i0 = c; }
            int i1 = -1; float l1 = -INFINITY;
#pragma unroll
            for (int c = 0; c < 8; ++c) if (c != i0 && el[c] > l1) { l1 = el[c]; i1 = c; }
            const float e10 = __expf(l1 - l0);
            const float w0 = pgroup / (1.0f + e10), w1 = pgroup * e10 / (1.0f + e10);
            const int e0 = gsel * EPG + i0, e1 = gsel * EPG + i1;
            const unsigned p0 = __hip_atomic_fetch_add(cnt + 64 * e0, 1u, RLX_AGENT), p1 = __hip_atomic_fetch_add(cnt + 64 * e1, 1u, RLX_AGENT);
            rowidx[e0 * MREAL + p0] = m * 2; rowidx[e1 * MREAL + p1] = m * 2 + 1;
            tokw[m * 2] = w0; tokw[m * 2 + 1] = w1;
            slot[m * 2] = (e0 << 16) | (int)p0; slot[m * 2 + 1] = (e1 << 16) | (int)p1;
        }
    }
}

__device__ __forceinline__ void p8_ln2(Frame& F, const Args& A, volatile LAS int* tp) {
    const int gw = F.vcu * NWAVES + F.wave, NGW = F.G * NWAVES;
    const bf16* XN = (const bf16*)(F.ws + WS_XN); const bf16* Y = (const bf16*)(F.ws + WS_Y);
    const float* g2 = arg_in(19); const float* b2 = arg_in(20);
    const int* slot = (const int*)(F.ws + WS_SLOT); const float* tokw = (const float*)(F.ws + WS_TOKW);
    for (int base = gw; base < MREAL; base += 4 * NGW) {
    int sl[4][2]; float wl[4][2];
#pragma unroll
    for (int k = 0; k < 4; ++k) { const int m = base + k * NGW; const int mm = m < MREAL ? m : 0; sl[k][0] = slot[2 * mm]; sl[k][1] = slot[2 * mm + 1]; wl[k][0] = tokw[2 * mm]; wl[k][1] = tokw[2 * mm + 1]; }
#pragma unroll
    for (int k = 0; k < 4; ++k) {
        const int m = base + k * NGW; if (m >= MREAL) break;
        int lane = lane_id();
        const int s0 = sl[k][0], s1 = sl[k][1]; const float w0 = wl[k][0], w1 = wl[k][1];
        const int r0 = __builtin_amdgcn_readfirstlane(tp[s0 >> 16]) * 256 + (s0 & 0xffff), r1 = __builtin_amdgcn_readfirstlane(tp[s1 >> 16]) * 256 + (s1 & 0xffff);
        const v2u* hp = (const v2u*)(XN + (size_t)m * DM) + lane; const v2u* y0 = (const v2u*)(Y + (size_t)r0 * DM) + lane; const v2u* y1 = (const v2u*)(Y + (size_t)r1 * DM) + lane;
        f32x4 v[8]; float s = 0.f;
#pragma unroll
        for (int j = 0; j < 8; ++j) { const v2u h = hp[64 * j], a = y0[64 * j], c = y1[64 * j];
            v[j] = (f32x4){ALPHA * bf_lo(h.x) + (w0 * bf_lo(a.x) + w1 * bf_lo(c.x)), ALPHA * bf_hi(h.x) + (w0 * bf_hi(a.x) + w1 * bf_hi(c.x)), ALPHA * bf_lo(h.y) + (w0 * bf_lo(a.y) + w1 * bf_lo(c.y)), ALPHA * bf_hi(h.y) + (w0 * bf_hi(a.y) + w1 * bf_hi(c.y))};
            s += (v[j][0] + v[j][1]) + (v[j][2] + v[j][3]); }
        const float mean = wave_sum(s) * (1.f / DM); float s2 = 0.f;
#pragma unroll
        for (int j = 0; j < 8; ++j) { v[j] = v[j] - mean; s2 += (v[j][0] * v[j][0] + v[j][1] * v[j][1]) + (v[j][2] * v[j][2] + v[j][3] * v[j][3]); }
        const float rstd = 1.f / sqrtf(wave_sum(s2) * (1.f / DM) + LN_EPS);
        f32x4* op = (f32x4*)(F.out + (size_t)m * DM) + lane;
#pragma unroll
        for (int j = 0; j < 8; ++j) { const f32x4 gg = ((const f32x4*)g2)[lane + 64 * j], bb = ((const f32x4*)b2)[lane + 64 * j]; op[64 * j] = v[j] * rstd * gg + bb; }
    }
    }
}

__global__ void __launch_bounds__(NWAVES * 64, 2) mk_fwd(Args args) {
    extern __shared__ __attribute__((aligned(16))) unsigned char lds[];
    Frame F;
    F.lds = (LAS unsigned char*)lds;
    F.MISC = (volatile LAS unsigned*)(F.lds + MISC_OFF);
    F.wave = __builtin_amdgcn_readfirstlane((int)(threadIdx.x >> 6));
    F.G = gridDim.x; { const int bx = blockIdx.x; F.vcu = (F.G % 8 == 0) ? (bx % 8) * (F.G / 8) + bx / 8 : bx; }
    F.ws = args.ws; F.out = args.out;
    F.ctl = (gu32*)(F.ws + WS_CTL);
    for (int u = threadIdx.x; u < (LDS_BYTES - LDSCTL_OFF) / 4; u += NWAVES * 64) ((LAS unsigned*)(F.lds + LDSCTL_OFF))[u] = 0u;
    __syncthreads();
    XcdBarrier bar; bar.bar = (unsigned*)(F.ctl + CW_BAR); bar.x = 0; bar.st = nullptr; bar.wave = F.wave;
    if (N_LAUNCHES == 1) { bar = xcd_barrier_post((unsigned*)(F.ctl + CW_BAR), F.MISC + 8); bar.wave = F.wave; }
#define GRID_BAR() do { if (N_LAUNCHES == 1) xcd_barrier(bar); } while (0)
    volatile LAS unsigned long long* stamps = (volatile LAS unsigned long long*)(F.lds + LDSCTL_OFF + 4096);
    int n_stamp = 0;
#define STAMP() do { if (MK_SPIN >= 0 && blockIdx.x == 0 && F.wave == 0 && lane_id() == 0) stamps[n_stamp] = __builtin_amdgcn_s_memrealtime(); ++n_stamp; } while (0)
    STAMP();
    const int lo = args.ph_lo, hi = args.ph_hi;
#define REP(k) for (int rep_ = 0; rep_ < 1 + ((MK_DUP >> (k)) & 1); ++rep_)
#ifndef MK_PH_MASK
#define MK_PH_MASK 0x1ff
#endif
#define IN(k) (((MK_PH_MASK >> (k)) & 1) && lo <= (k) && (k) < hi)
    bf16* P = (bf16*)(F.ws + WS_P); bf16* XN = (bf16*)(F.ws + WS_XN);

    if (IN(0)) REP(0) { p0_prologue(F, args); GRID_BAR(); }
    STAMP();

    if (IN(1)) REP(1) {
        const int NSPARE = (F.G == 256) ? 24 : 0;
        if ((int)blockIdx.x < F.G - NSPARE) {
            pg8::Gemm g{XN, (const bf16*)(F.ws + WS_WIN), DM, DM, -1};
            DenseOrder S; S.init(F.wave, MREAL / 256, LDP / 256, F.G - NSPARE, (int)blockIdx.x, (long)256 * DM * 2, (long)256 * DM * 2, (PC_GA - PC_K) / 256, PC_K / 256);
            EpiBf16 E{P, LDP, PC_CC / 256, PC_GA / 256, PC_CC, PC_GA / 256};
            pg8::gemm_phase<EpiBf16, DenseOrder, true>(F.lds + RING_OFF, g, S, E);
        }
        conv_queue((unsigned*)(F.ctl + CW_Q), 0, CT_B1, F.ws, F.lds + RING_OFF, F.MISC + 16, F.wave, lane_id());
        GRID_BAR();
    }
    STAMP();
    constexpr bool SEAM23 = MK_SEAM23 && N_LAUNCHES == 1 && MK_DUP == 0;
    if (IN(2)) { p2_attention_conv(F, args); if (!SEAM23) GRID_BAR(); }
    STAMP();
    constexpr bool SEAM34 = MK_SEAM34 && N_LAUNCHES == 1 && MK_DUP == 0;
    if (IN(3)) REP(3) {
        pg8::Gemm g{P, (const bf16*)(F.ws + WS_WB2), LDP, 2 * DM, DM / 64};
        EpiGate E{P, (bf16*)(F.ws + WS_MRG), SEAM34 ? (unsigned*)(F.ctl + CW_P3) : nullptr};
        if (SEAM23) {
            DenseOrderDep S; S.init(F.wave, MREAL / 256, DM / 256, F.G, (int)blockIdx.x, (long)256 * LDP * 2, (long)256 * 2 * DM * 2);
            S.rdy = (unsigned*)(F.ctl + CW_P2); S.need = 16u; S.tmo = (unsigned*)(F.ctl + CW_TMO);
            pg8::gemm_phase<EpiGate, DenseOrderDep, true>(F.lds + RING_OFF, g, S, E);
        } else {
            DenseOrder S; S.init(F.wave, MREAL / 256, DM / 256, F.G, (int)blockIdx.x, (long)256 * LDP * 2, (long)256 * 2 * DM * 2);
            pg8::gemm_phase<EpiGate, DenseOrder, true>(F.lds + RING_OFF, g, S, E);
        }
        if (!SEAM34) GRID_BAR();
    }
    STAMP();
    if (IN(4)) REP(4) {
        pg8::Gemm g{(const bf16*)(F.ws + WS_MRG), (const bf16*)(F.ws + WS_WOUT), DM, DM, -1};
        EpiPre E{XN, P + PC_GA, LDP, SEAM34 ? (unsigned*)(F.ctl + CW_P4) : nullptr};
        if (SEAM34) {
            DenseOrderDep S; S.init(F.wave, MREAL / 256, DM / 256, F.G, (int)blockIdx.x, (long)256 * DM * 2, (long)256 * DM * 2);
            S.rdy = (unsigned*)(F.ctl + CW_P3); S.need = 64u; S.tmo = (unsigned*)(F.ctl + CW_TMO);
            pg8::gemm_phase<EpiPre, DenseOrderDep, true>(F.lds + RING_OFF, g, S, E);
        } else {
            DenseOrder S; S.init(F.wave, MREAL / 256, DM / 256, F.G, (int)blockIdx.x, (long)256 * DM * 2, (long)256 * DM * 2);
            pg8::gemm_phase<EpiPre, DenseOrder, true>(F.lds + RING_OFF, g, S, E);
            GRID_BAR();
        }
    }
    STAMP();
    if (IN(5)) { p5_ln1_router(F, args); GRID_BAR(); }
    STAMP();
    volatile LAS int* tp = (volatile LAS int*)(F.MISC + 32);
    volatile LAS int* cn = (volatile LAS int*)(F.MISC + 72);
    if (IN(6) || IN(7) || IN(8)) {
        if (F.wave == 0) {
            const int l = lane_id(); const int c = l < NEXP ? (int)__hip_atomic_load(F.ctl + CW_CNT + 64 * (l & 31), RLX_AGENT) : 0;
            const int nt_e = (c + 255) >> 8; int inc = nt_e;
#pragma unroll
            for (int o = 1; o < 32; o <<= 1) { const int v = __shfl_up(inc, o); if ((l & 31) >= o) inc += v; }
            if (l < NEXP) { tp[l] = inc - nt_e; cn[l] = c; if (l == NEXP - 1) tp[32] = inc; }
        }
        __syncthreads();
    }
    constexpr bool MERGE = MK_MOE_MERGE && N_LAUNCHES == 1;
    if (IN(6)) REP(6) {
        pg8::Gemm g{XN, (const bf16*)(F.ws + WS_WGU), DM, DM, -1};
        MoeOrder<4, true> S{F.wave, tp, cn, F.G, (int)blockIdx.x, (long)1024 * DM * 2, (long)256 * DM * 2, 0, (const int*)(F.ws + WS_ROWIDX), (unsigned)(DM * 2)};
        EpiAct E{(bf16*)(F.ws + WS_ACT), (unsigned*)(F.ctl + CW_RDY)};
        pg8::gemm_phase<EpiAct, MoeOrder<4, true>, true>(F.lds + RING_OFF, g, S, E);
        if (MERGE) conv_queue<true>((unsigned*)(F.ctl + CW_Q + 64), CT_B1, CT_B, F.ws, F.lds + RING_OFF, F.MISC + 16, F.wave, lane_id(), (unsigned*)(F.ctl + CW_WD));
        else { conv_queue<false>((unsigned*)(F.ctl + CW_Q + 64), CT_B1, CT_B, F.ws, F.lds + RING_OFF, F.MISC + 16, F.wave, lane_id()); GRID_BAR(); }
    }
    STAMP();
    if (IN(7)) REP(7) {
        pg8::Gemm g{(const bf16*)(F.ws + WS_ACT), (const bf16*)(F.ws + WS_WD), DE, DE, -1};
        EpiDown E{(bf16*)(F.ws + WS_Y)};
        if (MERGE) {
            if (F.wave == 0) wait_count((unsigned*)(F.ctl + CW_WD), (unsigned)CT_DN, (unsigned*)(F.ctl + CW_TMO));
            MoeDownOrder S{F.wave, tp, cn, F.G, (int)blockIdx.x, (long)DM * DE * 2, (long)256 * DE * 2, (long)256 * DE * 2, (unsigned*)(F.ctl + CW_RDY), (unsigned*)(F.ctl + CW_WD), (unsigned*)(F.ctl + CW_TMO)};
            pg8::gemm_phase<EpiDown, MoeDownOrder, true>(F.lds + RING_OFF, g, S, E);
        } else {
            MoeOrder<8, false> S{F.wave, tp, cn, F.G, (int)blockIdx.x, (long)DM * DE * 2, (long)256 * DE * 2, (long)256 * DE * 2, (const int*)(F.ws + WS_ROWIDX), 0u};
            pg8::gemm_phase<EpiDown, MoeOrder<8, false>, true>(F.lds + RING_OFF, g, S, E);
        }
        GRID_BAR();
    }
    STAMP();
    if (IN(8)) REP(8) { p8_ln2(F, args, tp); }
    STAMP();
    if (MK_SPIN >= 0 && blockIdx.x == 0 && F.wave == 0 && lane_id() == 0) {
        const unsigned long long t_end = __builtin_amdgcn_s_memrealtime();
        const unsigned long long span = (MK_SPIN >= 100) ? (unsigned long long)MK_SPIN * 100ull : (stamps[(MK_SPIN < 9 ? MK_SPIN : 8) + 1] - stamps[MK_SPIN < 9 ? MK_SPIN : 8]);
        while (__builtin_amdgcn_s_memrealtime() - t_end < span) __builtin_amdgcn_s_sleep(8);
    }
#undef IN
#undef GRID_BAR
}

extern "C" void kernel_launch(void* const* d_in, const int* in_sizes, int n_in, void* d_out, int out_size, void* d_ws, size_t ws_size, hipStream_t stream) {
    static int grid = 0;
    if (grid == 0) {
        if (n_in != 21 || in_sizes[0] != MREAL * DM || out_size != MREAL * DM || ws_size < WS_END) { fprintf(stderr, "kernel_launch: unexpected shapes / workspace (n_in %d, ws %zu); nothing launched\n", n_in, ws_size); grid = -1; return; }
        int dev = 0, cus = 0, per_cu = 0;
        if (hipGetDevice(&dev) != hipSuccess || hipDeviceGetAttribute(&cus, hipDeviceAttributeMultiprocessorCount, dev) != hipSuccess) { grid = -1; return; }
        if (hipFuncSetAttribute((const void*)mk_fwd, hipFuncAttributeMaxDynamicSharedMemorySize, LDS_BYTES) != hipSuccess) { fprintf(stderr, "kernel_launch: hipFuncSetAttribute failed\n"); grid = -1; return; }
        if (hipOccupancyMaxActiveBlocksPerMultiprocessor(&per_cu, (const void*)mk_fwd, NWAVES * 64, LDS_BYTES) != hipSuccess || per_cu < 1) { fprintf(stderr, "kernel_launch: occupancy query reports %d\n", per_cu); }
        (void)hipGetLastError();
        grid = cus;
    }
    if (grid < 0) return;
    if (hipMemsetAsync((char*)d_ws + WS_CTL, 0, CTL_ZERO_BYTES, stream) != hipSuccess) return;
    Args a{};
    for (int i = 0; i < 21; ++i) a.in[i] = (const float*)d_in[i];
    a.out = (float*)d_out; a.ws = (unsigned char*)d_ws;
    for (int li = 0; li < N_LAUNCHES; ++li) {
        a.ph_lo = (N_LAUNCHES == 1) ? 0 : li; a.ph_hi = (N_LAUNCHES == 1) ? PER_PHASE : li + 1; a.li = li;
        hipLaunchKernelGGL(mk_fwd, dim3(grid), dim3(NWAVES * 64), LDS_BYTES, stream, a);
    }
}
```

```cpp
#include <hip/hip_runtime.h>
#include <cstdio>
#include <cstdint>

#ifndef MK_SPIN
#define MK_SPIN -1
#endif
#ifndef MK_DUP
#define MK_DUP 0
#endif
#ifndef MK_SEAM23
#define MK_SEAM23 1
#endif
#ifndef MK_SEAM34
#define MK_SEAM34 1
#endif
#ifndef MK_MOE_MERGE
#define MK_MOE_MERGE 1
#endif
#ifndef MK_N_LAUNCHES
#define MK_N_LAUNCHES 1
#endif

__device__ __forceinline__ int lane_id() { int l = (int)__builtin_amdgcn_mbcnt_hi(~0u, __builtin_amdgcn_mbcnt_lo(~0u, 0u)); asm volatile("" : "+v"(l)); return l; }
namespace pg8 {
#define PG8_LAS __attribute__((address_space(3)))
typedef unsigned short bf16_t;
typedef short bf16x8 __attribute__((ext_vector_type(8)));
typedef float f32x4 __attribute__((ext_vector_type(4)));
typedef float f32x2 __attribute__((ext_vector_type(2)));
typedef unsigned u32x4 __attribute__((ext_vector_type(4)));
typedef unsigned u32x2 __attribute__((ext_vector_type(2)));
constexpr int BM = 256, BK = 64, HALF = 128, HTB = HALF * BK * 2  , STAGE_BYTES = 8 * HTB, NXCD = 8, WGM = 8;

__host__ __device__ __forceinline__ int lds_byte(int r, int c) { const int st = (r >> 4) * 2 + (c >> 5), rr = r & 15, cc = c & 31, ob = rr * 64 + cc * 2; return st * 1024 + (ob ^ (((ob >> 9) & 1) << 5)); }
__host__ __device__ __forceinline__ void stage_rc(int b, int& R, int& C) { const int st = b / 1024, sb = b % 1024, swz = sb ^ (((sb >> 9) & 1) << 5); R = (st >> 1) * 16 + swz / 64; C = (st & 1) * 32 + (swz % 64) / 2; }
__host__ __device__ __forceinline__ int perm32(int rho) { const int n = rho >> 4, i = rho & 15; return 8 * (i >> 2) + 4 * n + (i & 3); }

struct Unit { int pm, pn; long a_byte, b_byte; int e, mt, cnt; };
struct Gemm { const bf16_t* A; const bf16_t* Bt; int lda; int K; int tmid; };

__device__ __forceinline__ unsigned cvt_pk_bf16(float lo, float hi) { unsigned r; asm volatile("v_cvt_pk_bf16_f32 %0, %1, %2" : "=v"(r) : "v"(lo), "v"(hi)); return r; }
__device__ __forceinline__ float bf_lo(unsigned u) { return __builtin_bit_cast(float, u << 16); }
__device__ __forceinline__ float bf_hi(unsigned u) { return __builtin_bit_cast(float, u & 0xffff0000u); }

template <class Epi, class Sched, bool ALIGN_EPI>
__device__ __forceinline__ void gemm_phase(PG8_LAS unsigned char* lds, const Gemm g, const Sched& S, const Epi& E) {
    constexpr bool GATHER = Sched::GATHER;
    const int lane = lane_id(), wid = S.wave, tid = wid * 64 + lane, wr = wid >> 2, wc = wid & 3, fr = lane & 15, fq = lane >> 4;
    const int K = g.K, nt = K / BK, lda = g.lda;
    unsigned voffA[2], voffB[2]; int rA[2]; unsigned cA2[2];
#pragma unroll
    for (int i = 0; i < 2; ++i) { int R, C; stage_rc(tid * 16 + i * 8192, R, C); const int Rb = Epi::PERM ? ((R & ~31) + perm32(R & 31)) : R;
        voffA[i] = (unsigned)(R * lda + C) * 2u; voffB[i] = (unsigned)(Rb * K + C) * 2u; rA[i] = R; cA2[i] = (unsigned)C * 2u; }
    const size_t kstep = (size_t)(BK * 2);
    const size_t hstepA = (size_t)HALF * lda * 2, hstepB = (size_t)HALF * K * 2;
    const unsigned ldsw = (unsigned)wid * 1024u;
    const int aoff = lds_byte(wr * 64 + fr, fq * 8), boff = lds_byte(wc * 32 + fr, fq * 8);
#define PG8_SA(b, h) (((b) * 2 + (h)) * HTB)
#define PG8_SB(b, h) ((4 + (b) * 2 + (h)) * HTB)
#define PG8_GLDS(gp, ldsoff) __builtin_amdgcn_global_load_lds((const unsigned*)(gp), (PG8_LAS unsigned*)(lds + (ldsoff)), 16, 0, 0)
#define PG8_STAGE_O(bufoff, gbase, o0, o1) do { PG8_GLDS((const char*)(gbase) + (o0), (bufoff) + ldsw); PG8_GLDS((const char*)(gbase) + (o1), (bufoff) + ldsw + 8192); } while (0)
#define PG8_STB(bufoff, gbase) PG8_STAGE_O(bufoff, gbase, voffB[0], voffB[1])
#define PG8_STA(bufoff, ap, h, V) do { if constexpr (GATHER) PG8_STAGE_O(bufoff, ap, V[h][0], V[h][1]); else PG8_STAGE_O(bufoff, (ap) + (h) * hstepA, voffA[0], voffA[1]); } while (0)
#define PG8_LDA(dst, b, h) do { _Pragma("unroll") for (int m = 0; m < 4; ++m) _Pragma("unroll") for (int k = 0; k < 2; ++k) dst[m][k] = *(const PG8_LAS bf16x8*)(lds + PG8_SA(b, h) + aoff + m * 2048 + k * 1024); } while (0)
#define PG8_LDB(dst, b, h) do { _Pragma("unroll") for (int n = 0; n < 2; ++n) _Pragma("unroll") for (int k = 0; k < 2; ++k) dst[n][k] = *(const PG8_LAS bf16x8*)(lds + PG8_SB(b, h) + boff + n * 2048 + k * 1024); } while (0)
#define PG8_MMA(ai, bj, At, Bt) do { __builtin_amdgcn_s_setprio(1); _Pragma("unroll") for (int m = 0; m < 4; ++m) _Pragma("unroll") for (int n = 0; n < 2; ++n) _Pragma("unroll") for (int k = 0; k < 2; ++k) \
        acc[ai][bj][m][n] = __builtin_amdgcn_mfma_f32_16x16x32_bf16(Bt[n][k], At[m][k], acc[ai][bj][m][n], 0, 0, 0); __builtin_amdgcn_s_setprio(0); } while (0)
#define PG8_WAIT_V(n) asm volatile("s_waitcnt vmcnt(" #n ")" ::: "memory")
#define PG8_WAIT_L(n) asm volatile("s_waitcnt lgkmcnt(" #n ")" ::: "memory")
#define PG8_BAR __builtin_amdgcn_s_barrier()
#define PG8_SCHED __builtin_amdgcn_sched_barrier(0)
    Unit cur, nxt; int ui = 0;
    if (!S.next(0, cur)) return;
    f32x4 acc[2][2][4][2];
#pragma unroll
    for (int a = 0; a < 2; ++a)
#pragma unroll
        for (int b = 0; b < 2; ++b)
#pragma unroll
            for (int m = 0; m < 4; ++m)
#pragma unroll
                for (int n = 0; n < 2; ++n) acc[a][b][m][n] = (f32x4){0.f, 0.f, 0.f, 0.f};
    bf16x8 At[4][2], B0[2][2], B1[2][2];
    unsigned va[2][2], nva[2][2];
    if constexpr (GATHER) {
#pragma unroll
        for (int h = 0; h < 2; ++h)
#pragma unroll
            for (int i = 0; i < 2; ++i) { va[h][i] = S.row_byte(cur, h * HALF + rA[i]) + cA2[i]; nva[h][i] = va[h][i]; }
    } else { va[0][0] = va[0][1] = va[1][0] = va[1][1] = 0u; nva[0][0] = nva[0][1] = nva[1][0] = nva[1][1] = 0u; }
    const char* cA = (const char*)g.A + cur.a_byte; const char* cB = (const char*)g.Bt + cur.b_byte;
    S.a_ready(cur);
    PG8_STB(PG8_SB(0, 0), cB); PG8_STB(PG8_SB(0, 1), cB + hstepB); PG8_STA(PG8_SA(0, 0), cA, 0, va); PG8_STA(PG8_SA(0, 1), cA, 1, va);
    if (wr == 1) PG8_BAR;
    PG8_WAIT_V(2); PG8_BAR;
    PG8_STB(PG8_SB(1, 0), cB + kstep); PG8_STA(PG8_SA(1, 0), cA + kstep, 0, va); PG8_STB(PG8_SB(1, 1), cB + hstepB + kstep);
    PG8_WAIT_V(6); PG8_BAR;
    for (;;) {
        const bool has_next = S.next(ui + 1, nxt);
        const char* nA = has_next ? (const char*)g.A + nxt.a_byte : cA; const char* nB = has_next ? (const char*)g.Bt + nxt.b_byte : cB;
        if constexpr (GATHER) {
            if (has_next) {
#pragma unroll
                for (int h = 0; h < 2; ++h)
#pragma unroll
                    for (int i = 0; i < 2; ++i) nva[h][i] = S.row_byte(nxt, h * HALF + rA[i]) + cA2[i];
            }
            asm volatile("" : "+v"(nva[0][0]), "+v"(nva[0][1]), "+v"(nva[1][0]), "+v"(nva[1][1]));
        }
        for (int t = 0; t < nt; t += 2) {
            const bool last = (t == nt - 2);
            if constexpr (Epi::MID) { if (t == g.tmid) E.mid(acc, cur, wr, wc, fr, fq); }
            if (last && has_next) S.a_ready(nxt);
            const char* a1 = cA + (size_t)(t + 1) * kstep;
            const char* a2 = last ? nA : cA + (size_t)(t + 2) * kstep; const char* b2 = last ? nB : cB + (size_t)(t + 2) * kstep;
            const char* a3 = a2 + kstep; const char* b3 = b2 + kstep;
            unsigned xa[2][2];
#pragma unroll
            for (int h = 0; h < 2; ++h)
#pragma unroll
                for (int i = 0; i < 2; ++i) xa[h][i] = last ? nva[h][i] : va[h][i];
            PG8_LDB(B0, 0, 0); PG8_LDB(B1, 0, 1); PG8_SCHED; PG8_LDA(At, 0, 0); PG8_STA(PG8_SA(1, 1), a1, 1, va);
            PG8_WAIT_V(8); PG8_WAIT_L(0); PG8_BAR; PG8_MMA(0, 0, At, B0); PG8_MMA(0, 1, At, B1); PG8_BAR; PG8_SCHED;
            PG8_LDA(At, 0, 1); PG8_STB(PG8_SB(0, 0), b2); PG8_STB(PG8_SB(0, 1), b2 + hstepB); PG8_STA(PG8_SA(0, 0), a2, 0, xa);
            PG8_WAIT_V(8); PG8_WAIT_L(0); PG8_BAR; PG8_MMA(1, 0, At, B0); PG8_MMA(1, 1, At, B1); PG8_BAR; PG8_SCHED;
            PG8_LDB(B0, 1, 0); PG8_LDB(B1, 1, 1); PG8_SCHED; PG8_LDA(At, 1, 0); PG8_STA(PG8_SA(0, 1), a2, 1, xa);
            PG8_WAIT_V(8); PG8_WAIT_L(0); PG8_BAR; PG8_MMA(0, 0, At, B0); PG8_MMA(0, 1, At, B1); PG8_BAR; PG8_SCHED;
            PG8_LDA(At, 1, 1); PG8_STB(PG8_SB(1, 0), b3); PG8_STB(PG8_SB(1, 1), b3 + hstepB); PG8_STA(PG8_SA(1, 0), a3, 0, xa);
            PG8_WAIT_V(8); PG8_WAIT_L(0); PG8_BAR; PG8_MMA(1, 0, At, B0); PG8_MMA(1, 1, At, B1); PG8_BAR; PG8_SCHED;
        }
        if constexpr (ALIGN_EPI) { if (wr == 0) PG8_BAR; }
        E(acc, cur, wr, wc, fr, fq);
        if (!has_next) break;
#pragma unroll
        for (int a = 0; a < 2; ++a)
#pragma unroll
            for (int b = 0; b < 2; ++b)
#pragma unroll
                for (int m = 0; m < 4; ++m)
#pragma unroll
                    for (int n = 0; n < 2; ++n) acc[a][b][m][n] = (f32x4){0.f, 0.f, 0.f, 0.f};
        cur = nxt; cA = nA; cB = nB; ++ui;
        if constexpr (GATHER) {
#pragma unroll
            for (int h = 0; h < 2; ++h)
#pragma unroll
                for (int i = 0; i < 2; ++i) va[h][i] = nva[h][i];
        }
        if constexpr (ALIGN_EPI) { if (wr == 1) PG8_BAR; }
    }
    PG8_WAIT_V(0);
    if constexpr (!ALIGN_EPI) { if (wr == 0) PG8_BAR; }
    PG8_BAR;
#undef PG8_SA
#undef PG8_SB
#undef PG8_GLDS
#undef PG8_STAGE_O
#undef PG8_STB
#undef PG8_STA
#undef PG8_LDA
#undef PG8_LDB
#undef PG8_MMA
#undef PG8_WAIT_V
#undef PG8_WAIT_L
#undef PG8_BAR
#undef PG8_SCHED
}
}

constexpr int NWAVES = 8;
constexpr int N_LAUNCHES = MK_N_LAUNCHES;
constexpr int PER_PHASE = 9;
constexpr int BATCH = 4, SEQ = 2048, DM = 2048, NMETA = 16;
constexpr int MREAL = BATCH * SEQ;
constexpr int MPAD = MREAL + 256;
constexpr int LDP = 12800;
constexpr int PC_Q = 0, PC_CB = 2048, PC_K = 4096, PC_V = 4352, PC_CC = 4608, PC_CH = 6656, PC_GA = 8704, PC_GC = 10752;
constexpr int NQH = 32, NKVH = 4, HD = 64, WIN = 128;
constexpr int NEXP = 32, NGRP = 4, EPG = 8, DE = 512;
constexpr float LN_EPS = 1e-5f;
constexpr float ALPHA = 1.189207115002721f;
constexpr int MOE_ROWS_MAX = 2 * MREAL + NEXP * 256;

constexpr int CT_IN = 32 * 50, CT_SQ = 32 * 8, CT_GU = 32 * 64, CT_DN = 32 * 64;
constexpr size_t MiB = 1u << 20;
constexpr size_t WS_CTL = 0, CTL_ZERO_BYTES = 131072;
constexpr size_t WS_ROWIDX = 1 * MiB;
constexpr size_t WS_TOKW = 2 * MiB;
constexpr size_t WS_SLOT = 2 * MiB + 128 * 1024;
constexpr size_t WS_REWG = 3 * MiB;
constexpr size_t WS_WIN = 4 * MiB;
constexpr size_t WS_WB2 = 54 * MiB;
constexpr size_t WS_WOUT = 70 * MiB;
constexpr size_t WS_WGU = 78 * MiB;
constexpr size_t WS_WD = 206 * MiB;
constexpr size_t WS_XN = 270 * MiB;
constexpr size_t WS_P = 303 * MiB;
constexpr size_t WS_ACT = WS_P;
constexpr size_t WS_Y = WS_P + 24 * MiB;
constexpr size_t WS_MRG = 512 * MiB;
constexpr size_t WS_END = 544 * MiB;
static_assert(WS_P + (size_t)MPAD * LDP * 2 <= WS_MRG && WS_Y + (size_t)MOE_ROWS_MAX * DM * 2 <= WS_MRG && (size_t)MOE_ROWS_MAX * DE * 2 <= 24 * MiB, "ws map");
constexpr int CW_TMO = 0, CW_CODE = 1;
constexpr int CW_CNT = 256;
constexpr int CW_Q = 64;
constexpr int CW_BAR = 4096;
constexpr int CW_P2 = 16384 + 4096, CW_P3 = 16384, CW_P4 = 16384 + 2048;
constexpr int CW_WD = 192;
constexpr int CW_RDY = 8192;
static_assert((CW_RDY + 64 * 96) * 4 <= 65536 && (CW_P2 + 2048) * 4 <= 131072, "control words inside the memset");

constexpr int RING_OFF = 0, RING_BYTES = 131072;
constexpr int LDSCTL_OFF = RING_BYTES, MISC_OFF = LDSCTL_OFF + 320;
constexpr int LDS_BYTES = 147456;

#define GAS __attribute__((address_space(1)))
#define LAS __attribute__((address_space(3)))
typedef unsigned short bf16;
typedef unsigned v4u __attribute__((ext_vector_type(4)));
typedef unsigned v2u __attribute__((ext_vector_type(2)));
typedef float f32x4 __attribute__((ext_vector_type(4)));
typedef float f32x16 __attribute__((ext_vector_type(16)));
typedef short bf16x8 __attribute__((ext_vector_type(8)));
typedef short s16x4 __attribute__((ext_vector_type(4)));
typedef GAS unsigned gu32;
#define RLX_AGENT __ATOMIC_RELAXED, __HIP_MEMORY_SCOPE_AGENT
#define LDS_WAIT() asm volatile("s_waitcnt lgkmcnt(0)" ::: "memory")
#define VM_WAIT() asm volatile("s_waitcnt vmcnt(0)" ::: "memory")
__device__ __forceinline__ unsigned f2bf(float f) { unsigned u = __builtin_bit_cast(unsigned, f); return (u + 0x7fffu + ((u >> 16) & 1u)) >> 16; }
__device__ __forceinline__ unsigned pk2(float lo, float hi) { return f2bf(lo) | (f2bf(hi) << 16); }
using pg8::bf_lo; using pg8::bf_hi; using pg8::cvt_pk_bf16;

#define XB_TMO      128
#define XB_XCNT(j)  (256  + 64 * (j))
#define XB_XSUB(j)  (1280 + 64 * (j))
#define XB_XGEN(j)  (2304 + 64 * (j))
#define XB_TOP      3328
#define XB_TOPGEN   3392
#define XCD_BAR_WORDS 3456
#define XB_SPIN_CAP (1u << 18)
__device__ __forceinline__ unsigned xb_ld(unsigned* p)              { return __hip_atomic_load(p, __ATOMIC_RELAXED, __HIP_MEMORY_SCOPE_AGENT); }
__device__ __forceinline__ unsigned xb_add(unsigned* p, unsigned v) { return __hip_atomic_fetch_add(p, v, __ATOMIC_RELAXED, __HIP_MEMORY_SCOPE_AGENT); }
__device__ __forceinline__ unsigned xb_xcc_id() { return (unsigned)__builtin_amdgcn_s_getreg((3 << 11) | 20) & 0xFu; }
#define XB_SPIN(cond, bar) do { unsigned _sp = 0; while (cond) { __builtin_amdgcn_s_sleep(1); \
    if ((++_sp & 255u) == 0u) { if (xb_ld(&(bar)[XB_TMO])) break; if (_sp > XB_SPIN_CAP) { atomicAdd(&(bar)[XB_TMO], 1u); break; } } } } while (0)
struct XcdBarrier { unsigned* bar; unsigned x; volatile LAS unsigned* st; int wave; };
__device__ __forceinline__ XcdBarrier xcd_barrier_post(unsigned* bar, volatile LAS unsigned* st) {
    XcdBarrier b; b.bar = bar; b.x = xb_xcc_id(); b.st = st; b.wave = 0;
    if (threadIdx.x == 0) (void)xb_add(&bar[XB_XCNT(b.x)], 1u);
    return b;
}
__device__ __forceinline__ void xcd_barrier_complete(unsigned* bar, unsigned x, unsigned& nloc, unsigned& nx) {
    const unsigned G = gridDim.x * gridDim.y * gridDim.z;
    unsigned sum, cnt, mine, sp = 0u;
    for (;;) {
        sum = 0u; cnt = 0u; mine = 0u;
#pragma unroll
        for (unsigned j = 0; j < 16; ++j) { const unsigned c = xb_ld(&bar[XB_XCNT(j)]); sum += c; cnt += (c > 0u) ? 1u : 0u; mine = (j == x) ? c : mine; }
        if (sum == G) break;
        __builtin_amdgcn_s_sleep(1);
        if ((++sp & 255u) == 0u) { if (xb_ld(&bar[XB_TMO])) break; if (sp > XB_SPIN_CAP) { atomicAdd(&bar[XB_TMO], 1u); break; } }
    }
    nloc = mine > 0u ? mine : 1u; nx = cnt > 0u ? cnt : 1u;
}
__device__ __forceinline__ void xcd_barrier(const XcdBarrier& b) {
    asm volatile("s_waitcnt vmcnt(0)" ::: "memory");
    __syncthreads();
    if (b.wave == 0 && lane_id() == 0) {
        unsigned* bar = b.bar;
        __builtin_amdgcn_s_waitcnt(0);
        unsigned nloc = b.st[0], nx = b.st[1];
        if (nloc == 0u) { xcd_barrier_complete(bar, b.x, nloc, nx); b.st[0] = nloc; b.st[1] = nx; }
        const unsigned old = xb_add(&bar[XB_XSUB(b.x)], 1u);
        const unsigned gen = old / nloc;
        if (old + 1u == (gen + 1u) * nloc) {
            __builtin_amdgcn_fence(__ATOMIC_RELEASE, "agent");
            asm volatile("s_waitcnt vmcnt(0)" ::: "memory");
            const unsigned og = xb_add(&bar[XB_TOP], 1u);
            const unsigned tg = og / nx;
            if (og + 1u == (tg + 1u) * nx) xb_add(&bar[XB_TOPGEN], 1u);
            else XB_SPIN(xb_ld(&bar[XB_TOPGEN]) == tg, bar);
            __builtin_amdgcn_fence(__ATOMIC_ACQUIRE, "agent");
            xb_add(&bar[XB_XGEN(b.x)], 1u);
            asm volatile("s_waitcnt vmcnt(0)" ::: "memory");
        } else {
            XB_SPIN(xb_ld(&bar[XB_XGEN(b.x)]) == gen, bar);
            __builtin_amdgcn_fence(__ATOMIC_ACQUIRE, "agent");
            asm volatile("s_waitcnt vmcnt(0)" ::: "memory");
        }
    }
    __syncthreads();
}

struct Frame {
    LAS unsigned char* lds;
    volatile LAS unsigned* MISC;
    gu32* ctl;
    int wave;
    int vcu, G;
    float* out;
    unsigned char* ws;
};
struct Args { const float* in[21]; float* out; unsigned char* ws; int ph_lo, ph_hi, li, pad; };
__device__ __forceinline__ const float* arg_in(int i) {
    const __attribute__((address_space(4))) char* ka = (const __attribute__((address_space(4))) char*)__builtin_amdgcn_kernarg_segment_ptr();
    unsigned off = (unsigned)i * 8u; asm volatile("" : "+s"(off));
    return *(const float* const __attribute__((address_space(4)))*)(ka + off);
}
__device__ __forceinline__ float wave_sum(float v) {
#pragma unroll
    for (int o = 1; o < 64; o <<= 1) v += __shfl_xor(v, o);
    return v;
}

struct DenseOrder {
    static constexpr bool GATHER = false;
    int nM, nN, nwg, G, c, extra, ex0, wave; long a_tile, b_tile;
    __device__ void init(int wave_, int nM_, int nN_, int G_, int c_, long a_tile_, long b_tile_, int extra_ = 0, int ex0_ = 0) { wave = wave_; nM = nM_; nN = nN_; nwg = nM * nN; G = G_; c = c_; a_tile = a_tile_; b_tile = b_tile_; extra = extra_; ex0 = ex0_; }
    __device__ bool next(int i, pg8::Unit& u) const {
        const long L = (long)i * G + c; if (L >= nwg + extra) return false;
        if (L >= nwg) { u.pm = nM; u.pn = ex0 + (int)(L - nwg); }
        else {
            int wgid = (int)L; { const int q = nwg / pg8::NXCD, r = nwg % pg8::NXCD, xcd = wgid % pg8::NXCD, off = wgid / pg8::NXCD; wgid = (xcd < r ? xcd * (q + 1) : r * (q + 1) + (xcd - r) * q) + off; }
            const int nig = pg8::WGM * nN, gid = wgid / nig, fm = gid * pg8::WGM, gsz = (nM - fm) < pg8::WGM ? (nM - fm) : pg8::WGM;
            u.pm = fm + ((wgid % nig) % gsz); u.pn = (wgid % nig) / gsz;
        }
        u.a_byte = (long)u.pm * a_tile; u.b_byte = (long)u.pn * b_tile; u.e = 0; u.mt = 0; u.cnt = 0; return true;
    }
    __device__ __forceinline__ unsigned row_byte(const pg8::Unit&, int) const { return 0u; }
    __device__ __forceinline__ void a_ready(const pg8::Unit&) const {}
};
__device__ __forceinline__ void wait_count(unsigned* word, unsigned need, unsigned* tmo) {
    unsigned sp = 0;
    while ((unsigned)__builtin_amdgcn_readfirstlane((int)__hip_atomic_load(word, RLX_AGENT)) < need) {
        __builtin_amdgcn_s_sleep(2);
        if (++sp > (1u << 22)) { if (lane_id() == 0) __hip_atomic_store(tmo, 1u, RLX_AGENT); break; }
    }
    __builtin_amdgcn_fence(__ATOMIC_ACQUIRE, "agent");
    asm volatile("s_waitcnt vmcnt(0)" ::: "memory");
}
struct DenseOrderDep : DenseOrder {
    unsigned* rdy; unsigned need; unsigned* tmo;
    __device__ __forceinline__ void a_ready(const pg8::Unit& u) const {
        if (wave == 0) wait_count(rdy + 64 * u.pm, need, tmo);
        asm volatile("" ::: "memory"); __builtin_amdgcn_s_barrier(); asm volatile("" ::: "memory");
    }
};
template <int NT, bool GATH>
struct MoeOrder {
    static constexpr bool GATHER = GATH;
    int wave; volatile LAS int* tp; volatile LAS int* cn; int G, c; long b_exp, b_tile, a_tile; const int* rowidx; unsigned row_bytes;
    __device__ bool next(int i, pg8::Unit& u) const {
        const int total = __builtin_amdgcn_readfirstlane(tp[32]) * NT;
        const long L = (long)i * G + c; if (L >= total) return false;
        const int T = (int)(L / NT), n = (int)(L % NT);
        const int l_ = lane_id(); const int tv_ = tp[l_ & 31];
        const int e = (int)__builtin_popcountll(__ballot(l_ >= 1 && l_ < 32 && tv_ <= T));
        u.e = e; u.mt = T - __builtin_amdgcn_readfirstlane(tp[e]); u.cnt = __builtin_amdgcn_readfirstlane(cn[e]); u.pm = T; u.pn = n;
        u.a_byte = GATH ? 0 : (long)T * a_tile; u.b_byte = (long)e * b_exp + (long)n * b_tile; return true;
    }
    __device__ __forceinline__ unsigned row_byte(const pg8::Unit& u, int r) const {
        const int pos = u.mt * 256 + r;
        int tk = 0; if (pos < u.cnt) tk = rowidx[u.e * MREAL + pos];
        return (unsigned)(tk >> 1) * row_bytes;
    }
    __device__ __forceinline__ void a_ready(const pg8::Unit&) const {}
};
struct MoeDownOrder {
    static constexpr bool GATHER = false;
    int wave; volatile LAS int* tp; volatile LAS int* cn; int G, c; long b_exp, b_tile, a_tile; unsigned* rdy; unsigned* wd; unsigned* tmo;
    __device__ bool next(int i, pg8::Unit& u) const {
        const int T = __builtin_amdgcn_readfirstlane(tp[32]);
        const int T1 = T < G / 4 ? T : G / 4, nb2 = 4 * T > G ? 4 * T - G : 0;
        int Tt, n;
        if (c >= nb2) { const int j = (c - nb2) + i * (G - nb2); if (j >= 8 * T1) return false; Tt = j >> 3; n = j & 7; }
        else { const int j = c + i * nb2; if (j >= 8 * (T - T1)) return false; Tt = T1 + (j >> 3); n = j & 7; }
        const int l_ = lane_id(); const int tv_ = tp[l_ & 31];
        const int e = (int)__builtin_popcountll(__ballot(l_ >= 1 && l_ < 32 && tv_ <= Tt));
        u.e = e; u.mt = Tt - __builtin_amdgcn_readfirstlane(tp[e]); u.cnt = __builtin_amdgcn_readfirstlane(cn[e]); u.pm = Tt; u.pn = n;
        u.a_byte = (long)Tt * a_tile; u.b_byte = (long)e * b_exp + (long)n * b_tile; return true;
    }
    __device__ __forceinline__ unsigned row_byte(const pg8::Unit&, int) const { return 0u; }
    __device__ __forceinline__ void a_ready(const pg8::Unit& u) const {
        if (wave == 0) {
            unsigned sp = 0;
            while ((unsigned)__builtin_amdgcn_readfirstlane((int)__hip_atomic_load(rdy + 64 * u.pm, RLX_AGENT)) < 32u) {
                __builtin_amdgcn_s_sleep(2);
                if (++sp > (1u << 22)) { if (lane_id() == 0) __hip_atomic_store(tmo, 1u, RLX_AGENT); break; }
            }
            __builtin_amdgcn_fence(__ATOMIC_ACQUIRE, "agent");
            asm volatile("s_waitcnt vmcnt(0)" ::: "memory");
        }
        asm volatile("" ::: "memory"); __builtin_amdgcn_s_barrier(); asm volatile("" ::: "memory");
    }
};

__device__ __forceinline__ void st16_wt(void* p, v4u v) { asm volatile("global_store_dwordx4 %0, %1, off sc1\n\ts_nop 1" :: "v"(p), "v"(v) : "memory"); }
using pg8::Unit; using pg8::HALF; using pg8::BM;
struct EpiBf16 {
    static constexpr bool PERM = true, MID = false;
    bf16* O; int ldc; int pp_lo, pp_hi, pp_col, sg_lo;
    __device__ __forceinline__ void mid(f32x4 (&)[2][2][4][2], const Unit&, int, int, int, int) const {}
    __device__ __forceinline__ void operator()(const f32x4 (&acc)[2][2][4][2], const Unit& u, int wr, int wc, int fr, int fq) const {
        const int row0 = u.pm * BM + wr * 64 + fr, col0 = u.pn * BM + wc * 32 + 8 * fq;
        if (pp_lo <= u.pn && u.pn < pp_hi) {
            const int pc = pp_col + (u.pn - pp_lo) * HALF + wc * 32 + 8 * fq;
#pragma unroll
            for (int ai = 0; ai < 2; ++ai)
#pragma unroll
                for (int m = 0; m < 4; ++m) { bf16* rowp = O + (size_t)(row0 + ai * HALF + m * 16) * ldc + pc;
                    const f32x4 v0 = acc[ai][0][m][0] * acc[ai][1][m][0], v1 = acc[ai][0][m][1] * acc[ai][1][m][1];
                    v4u w; w.x = cvt_pk_bf16(v0[0], v0[1]); w.y = cvt_pk_bf16(v0[2], v0[3]); w.z = cvt_pk_bf16(v1[0], v1[1]); w.w = cvt_pk_bf16(v1[2], v1[3]);
                    *(v4u*)rowp = w; }
            return;
        }
        const bool sg = u.pn >= sg_lo;
#pragma unroll
        for (int ai = 0; ai < 2; ++ai)
#pragma unroll
            for (int m = 0; m < 4; ++m) { bf16* rowp = O + (size_t)(row0 + ai * HALF + m * 16) * ldc + col0;
#pragma unroll
                for (int bj = 0; bj < 2; ++bj) { f32x4 v0 = acc[ai][bj][m][0], v1 = acc[ai][bj][m][1];
                    if (sg) {
#pragma unroll
                        for (int j = 0; j < 4; ++j) { v0[j] = __builtin_amdgcn_rcpf(1.0f + __expf(-v0[j])); v1[j] = __builtin_amdgcn_rcpf(1.0f + __expf(-v1[j])); } }
                    v4u w; w.x = cvt_pk_bf16(v0[0], v0[1]); w.y = cvt_pk_bf16(v0[2], v0[3]); w.z = cvt_pk_bf16(v1[0], v1[1]); w.w = cvt_pk_bf16(v1[2], v1[3]);
                    *(v4u*)(rowp + bj * HALF) = w; } }
    }
};
__device__ __forceinline__ float sigm(float x) { return __builtin_amdgcn_rcpf(1.0f + __expf(-x)); }
struct EpiGate {
    static constexpr bool PERM = true, MID = true;
    bf16* P; bf16* MRG; unsigned* rdy;
    __device__ __forceinline__ void mid(f32x4 (&acc)[2][2][4][2], const Unit& u, int wr, int wc, int fr, int fq) const {
        int row0 = u.pm * BM + wr * 64 + fr, col0 = u.pn * BM + wc * 32 + 8 * fq;
        asm volatile("" : "+v"(row0), "+v"(col0));
#pragma unroll
        for (int ai = 0; ai < 2; ++ai)
#pragma unroll
            for (int m = 0; m < 4; ++m) { const bf16* rowp = P + (size_t)(row0 + ai * HALF + m * 16) * LDP + col0;
#pragma unroll
                for (int bj = 0; bj < 2; ++bj) { const v4u a = *(const v4u*)(rowp + PC_GA + bj * HALF), c = *(const v4u*)(rowp + PC_GC + bj * HALF);
                    const unsigned aw[4] = {a.x, a.y, a.z, a.w}, cw[4] = {c.x, c.y, c.z, c.w};
#pragma unroll
                    for (int q = 0; q < 4; ++q) {
                        const float r0 = bf_lo(aw[q]) * __builtin_amdgcn_rcpf(bf_lo(cw[q]));
                        const float r1 = bf_hi(aw[q]) * __builtin_amdgcn_rcpf(bf_hi(cw[q]));
                        acc[ai][bj][m][q >> 1][(q & 1) * 2] *= r0; acc[ai][bj][m][q >> 1][(q & 1) * 2 + 1] *= r1; } }
                asm volatile("" ::: "memory"); }
    }
    __device__ __forceinline__ void operator()(const f32x4 (&acc)[2][2][4][2], const Unit& u, int wr, int wc, int fr, int fq) const {
        const int row0 = u.pm * BM + wr * 64 + fr, col0 = u.pn * BM + wc * 32 + 8 * fq;
#pragma unroll
        for (int ai = 0; ai < 2; ++ai)
#pragma unroll
            for (int m = 0; m < 4; ++m) { bf16* rowp = P + (size_t)(row0 + ai * HALF + m * 16) * LDP + col0;
#pragma unroll
                for (int bj = 0; bj < 2; ++bj) { const v4u c = *(const v4u*)(rowp + PC_GC + bj * HALF); const unsigned cw[4] = {c.x, c.y, c.z, c.w};
                    const f32x4 v0 = acc[ai][bj][m][0], v1 = acc[ai][bj][m][1];
                    v4u w;
                    w.x = cvt_pk_bf16(v0[0] * bf_lo(cw[0]), v0[1] * bf_hi(cw[0])); w.y = cvt_pk_bf16(v0[2] * bf_lo(cw[1]), v0[3] * bf_hi(cw[1]));
                    w.z = cvt_pk_bf16(v1[0] * bf_lo(cw[2]), v1[1] * bf_hi(cw[2])); w.w = cvt_pk_bf16(v1[2] * bf_lo(cw[3]), v1[3] * bf_hi(cw[3]));
                    bf16* mp = MRG + (size_t)(row0 + ai * HALF + m * 16) * DM + col0 + bj * HALF;
                    if (rdy) st16_wt(mp, w); else *(v4u*)mp = w; }
                asm volatile("" ::: "memory"); }
        if (rdy) { asm volatile("s_waitcnt vmcnt(0)" ::: "memory"); if (fr == 0 && fq == 0) __hip_atomic_fetch_add(rdy + 64 * u.pm, 1u, RLX_AGENT); }
    }
};
struct EpiPre {
    static constexpr bool PERM = true, MID = false;
    const bf16* XN; bf16* pre; int ldo; unsigned* rdy;
    __device__ __forceinline__ void mid(f32x4 (&)[2][2][4][2], const Unit&, int, int, int, int) const {}
    __device__ __forceinline__ void operator()(const f32x4 (&acc)[2][2][4][2], const Unit& u, int wr, int wc, int fr, int fq) const {
        const int row0 = u.pm * BM + wr * 64 + fr, col0 = u.pn * BM + wc * 32 + 8 * fq;
#pragma unroll
        for (int ai = 0; ai < 2; ++ai)
#pragma unroll
            for (int m = 0; m < 4; ++m) { const int r = row0 + ai * HALF + m * 16; const bf16* xr = XN + (size_t)r * DM + col0; bf16* orow = pre + (size_t)r * ldo + col0;
#pragma unroll
                for (int bj = 0; bj < 2; ++bj) { const v4u h = *(const v4u*)(xr + bj * HALF); const f32x4 a0 = acc[ai][bj][m][0], a1 = acc[ai][bj][m][1];
                    v4u o; o.x = cvt_pk_bf16(ALPHA * bf_lo(h.x) + a0[0], ALPHA * bf_hi(h.x) + a0[1]); o.y = cvt_pk_bf16(ALPHA * bf_lo(h.y) + a0[2], ALPHA * bf_hi(h.y) + a0[3]);
                    o.z = cvt_pk_bf16(ALPHA * bf_lo(h.z) + a1[0], ALPHA * bf_hi(h.z) + a1[1]); o.w = cvt_pk_bf16(ALPHA * bf_lo(h.w) + a1[2], ALPHA * bf_hi(h.w) + a1[3]);
                    if (rdy) st16_wt(orow + bj * HALF, o); else *(v4u*)(orow + bj * HALF) = o; } }
        if (rdy) { asm volatile("s_waitcnt vmcnt(0)" ::: "memory"); if (fr == 0 && fq == 0) __hip_atomic_fetch_add(rdy + 64 * u.pm, 1u, RLX_AGENT); }
    }
};
struct EpiAct {
    static constexpr bool PERM = true, MID = false;
    bf16* act; unsigned* rdy;
    __device__ __forceinline__ void mid(f32x4 (&)[2][2][4][2], const Unit&, int, int, int, int) const {}
    __device__ __forceinline__ void operator()(const f32x4 (&acc)[2][2][4][2], const Unit& u, int wr, int wc, int fr, int fq) const {
        const int row0 = u.pm * BM + wr * 64 + fr, col0 = u.pn * HALF + wc * 32 + 8 * fq;
#pragma unroll
        for (int ai = 0; ai < 2; ++ai)
#pragma unroll
            for (int m = 0; m < 4; ++m) { bf16* rowp = act + (size_t)(row0 + ai * HALF + m * 16) * DE + col0;
                float o[8];
#pragma unroll
                for (int n = 0; n < 2; ++n)
#pragma unroll
                    for (int j = 0; j < 4; ++j) { const float gt = acc[ai][0][m][n][j], up = acc[ai][1][m][n][j]; o[n * 4 + j] = gt * sigm(gt) * up; }
                v4u w; w.x = cvt_pk_bf16(o[0], o[1]); w.y = cvt_pk_bf16(o[2], o[3]); w.z = cvt_pk_bf16(o[4], o[5]); w.w = cvt_pk_bf16(o[6], o[7]);
                if (MK_MOE_MERGE && N_LAUNCHES == 1) st16_wt(rowp, w); else *(v4u*)rowp = w; }
        if (MK_MOE_MERGE && N_LAUNCHES == 1) {
            asm volatile("s_waitcnt vmcnt(0)" ::: "memory");
            if (fr == 0 && fq == 0) __hip_atomic_fetch_add(rdy + 64 * u.pm, 1u, RLX_AGENT);
        }
    }
};
struct EpiDown {
    static constexpr bool PERM = true, MID = false;
    bf16* Y;
    __device__ __forceinline__ void mid(f32x4 (&)[2][2][4][2], const Unit&, int, int, int, int) const {}
    __device__ __forceinline__ void operator()(const f32x4 (&acc)[2][2][4][2], const Unit& u, int wr, int wc, int fr, int fq) const {
        const int row0 = u.pm * BM + wr * 64 + fr, col0 = u.pn * BM + wc * 32 + 8 * fq;
#pragma unroll
        for (int ai = 0; ai < 2; ++ai)
#pragma unroll
            for (int m = 0; m < 4; ++m) { bf16* rowp = Y + (size_t)(row0 + ai * HALF + m * 16) * DM + col0;
#pragma unroll
                for (int bj = 0; bj < 2; ++bj) { const f32x4 v0 = acc[ai][bj][m][0], v1 = acc[ai][bj][m][1];
                    v4u o; o.x = cvt_pk_bf16(v0[0], v0[1]); o.y = cvt_pk_bf16(v0[2], v0[3]); o.z = cvt_pk_bf16(v1[0], v1[1]); o.w = cvt_pk_bf16(v1[2], v1[3]);
                    *(v4u*)(rowp + bj * HALF) = o; } }
    }
};

struct ConvTile { const float* src; bf16* dst0; bf16* dst1; int ld_src, ld_dst; };
constexpr int CT_A = CT_IN;
constexpr int CT_B = 3 * CT_SQ + 2 * CT_GU + CT_DN;
constexpr int CT_PITCH = 144, CT_BUF = 256 * CT_PITCH;
__device__ __forceinline__ ConvTile conv_tile_a(int r, unsigned char* ws) {
    const int nt = r >> 5, kg = r & 31, ns = nt * 256, k0 = 64 * kg;
    int nn = ns; if (ns >= 2048 && ns < 2560) nn = ns + 2048; else if (ns >= 2560 && ns < 4608) nn = ns - 512;
    bf16* d = (bf16*)(ws + WS_WIN) + (size_t)nn * DM + k0; bf16* d1 = d + (size_t)128 * DM;
    if (ns >= PC_CC && ns < PC_GA) {
        const int ch = ns >= PC_CH ? 1 : 0, sidx = (ns - (ch ? PC_CH : PC_CC)) >> 8;
        d = (bf16*)(ws + WS_WIN) + (size_t)(256 * (18 + 2 * sidx) + 128 * ch) * DM + k0; d1 = d + (size_t)256 * DM; }
    return ConvTile{arg_in(4) + (size_t)k0 * LDP + ns, d, d1, LDP, DM};
}
__device__ __forceinline__ ConvTile conv_tile_b(int r, unsigned char* ws) {
    bf16* Wb2_t = (bf16*)(ws + WS_WB2); bf16* Wout_t = (bf16*)(ws + WS_WOUT); bf16* Wgu_t = (bf16*)(ws + WS_WGU); bf16* Wd_t = (bf16*)(ws + WS_WD);
    if (r < 2 * CT_SQ) { const int cv = r >= CT_SQ ? 1 : 0; r -= cv * CT_SQ; const int nt = r >> 5, k0 = 64 * (r & 31), n = nt * 256;
        bf16* d = Wb2_t + (size_t)n * 4096 + cv * 2048 + k0; return ConvTile{arg_in(7 + cv) + (size_t)k0 * DM + n, d, d + (size_t)128 * 4096, DM, 4096}; }
    r -= 2 * CT_SQ;
    if (r < CT_SQ) { const int nt = r >> 5, k0 = 64 * (r & 31), n = nt * 256; bf16* d = Wout_t + (size_t)n * DM + k0; return ConvTile{arg_in(9) + (size_t)k0 * DM + n, d, d + (size_t)128 * DM, DM, DM}; }
    r -= CT_SQ;
    if (r < 2 * CT_GU) { const int up = r >= CT_GU ? 1 : 0; r -= up * CT_GU; const int e = r >> 6, q = r & 63, nt = q >> 5, k0 = 64 * (q & 31), n = nt * 256;
        bf16* d = Wgu_t + ((size_t)e * 1024 + (size_t)(n >> 7) * 256 + up * 128) * DM + k0;
        return ConvTile{arg_in(16 + up) + (size_t)e * DM * DE + (size_t)k0 * DE + n, d, d + (size_t)256 * DM, DE, DM}; }
    r -= 2 * CT_GU;
    { const int e = r >> 6, q = r & 63, nt = q >> 3, k0 = 64 * (q & 7), n = nt * 256;
      bf16* d = Wd_t + ((size_t)e * DM + n) * DE + k0; return ConvTile{arg_in(18) + (size_t)e * DE * DM + (size_t)k0 * DM + n, d, d + (size_t)128 * DE, DM, DE}; }
}
struct ConvRegs { f32x4 v[8]; };
__device__ __forceinline__ void conv_load(ConvRegs& R, const ConvTile& t, int w, int lane) {
    const float* p = t.src + (size_t)(8 * w) * t.ld_src + 4 * lane;
#pragma unroll
    for (int i = 0; i < 8; ++i) R.v[i] = __builtin_nontemporal_load((const f32x4*)(p + (size_t)i * t.ld_src));
}
__device__ __forceinline__ void conv_lds_write(const ConvRegs& R, LAS unsigned char* buf, int w, int lane) {
#pragma unroll
    for (int j = 0; j < 4; ++j) { v4u o; o.x = cvt_pk_bf16(R.v[0][j], R.v[1][j]); o.y = cvt_pk_bf16(R.v[2][j], R.v[3][j]); o.z = cvt_pk_bf16(R.v[4][j], R.v[5][j]); o.w = cvt_pk_bf16(R.v[6][j], R.v[7][j]);
        *(LAS v4u*)(buf + (4 * lane + j) * CT_PITCH + 16 * w) = o; }
}
template <bool WT>
__device__ __forceinline__ void conv_store(const ConvTile& t, LAS const unsigned char* buf, int w, int lane) {
    const int c = lane & 7, nr = 8 * w + (lane >> 3);
#pragma unroll
    for (int p = 0; p < 4; ++p) { const int n = nr + 64 * p; const v4u o = *(LAS const v4u*)(buf + n * CT_PITCH + 16 * c);
        bf16* d = (p < 2 ? t.dst0 + (size_t)n * t.ld_dst : t.dst1 + (size_t)(n - 128) * t.ld_dst) + 8 * c;
        if (WT) st16_wt(d, o); else *(GAS v4u*)d = o; }
}
template <int LIST, bool WT = false>
__device__ __forceinline__ void conv_run(int first, int last, int stride, unsigned char* ws, LAS unsigned char* lds, int w, int lane, int& par) {
    if (first >= last) return;
    ConvTile t0 = LIST ? conv_tile_b(first, ws) : conv_tile_a(first, ws), t1 = t0;
    ConvRegs r0, r1;
    conv_load(r0, t0, w, lane);
    r1 = r0;
    for (int it = first; it < last; it += stride) {
        const int nx = it + stride;
        if (nx < last) { t1 = LIST ? conv_tile_b(nx, ws) : conv_tile_a(nx, ws); conv_load(r1, t1, w, lane); }
        LAS unsigned char* buf = lds + par * CT_BUF; par ^= 1;
        conv_lds_write(r0, buf, w, lane);
        __syncthreads();
        conv_store<WT>(t0, buf, w, lane);
        r0 = r1; t0 = t1;
    }
}
constexpr int CT_CHUNK = 4;
constexpr int CT_B1 = 3 * CT_SQ + 2 * CT_GU;
template <bool WT = false>
__device__ __forceinline__ void conv_queue(unsigned* qhead, int lo, int hi, unsigned char* ws, LAS unsigned char* lds, volatile LAS unsigned* slot, int w, int lane, unsigned* done = nullptr) {
    int par = 0;
    for (;;) {
        __syncthreads();
        if (w == 0 && lane == 0) slot[0] = __hip_atomic_fetch_add(qhead, (unsigned)CT_CHUNK, RLX_AGENT);
        __syncthreads();
        const int base = lo + __builtin_amdgcn_readfirstlane((int)slot[0]);
        if (base >= hi) break;
        const int end = base + CT_CHUNK < hi ? base + CT_CHUNK : hi;
        conv_run<1, WT>(base, end, 1, ws, lds, w, lane, par);
        if (WT) {
            asm volatile("s_waitcnt vmcnt(0)" ::: "memory");
            __syncthreads();
            if (w == 0 && lane == 0) __hip_atomic_fetch_add(done, (unsigned)(end - base), RLX_AGENT);
        }
    }
}
__device__ __forceinline__ void ln_regs_to_bf16(f32x4 (&v)[8], const float* g, const float* b, bf16* orow, int lane) {
    asm volatile("" : "+v"(lane));
    float s = 0.f;
#pragma unroll
    for (int j = 0; j < 8; ++j) s += (v[j][0] + v[j][1]) + (v[j][2] + v[j][3]);
    const float mean = wave_sum(s) * (1.f / DM); float s2 = 0.f;
#pragma unroll
    for (int j = 0; j < 8; ++j) { v[j] = v[j] - mean; s2 += (v[j][0] * v[j][0] + v[j][1] * v[j][1]) + (v[j][2] * v[j][2] + v[j][3] * v[j][3]); }
    const float rstd = 1.f / sqrtf(wave_sum(s2) * (1.f / DM) + LN_EPS);
    v2u* o8 = (v2u*)orow + lane;
#pragma unroll
    for (int j = 0; j < 8; ++j) { const f32x4 gg = ((const f32x4*)g)[lane + 64 * j], bb = ((const f32x4*)b)[lane + 64 * j]; const f32x4 y = v[j] * rstd * gg + bb;
        v2u w; w.x = pk2(y[0], y[1]); w.y = pk2(y[2], y[3]); o8[64 * j] = w; }
}
__device__ __forceinline__ void ln_row_to_bf16(const float* xrow, const float* g, const float* b, bf16* orow, int lane) {
    asm volatile("" : "+v"(lane));
    const f32x4* xr = (const f32x4*)xrow + lane;
    f32x4 v[8]; float s = 0.f;
#pragma unroll
    for (int j = 0; j < 8; ++j) { v[j] = xr[64 * j]; s += (v[j][0] + v[j][1]) + (v[j][2] + v[j][3]); }
    const float mean = wave_sum(s) * (1.f / DM); float s2 = 0.f;
#pragma unroll
    for (int j = 0; j < 8; ++j) { v[j] = v[j] - mean; s2 += (v[j][0] * v[j][0] + v[j][1] * v[j][1]) + (v[j][2] * v[j][2] + v[j][3] * v[j][3]); }
    const float rstd = 1.f / sqrtf(wave_sum(s2) * (1.f / DM) + LN_EPS);
    v2u* o8 = (v2u*)orow + lane;
#pragma unroll
    for (int j = 0; j < 8; ++j) { const f32x4 gg = ((const f32x4*)g)[lane + 64 * j], bb = ((const f32x4*)b)[lane + 64 * j]; const f32x4 y = v[j] * rstd * gg + bb;
        v2u w; w.x = pk2(y[0], y[1]); w.y = pk2(y[2], y[3]); o8[64 * j] = w; }
}
__device__ __forceinline__ void p0_prologue(Frame& F, const Args& A) {
    const int lane0 = lane_id(), tid0 = F.wave * 64 + lane0;
    const int gw = F.vcu * NWAVES + F.wave, NGW = F.G * NWAVES;
    bf16* XN = (bf16*)(F.ws + WS_XN);
    { int par = 0; conv_run<0>((int)blockIdx.x, CT_A, F.G, F.ws, F.lds + RING_OFF, F.wave, lane0, par); __syncthreads(); }
    { bf16* whi = (bf16*)(F.ws + WS_REWG); bf16* wlo = whi + 48 * DM; const float* rgw = arg_in(12); const float* rew = arg_in(14);
      for (int i = (F.vcu * NWAVES * 64) + tid0; i < 48 * DM; i += F.G * NWAVES * 64) { const int n = i / DM, k = i % DM;
          const float w = n < NGRP ? rgw[k * NGRP + n] : (n < NGRP + NEXP ? rew[k * NEXP + (n - NGRP)] : 0.f);
          const unsigned hi = f2bf(w); const float rem = w - __builtin_bit_cast(float, hi << 16);
          whi[i] = (bf16)hi; wlo[i] = (bf16)f2bf(rem); } }
    {
        const float* xin = arg_in(0); const float* g = arg_in(2); const float* b = arg_in(3);
        f32x4 va[8], vb[8];
        int m = gw;
        if (m < MREAL) {
#pragma unroll
            for (int j = 0; j < 8; ++j) va[j] = __builtin_nontemporal_load((const f32x4*)(xin + (size_t)m * DM) + lane0 + 64 * j);
        }
        for (; m < MREAL; m += 2 * NGW) {
            const int m1 = m + NGW, m2 = m + 2 * NGW;
            if (m1 < MREAL) {
#pragma unroll
                for (int j = 0; j < 8; ++j) vb[j] = __builtin_nontemporal_load((const f32x4*)(xin + (size_t)m1 * DM) + lane0 + 64 * j);
            }
            ln_regs_to_bf16(va, g, b, XN + (size_t)m * DM, lane0);
            if (m2 < MREAL) {
#pragma unroll
                for (int j = 0; j < 8; ++j) va[j] = __builtin_nontemporal_load((const f32x4*)(xin + (size_t)m2 * DM) + lane0 + 64 * j);
            }
            if (m1 < MREAL) ln_regs_to_bf16(vb, g, b, XN + (size_t)m1 * DM, lane0);
        }
    }
    for (int m = MREAL + gw; m < MPAD; m += NGW) {
        if (m < MREAL + NMETA) ln_row_to_bf16(arg_in(1) + (size_t)(m - MREAL) * DM, arg_in(2), arg_in(3), XN + (size_t)m * DM, lane0);
        else { v2u* o8 = (v2u*)(XN + (size_t)m * DM) + lane0;
#pragma unroll
            for (int j = 0; j < 8; ++j) o8[64 * j] = (v2u){0u, 0u}; }
    }
}

constexpr int KS_PITCH = 144;
constexpr int VT_PITCH = 584;
constexpr int KROWS = 288;
constexpr int ATT_KS = 0, ATT_VT = KROWS * KS_PITCH, ATT_LDS = ATT_VT + 64 * VT_PITCH;
static_assert(ATT_LDS <= RING_BYTES, "attention LDS");
constexpr float LOG2E = 1.4426950408889634f;

template <int R>
__device__ __forceinline__ void attn_qblock(LAS const unsigned char* lds, bf16* P, int qrow0, int head, float sink_l2, bool has_prev, int lane) {
    asm volatile("" : "+v"(lane));
    const int ql = lane & 31, hh = lane >> 5;
    bf16* qp = P + (size_t)(qrow0 + 32 * R + ql) * LDP + PC_Q + head * HD;
    bf16x8 qf[4];
#pragma unroll
    for (int s = 0; s < 4; ++s) qf[s] = *(const bf16x8*)(qp + 16 * s + 8 * hh);
    f32x16 S[6];
#define KB_ROW(i) ((i) == 0 ? 0 : ((i) <= 4 - R ? 32 + 32 * (R + (i) - 1) : 160 + 32 * ((i) - (5 - R))))
#pragma unroll
    for (int i = 0; i < 6; ++i) {
        const int kr = KB_ROW(i);
        f32x16 a = {0.f, 0.f, 0.f, 0.f, 0.f, 0.f, 0.f, 0.f, 0.f, 0.f, 0.f, 0.f, 0.f, 0.f, 0.f, 0.f};
        const LAS unsigned char* kp = lds + ATT_KS + (kr + ql) * KS_PITCH + 16 * hh;
#pragma unroll
        for (int s = 0; s < 4; ++s) { const bf16x8 kf = *(const LAS bf16x8*)(kp + 32 * s); a = __builtin_amdgcn_mfma_f32_32x32x16_bf16(kf, qf[s], a, 0, 0, 0); }
        S[i] = a;
    }
    const float NEG = -INFINITY; const float sc = 0.125f * LOG2E;
    float mx = sink_l2;
#pragma unroll
    for (int i = 0; i < 6; ++i)
#pragma unroll
        for (int r = 0; r < 16; ++r) {
            const int kvl = (r & 3) + 8 * (r >> 2) + 4 * hh;
            float t = S[i][r] * sc;
            bool ok = true;
            if (i == 0) ok = kvl < NMETA;
            else if (i <= 4 - R) { ok = has_prev; if (i == 1) ok = ok && (kvl > ql); }
            else { if (i == 5) ok = (kvl <= ql); }
            t = ok ? t : NEG; S[i][r] = t; mx = fmaxf(mx, t);
        }
    mx = fmaxf(mx, __shfl_xor(mx, 32));
    float l = 0.f;
#pragma unroll
    for (int i = 0; i < 6; ++i)
#pragma unroll
        for (int r = 0; r < 16; ++r) { const float p = __builtin_amdgcn_exp2f(S[i][r] - mx); S[i][r] = p; l += p; }
    l += __shfl_xor(l, 32);
    l += __builtin_amdgcn_exp2f(sink_l2 - mx);
    const float inv = 1.0f / l;
    f32x16 O[2];
#pragma unroll
    for (int d = 0; d < 2; ++d) O[d] = (f32x16){0.f, 0.f, 0.f, 0.f, 0.f, 0.f, 0.f, 0.f, 0.f, 0.f, 0.f, 0.f, 0.f, 0.f, 0.f, 0.f};
#pragma unroll
    for (int i = 0; i < 6; ++i) {
        const int kr = KB_ROW(i);
#pragma unroll
        for (int s2 = 0; s2 < 2; ++s2) {
            unsigned pw[4];
#pragma unroll
            for (int j = 0; j < 4; ++j) pw[j] = cvt_pk_bf16(S[i][8 * s2 + 2 * j] * inv, S[i][8 * s2 + 2 * j + 1] * inv);
            const v4u pv = {pw[0], pw[1], pw[2], pw[3]};
            const bf16x8 pf = __builtin_bit_cast(bf16x8, pv);
#pragma unroll
            for (int d = 0; d < 2; ++d) {
                const LAS unsigned char* vp = lds + ATT_VT + (ql + 32 * d) * VT_PITCH + (kr + 16 * s2 + 4 * hh) * 2;
                const v2u lo = *(const LAS v2u*)vp, hi = *(const LAS v2u*)(vp + 16);
                const v4u vv = {lo.x, lo.y, hi.x, hi.y};
                O[d] = __builtin_amdgcn_mfma_f32_32x32x16_bf16(pf, __builtin_bit_cast(bf16x8, vv), O[d], 0, 0, 0);
            }
        }
    }
#undef KB_ROW
#pragma unroll
    for (int d = 0; d < 2; ++d)
#pragma unroll
        for (int r = 0; r < 16; ++r) { const int q = (r & 3) + 8 * (r >> 2) + 4 * hh;
            P[(size_t)(qrow0 + 32 * R + q) * LDP + PC_Q + head * HD + 32 * d + ql] = (bf16)f2bf(O[d][r]); }
}

__device__ __forceinline__ f32x4 conv_p(v2u a) { return (f32x4){bf_lo(a.x), bf_hi(a.x), bf_lo(a.y), bf_hi(a.y)}; }
__device__ __forceinline__ void p2_attention_conv(Frame& F, const Args& A) {
    bf16* P = (bf16*)(F.ws + WS_P);
    const float* sinks = arg_in(5);
    const float* cw = arg_in(6);
    const int lane0 = lane_id(), tid0 = F.wave * 64 + lane0;
    const int c0 = 4 * tid0;
    for (int it = blockIdx.x; it < BATCH * NKVH * (SEQ / WIN); it += F.G) {
        const int b = it / (NKVH * 16), kvh = (it / 16) % NKVH, nb = it % 16;
        const int row_own = b * SEQ + nb * WIN, row_prev = row_own - WIN;
        const int r0 = it * 32, s0 = r0 % SEQ;
        const int rm2 = (s0 == 0) ? MREAL + NMETA - 2 : r0 - 2, rm1 = (s0 == 0) ? MREAL + NMETA - 1 : r0 - 1;
        const f32x4 w0 = *(const f32x4*)(cw + c0), w1 = *(const f32x4*)(cw + DM + c0), w2 = *(const f32x4*)(cw + 2 * DM + c0);
        const v2u a2 = *(const v2u*)(P + (size_t)rm2 * LDP + PC_CC + c0);
        const v2u a1 = *(const v2u*)(P + (size_t)rm1 * LDP + PC_CC + c0);
        __syncthreads();
        v4u kq[5], vq[5];
#pragma unroll
        for (int i = 0; i < 5; ++i) { const int q = tid0 + i * (NWAVES * 64); const int row = q >> 3, c = q & 7;
            int grow = -1;
            if (row < NMETA) grow = MREAL + row;
            else if (row >= 32 && row < 160) { if (nb > 0) grow = row_prev + (row - 32); }
            else if (row >= 160 && row < KROWS) grow = row_own + (row - 160);
            kq[i] = (v4u){0u, 0u, 0u, 0u}; vq[i] = (v4u){0u, 0u, 0u, 0u};
            if (grow >= 0) { const bf16* rp = P + (size_t)grow * LDP; kq[i] = *(const v4u*)(rp + PC_K + kvh * HD + 8 * c); vq[i] = *(const v4u*)(rp + PC_V + kvh * HD + 8 * c); } }
#pragma unroll
        for (int i = 0; i < 5; ++i) { const int q = tid0 + i * (NWAVES * 64); const int row = q >> 3, c = q & 7;
            if (q < KROWS * 8) {
                *(LAS v4u*)(F.lds + ATT_KS + row * KS_PITCH + c * 16) = kq[i];
                const unsigned vw[4] = {vq[i].x, vq[i].y, vq[i].z, vq[i].w};
#pragma unroll
                for (int e = 0; e < 4; ++e) {
                    *(LAS unsigned short*)(F.lds + ATT_VT + (8 * c + 2 * e) * VT_PITCH + row * 2) = (unsigned short)(vw[e] & 0xffffu);
                    *(LAS unsigned short*)(F.lds + ATT_VT + (8 * c + 2 * e + 1) * VT_PITCH + row * 2) = (unsigned short)(vw[e] >> 16);
                } } }
        __syncthreads();
        const int head = kvh * 8 + F.wave;
        const float sink_l2 = sinks[head] * LOG2E;
        f32x4 pm2 = conv_p(a2), pm1 = conv_p(a1);
        const unsigned voff0 = (unsigned)c0 * 2u;
#define P2_STEP(R) do { \
            unsigned voff = voff0; asm volatile("" : "+v"(voff)); \
            v2u ca[8], cbb[8]; \
            _Pragma("unroll") for (int i = 0; i < 8; ++i) { const char* rp = (const char*)(P + (size_t)(r0 + 8 * (R) + i) * LDP);     \
                ca[i] = *(const v2u*)(rp + PC_CC * 2 + voff); cbb[i] = *(const v2u*)(rp + PC_CB * 2 + voff); } \
            asm volatile("" ::: "memory"); \
            attn_qblock<R>((LAS const unsigned char*)F.lds, P, row_own, head, sink_l2, nb > 0, lane0); \
            asm volatile("" ::: "memory"); \
            _Pragma("unroll") for (int i = 0; i < 8; ++i) { char* rp = (char*)(P + (size_t)(r0 + 8 * (R) + i) * LDP); \
                const f32x4 p = conv_p(ca[i]); const f32x4 cbv = {bf_lo(cbb[i].x), bf_hi(cbb[i].x), bf_lo(cbb[i].y), bf_hi(cbb[i].y)}; \
                const f32x4 uu = cbv * (w0 * pm2 + w1 * pm1 + w2 * p); \
                v2u o; o.x = pk2(uu[0], uu[1]); o.y = pk2(uu[2], uu[3]); *(v2u*)(rp + PC_CB * 2 + voff) = o; pm2 = pm1; pm1 = p; } } while (0)
        P2_STEP(0); P2_STEP(1); P2_STEP(2); P2_STEP(3);
        if (MK_SEAM23 && N_LAUNCHES == 1 && MK_DUP == 0) {
            asm volatile("s_waitcnt vmcnt(0)" ::: "memory"); __syncthreads();
            if (F.wave == 0 && lane0 == 0) { __builtin_amdgcn_fence(__ATOMIC_RELEASE, "agent"); asm volatile("s_waitcnt vmcnt(0)" ::: "memory");
                __hip_atomic_fetch_add(F.ctl + CW_P2 + 64 * (b * 8 + (nb >> 1)), 1u, RLX_AGENT); __hip_atomic_fetch_add(F.ctl + CW_P2 + 64 * (it >> 3), 1u, RLX_AGENT); }
        }
    }
}

#undef P2_STEP
__device__ __forceinline__ void p5_ln1_router(Frame& F, const Args& A) {
    const int lane = lane_id(), w = F.wave, tid = w * 64 + lane;
    const int rl = lane & 15, kq = lane >> 4;
    bf16* P = (bf16*)(F.ws + WS_P); bf16* XN = (bf16*)(F.ws + WS_XN);
    const float* g1 = arg_in(10); const float* b1 = arg_in(11);
    const float* rgb = arg_in(13); const float* reb = arg_in(15);
    const bf16* whi = (const bf16*)(F.ws + WS_REWG); const bf16* wlo = whi + 48 * DM;
    int* rowidx = (int*)(F.ws + WS_ROWIDX); float* tokw = (float*)(F.ws + WS_TOKW); int* slot = (int*)(F.ws + WS_SLOT);
    unsigned* cnt = (unsigned*)(F.ctl + CW_CNT);
    LAS float* red = (LAS float*)(F.lds + RING_OFF);
    LAS float* plog = (LAS float*)(F.lds + RING_OFF + 4096);
    LAS float* flog = (LAS float*)(F.lds + RING_OFF + 4096 + 49152);
    LAS float* bias = (LAS float*)(F.lds + RING_OFF + 4096 + 49152 + 6144);
    if (tid < NGRP + NEXP) bias[tid] = tid < NGRP ? rgb[tid] : reb[tid - NGRP];
    __syncthreads();
    const int kbase0 = 256 * w + 8 * kq, rl0 = rl;
    for (int rg = blockIdx.x; rg < MREAL / 32; rg += F.G) {
        if (MK_SEAM34 && N_LAUNCHES == 1 && MK_DUP == 0) { if (w == 0) wait_count((unsigned*)(F.ctl + CW_P4) + 64 * (rg >> 3), 64u, (unsigned*)(F.ctl + CW_TMO)); __syncthreads(); }
        int kbase = kbase0, rl = rl0; asm volatile("" : "+v"(kbase), "+v"(rl));
        f32x4 x[2][8][2];
#pragma unroll
        for (int hq = 0; hq < 2; ++hq) { const bf16* xp = P + (size_t)(rg * 32 + 16 * hq + rl) * LDP + PC_GA + kbase;
#pragma unroll
            for (int s = 0; s < 8; ++s) { const v4u q = *(const v4u*)(xp + 32 * s);
                x[hq][s][0] = (f32x4){bf_lo(q.x), bf_hi(q.x), bf_lo(q.y), bf_hi(q.y)}; x[hq][s][1] = (f32x4){bf_lo(q.z), bf_hi(q.z), bf_lo(q.w), bf_hi(q.w)}; } }
#pragma unroll
        for (int hq = 0; hq < 2; ++hq) { float sm = 0.f;
#pragma unroll
            for (int s = 0; s < 8; ++s) sm += ((x[hq][s][0][0] + x[hq][s][0][1]) + (x[hq][s][0][2] + x[hq][s][0][3])) + ((x[hq][s][1][0] + x[hq][s][1][1]) + (x[hq][s][1][2] + x[hq][s][1][3]));
            sm += __shfl_xor(sm, 16); sm += __shfl_xor(sm, 32);
            if (kq == 0) red[w * 32 + 16 * hq + rl] = sm; }
        __syncthreads();
        float rstd[2];
#pragma unroll
        for (int hq = 0; hq < 2; ++hq) { float tot = 0.f;
#pragma unroll
            for (int j = 0; j < 8; ++j) tot += red[j * 32 + 16 * hq + rl];
            const float mean = tot * (1.f / DM); float sq = 0.f;
#pragma unroll
            for (int s = 0; s < 8; ++s)
#pragma unroll
                for (int h = 0; h < 2; ++h) { x[hq][s][h] = x[hq][s][h] - mean; sq += (x[hq][s][h][0] * x[hq][s][h][0] + x[hq][s][h][1] * x[hq][s][h][1]) + (x[hq][s][h][2] * x[hq][s][h][2] + x[hq][s][h][3] * x[hq][s][h][3]); }
            sq += __shfl_xor(sq, 16); sq += __shfl_xor(sq, 32);
            if (kq == 0) red[256 + w * 32 + 16 * hq + rl] = sq; }
        __syncthreads();
#pragma unroll
        for (int hq = 0; hq < 2; ++hq) { float tq = 0.f;
#pragma unroll
            for (int j = 0; j < 8; ++j) tq += red[256 + j * 32 + 16 * hq + rl];
            rstd[hq] = 1.f / sqrtf(tq * (1.f / DM) + LN_EPS); }
        f32x4 acc[2][3];
#pragma unroll
        for (int hq = 0; hq < 2; ++hq)
#pragma unroll
            for (int nb = 0; nb < 3; ++nb) acc[hq][nb] = (f32x4){0.f, 0.f, 0.f, 0.f};
#pragma unroll
        for (int s = 0; s < 8; ++s) {
            const int k0 = kbase + 32 * s;
            const f32x4 ga = *(const f32x4*)(g1 + k0), gb = *(const f32x4*)(g1 + k0 + 4), ba = *(const f32x4*)(b1 + k0), bb = *(const f32x4*)(b1 + k0 + 4);
            bf16x8 bh[3], bl[3];
#pragma unroll
            for (int nb = 0; nb < 3; ++nb) { bh[nb] = *(const bf16x8*)(whi + (size_t)(16 * nb + rl) * DM + k0); bl[nb] = *(const bf16x8*)(wlo + (size_t)(16 * nb + rl) * DM + k0); }
#pragma unroll
            for (int hq = 0; hq < 2; ++hq) {
                const f32x4 ha = x[hq][s][0] * rstd[hq] * ga + ba, hb = x[hq][s][1] * rstd[hq] * gb + bb;
                v4u uh; uh.x = cvt_pk_bf16(ha[0], ha[1]); uh.y = cvt_pk_bf16(ha[2], ha[3]); uh.z = cvt_pk_bf16(hb[0], hb[1]); uh.w = cvt_pk_bf16(hb[2], hb[3]);
                *(v4u*)(XN + (size_t)(rg * 32 + 16 * hq + rl) * DM + k0) = uh;
                v4u ul; ul.x = cvt_pk_bf16(ha[0] - bf_lo(uh.x), ha[1] - bf_hi(uh.x)); ul.y = cvt_pk_bf16(ha[2] - bf_lo(uh.y), ha[3] - bf_hi(uh.y));
                ul.z = cvt_pk_bf16(hb[0] - bf_lo(uh.z), hb[1] - bf_hi(uh.z)); ul.w = cvt_pk_bf16(hb[2] - bf_lo(uh.w), hb[3] - bf_hi(uh.w));
                const bf16x8 ahi = __builtin_bit_cast(bf16x8, uh), alo = __builtin_bit_cast(bf16x8, ul);
#pragma unroll
                for (int nb = 0; nb < 3; ++nb) {
                    acc[hq][nb] = __builtin_amdgcn_mfma_f32_16x16x32_bf16(ahi, bh[nb], acc[hq][nb], 0, 0, 0);
                    acc[hq][nb] = __builtin_amdgcn_mfma_f32_16x16x32_bf16(alo, bh[nb], acc[hq][nb], 0, 0, 0);
                    acc[hq][nb] = __builtin_amdgcn_mfma_f32_16x16x32_bf16(ahi, bl[nb], acc[hq][nb], 0, 0, 0);
                }
            }
            asm volatile("" ::: "memory");
        }
#pragma unroll
        for (int hq = 0; hq < 2; ++hq)
#pragma unroll
            for (int nb = 0; nb < 3; ++nb)
#pragma unroll
                for (int i = 0; i < 4; ++i) plog[(w * 32 + 16 * hq + 4 * kq + i) * 48 + 16 * nb + rl] = acc[hq][nb][i];
        __syncthreads();
        for (int o = tid; o < 32 * 48; o += NWAVES * 64) { float t = 0.f;
#pragma unroll
            for (int j = 0; j < 8; ++j) t += plog[j * 1536 + o];
            flog[o] = t; }
        __syncthreads();
        if (tid < 32) {
            const LAS float* fl = flog + tid * 48; const int m = rg * 32 + tid;
            float gl[4];
#pragma unroll
            for (int c = 0; c < 4; ++c) gl[c] = fl[c] + bias[c];
            int gsel = 0; float gmax = gl[0];
#pragma unroll
            for (int c = 1; c < 4; ++c) if (gl[c] > gmax) { gmax = gl[c]; gsel = c; }
            float gden = 0.f;
#pragma unroll
            for (int c = 0; c < 4; ++c) gden += __expf(gl[c] - gmax);
            const float pgroup = 1.0f / gden;
            float el[8];
#pragma unroll
            for (int c = 0; c < 8; ++c) el[c] = fl[4 + gsel * EPG + c] + bias[NGRP + gsel * EPG + c];
            int i0 = 0; float l0 = el[0];
#pragma unroll
            for (int c = 1; c < 8; ++c) if (el[c] > l0) { l0 = el[c]; i0 = c; }
            int i1 = -1; float l1 = -INFINITY;
#pragma unroll
            for (int c = 0; c < 8; ++c) if (c != i0 && el[c] > l1) { l1 = el[c]; i1 = c; }
            const float e10 = __expf(l1 - l0);
            const float w0 = pgroup / (1.0f + e10), w1 = pgroup * e10 / (1.0f + e10);
            const int e0 = gsel * EPG + i0, e1 = gsel * EPG + i1;
            const unsigned p0 = __hip_atomic_fetch_add(cnt + 64 * e0, 1u, RLX_AGENT), p1 = __hip_atomic_fetch_add(cnt + 64 * e1, 1u, RLX_AGENT);
            rowidx[e0 * MREAL + p0] = m * 2; rowidx[e1 * MREAL + p1] = m * 2 + 1;
            tokw[m * 2] = w0; tokw[m * 2 + 1] = w1;
            slot[m * 2] = (e0 << 16) | (int)p0; slot[m * 2 + 1] = (e1 << 16) | (int)p1;
        }
    }
}

__device__ __forceinline__ void p8_ln2(Frame& F, const Args& A, volatile LAS int* tp) {
    const int gw = F.vcu * NWAVES + F.wave, NGW = F.G * NWAVES;
    const bf16* XN = (const bf16*)(F.ws + WS_XN); const bf16* Y = (const bf16*)(F.ws + WS_Y);
    const float* g2 = arg_in(19); const float* b2 = arg_in(20);
    const int* slot = (const int*)(F.ws + WS_SLOT); const float* tokw = (const float*)(F.ws + WS_TOKW);
    for (int base = gw; base < MREAL; base += 4 * NGW) {
    int sl[4][2]; float wl[4][2];
#pragma unroll
    for (int k = 0; k < 4; ++k) { const int m = base + k * NGW; const int mm = m < MREAL ? m : 0; sl[k][0] = slot[2 * mm]; sl[k][1] = slot[2 * mm + 1]; wl[k][0] = tokw[2 * mm]; wl[k][1] = tokw[2 * mm + 1]; }
#pragma unroll
    for (int k = 0; k < 4; ++k) {
        const int m = base + k * NGW; if (m >= MREAL) break;
        int lane = lane_id();
        const int s0 = sl[k][0], s1 = sl[k][1]; const float w0 = wl[k][0], w1 = wl[k][1];
        const int r0 = __builtin_amdgcn_readfirstlane(tp[s0 >> 16]) * 256 + (s0 & 0xffff), r1 = __builtin_amdgcn_readfirstlane(tp[s1 >> 16]) * 256 + (s1 & 0xffff);
        const v2u* hp = (const v2u*)(XN + (size_t)m * DM) + lane; const v2u* y0 = (const v2u*)(Y + (size_t)r0 * DM) + lane; const v2u* y1 = (const v2u*)(Y + (size_t)r1 * DM) + lane;
        f32x4 v[8]; float s = 0.f;
#pragma unroll
        for (int j = 0; j < 8; ++j) { const v2u h = __builtin_nontemporal_load(hp + 64 * j), a = __builtin_nontemporal_load(y0 + 64 * j), c = __builtin_nontemporal_load(y1 + 64 * j);
            v[j] = (f32x4){ALPHA * bf_lo(h.x) + (w0 * bf_lo(a.x) + w1 * bf_lo(c.x)), ALPHA * bf_hi(h.x) + (w0 * bf_hi(a.x) + w1 * bf_hi(c.x)), ALPHA * bf_lo(h.y) + (w0 * bf_lo(a.y) + w1 * bf_lo(c.y)), ALPHA * bf_hi(h.y) + (w0 * bf_hi(a.y) + w1 * bf_hi(c.y))};
            s += (v[j][0] + v[j][1]) + (v[j][2] + v[j][3]); }
        const float mean = wave_sum(s) * (1.f / DM); float s2 = 0.f;
#pragma unroll
        for (int j = 0; j < 8; ++j) { v[j] = v[j] - mean; s2 += (v[j][0] * v[j][0] + v[j][1] * v[j][1]) + (v[j][2] * v[j][2] + v[j][3] * v[j][3]); }
        const float rstd = 1.f / sqrtf(wave_sum(s2) * (1.f / DM) + LN_EPS);
        f32x4* op = (f32x4*)(F.out + (size_t)m * DM) + lane;
#pragma unroll
        for (int j = 0; j < 8; ++j) { const f32x4 gg = ((const f32x4*)g2)[lane + 64 * j], bb = ((const f32x4*)b2)[lane + 64 * j]; __builtin_nontemporal_store(v[j] * rstd * gg + bb, op + 64 * j); }
    }
    }
}

__global__ void __launch_bounds__(NWAVES * 64, 2) mk_fwd(Args args) {
    extern __shared__ __attribute__((aligned(16))) unsigned char lds[];
    Frame F;
    F.lds = (LAS unsigned char*)lds;
    F.MISC = (volatile LAS unsigned*)(F.lds + MISC_OFF);
    F.wave = __builtin_amdgcn_readfirstlane((int)(threadIdx.x >> 6));
    F.G = gridDim.x; { const int bx = blockIdx.x; F.vcu = (F.G % 8 == 0) ? (bx % 8) * (F.G / 8) + bx / 8 : bx; }
    F.ws = args.ws; F.out = args.out;
    F.ctl = (gu32*)(F.ws + WS_CTL);
    for (int u = threadIdx.x; u < (LDS_BYTES - LDSCTL_OFF) / 4; u += NWAVES * 64) ((LAS unsigned*)(F.lds + LDSCTL_OFF))[u] = 0u;
    __syncthreads();
    XcdBarrier bar; bar.bar = (unsigned*)(F.ctl + CW_BAR); bar.x = 0; bar.st = nullptr; bar.wave = F.wave;
    if (N_LAUNCHES == 1) { bar = xcd_barrier_post((unsigned*)(F.ctl + CW_BAR), F.MISC + 8); bar.wave = F.wave; }
#define GRID_BAR() do { if (N_LAUNCHES == 1) xcd_barrier(bar); } while (0)
    volatile LAS unsigned long long* stamps = (volatile LAS unsigned long long*)(F.lds + LDSCTL_OFF + 4096);
    int n_stamp = 0;
#define STAMP() do { if (MK_SPIN >= 0 && blockIdx.x == 0 && F.wave == 0 && lane_id() == 0) stamps[n_stamp] = __builtin_amdgcn_s_memrealtime(); ++n_stamp; } while (0)
    STAMP();
    const int lo = args.ph_lo, hi = args.ph_hi;
#define REP(k) for (int rep_ = 0; rep_ < 1 + ((MK_DUP >> (k)) & 1); ++rep_)
#ifndef MK_PH_MASK
#define MK_PH_MASK 0x1ff
#endif
#define IN(k) (((MK_PH_MASK >> (k)) & 1) && lo <= (k) && (k) < hi)
    bf16* P = (bf16*)(F.ws + WS_P); bf16* XN = (bf16*)(F.ws + WS_XN);

    if (IN(0)) REP(0) { p0_prologue(F, args); GRID_BAR(); }
    STAMP();

    if (IN(1)) REP(1) {
        const int NSPARE = (F.G == 256) ? 24 : 0;
        if ((int)blockIdx.x < F.G - NSPARE) {
            pg8::Gemm g{XN, (const bf16*)(F.ws + WS_WIN), DM, DM, -1};
            DenseOrder S; S.init(F.wave, MREAL / 256, LDP / 256, F.G - NSPARE, (int)blockIdx.x, (long)256 * DM * 2, (long)256 * DM * 2, (PC_GA - PC_K) / 256, PC_K / 256);
            EpiBf16 E{P, LDP, PC_CC / 256, PC_GA / 256, PC_CC, PC_GA / 256};
            pg8::gemm_phase<EpiBf16, DenseOrder, true>(F.lds + RING_OFF, g, S, E);
        }
        conv_queue((unsigned*)(F.ctl + CW_Q), 0, CT_B1, F.ws, F.lds + RING_OFF, F.MISC + 16, F.wave, lane_id());
        GRID_BAR();
    }
    STAMP();
    constexpr bool SEAM23 = MK_SEAM23 && N_LAUNCHES == 1 && MK_DUP == 0;
    if (IN(2)) { p2_attention_conv(F, args); if (!SEAM23) GRID_BAR(); }
    STAMP();
    constexpr bool SEAM34 = MK_SEAM34 && N_LAUNCHES == 1 && MK_DUP == 0;
    if (IN(3)) REP(3) {
        pg8::Gemm g{P, (const bf16*)(F.ws + WS_WB2), LDP, 2 * DM, DM / 64};
        EpiGate E{P, (bf16*)(F.ws + WS_MRG), SEAM34 ? (unsigned*)(F.ctl + CW_P3) : nullptr};
        if (SEAM23) {
            DenseOrderDep S; S.init(F.wave, MREAL / 256, DM / 256, F.G, (int)blockIdx.x, (long)256 * LDP * 2, (long)256 * 2 * DM * 2);
            S.rdy = (unsigned*)(F.ctl + CW_P2); S.need = 16u; S.tmo = (unsigned*)(F.ctl + CW_TMO);
            pg8::gemm_phase<EpiGate, DenseOrderDep, true>(F.lds + RING_OFF, g, S, E);
        } else {
            DenseOrder S; S.init(F.wave, MREAL / 256, DM / 256, F.G, (int)blockIdx.x, (long)256 * LDP * 2, (long)256 * 2 * DM * 2);
            pg8::gemm_phase<EpiGate, DenseOrder, true>(F.lds + RING_OFF, g, S, E);
        }
        if (!SEAM34) GRID_BAR();
    }
    STAMP();
    if (IN(4)) REP(4) {
        pg8::Gemm g{(const bf16*)(F.ws + WS_MRG), (const bf16*)(F.ws + WS_WOUT), DM, DM, -1};
        EpiPre E{XN, P + PC_GA, LDP, SEAM34 ? (unsigned*)(F.ctl + CW_P4) : nullptr};
        if (SEAM34) {
            DenseOrderDep S; S.init(F.wave, MREAL / 256, DM / 256, F.G, (int)blockIdx.x, (long)256 * DM * 2, (long)256 * DM * 2);
            S.rdy = (unsigned*)(F.ctl + CW_P3); S.need = 64u; S.tmo = (unsigned*)(F.ctl + CW_TMO);
            pg8::gemm_phase<EpiPre, DenseOrderDep, true>(F.lds + RING_OFF, g, S, E);
        } else {
            DenseOrder S; S.init(F.wave, MREAL / 256, DM / 256, F.G, (int)blockIdx.x, (long)256 * DM * 2, (long)256 * DM * 2);
            pg8::gemm_phase<EpiPre, DenseOrder, true>(F.lds + RING_OFF, g, S, E);
            GRID_BAR();
        }
    }
    STAMP();
    if (IN(5)) { p5_ln1_router(F, args); GRID_BAR(); }
    STAMP();
    volatile LAS int* tp = (volatile LAS int*)(F.MISC + 32);
    volatile LAS int* cn = (volatile LAS int*)(F.MISC + 72);
    if (IN(6) || IN(7) || IN(8)) {
        if (F.wave == 0) {
            const int l = lane_id(); const int c = l < NEXP ? (int)__hip_atomic_load(F.ctl + CW_CNT + 64 * (l & 31), RLX_AGENT) : 0;
            const int nt_e = (c + 255) >> 8; int inc = nt_e;
#pragma unroll
            for (int o = 1; o < 32; o <<= 1) { const int v = __shfl_up(inc, o); if ((l & 31) >= o) inc += v; }
            if (l < NEXP) { tp[l] = inc - nt_e; cn[l] = c; if (l == NEXP - 1) tp[32] = inc; }
        }
        __syncthreads();
    }
    constexpr bool MERGE = MK_MOE_MERGE && N_LAUNCHES == 1;
    if (IN(6)) REP(6) {
        pg8::Gemm g{XN, (const bf16*)(F.ws + WS_WGU), DM, DM, -1};
        MoeOrder<4, true> S{F.wave, tp, cn, F.G, (int)blockIdx.x, (long)1024 * DM * 2, (long)256 * DM * 2, 0, (const int*)(F.ws + WS_ROWIDX), (unsigned)(DM * 2)};
        EpiAct E{(bf16*)(F.ws + WS_ACT), (unsigned*)(F.ctl + CW_RDY)};
        pg8::gemm_phase<EpiAct, MoeOrder<4, true>, true>(F.lds + RING_OFF, g, S, E);
        if (MERGE) conv_queue<true>((unsigned*)(F.ctl + CW_Q + 64), CT_B1, CT_B, F.ws, F.lds + RING_OFF, F.MISC + 16, F.wave, lane_id(), (unsigned*)(F.ctl + CW_WD));
        else { conv_queue<false>((unsigned*)(F.ctl + CW_Q + 64), CT_B1, CT_B, F.ws, F.lds + RING_OFF, F.MISC + 16, F.wave, lane_id()); GRID_BAR(); }
    }
    STAMP();
    if (IN(7)) REP(7) {
        pg8::Gemm g{(const bf16*)(F.ws + WS_ACT), (const bf16*)(F.ws + WS_WD), DE, DE, -1};
        EpiDown E{(bf16*)(F.ws + WS_Y)};
        if (MERGE) {
            if (F.wave == 0) wait_count((unsigned*)(F.ctl + CW_WD), (unsigned)CT_DN, (unsigned*)(F.ctl + CW_TMO));
            MoeDownOrder S{F.wave, tp, cn, F.G, (int)blockIdx.x, (long)DM * DE * 2, (long)256 * DE * 2, (long)256 * DE * 2, (unsigned*)(F.ctl + CW_RDY), (unsigned*)(F.ctl + CW_WD), (unsigned*)(F.ctl + CW_TMO)};
            pg8::gemm_phase<EpiDown, MoeDownOrder, true>(F.lds + RING_OFF, g, S, E);
        } else {
            MoeOrder<8, false> S{F.wave, tp, cn, F.G, (int)blockIdx.x, (long)DM * DE * 2, (long)256 * DE * 2, (long)256 * DE * 2, (const int*)(F.ws + WS_ROWIDX), 0u};
            pg8::gemm_phase<EpiDown, MoeOrder<8, false>, true>(F.lds + RING_OFF, g, S, E);
        }
        GRID_BAR();
    }
    STAMP();
    if (IN(8)) REP(8) { p8_ln2(F, args, tp); }
    STAMP();
    if (MK_SPIN >= 0 && blockIdx.x == 0 && F.wave == 0 && lane_id() == 0) {
        const unsigned long long t_end = __builtin_amdgcn_s_memrealtime();
        const unsigned long long span = (MK_SPIN >= 100) ? (unsigned long long)MK_SPIN * 100ull : (stamps[(MK_SPIN < 9 ? MK_SPIN : 8) + 1] - stamps[MK_SPIN < 9 ? MK_SPIN : 8]);
        while (__builtin_amdgcn_s_memrealtime() - t_end < span) __builtin_amdgcn_s_sleep(8);
    }
#undef IN
#undef GRID_BAR
}

extern "C" void kernel_launch(void* const* d_in, const int* in_sizes, int n_in, void* d_out, int out_size, void* d_ws, size_t ws_size, hipStream_t stream) {
    static int grid = 0;
    if (grid == 0) {
        if (n_in != 21 || in_sizes[0] != MREAL * DM || out_size != MREAL * DM || ws_size < WS_END) { fprintf(stderr, "kernel_launch: unexpected shapes / workspace (n_in %d, ws %zu); nothing launched\n", n_in, ws_size); grid = -1; return; }
        int dev = 0, cus = 0, per_cu = 0;
        if (hipGetDevice(&dev) != hipSuccess || hipDeviceGetAttribute(&cus, hipDeviceAttributeMultiprocessorCount, dev) != hipSuccess) { grid = -1; return; }
        if (hipFuncSetAttribute((const void*)mk_fwd, hipFuncAttributeMaxDynamicSharedMemorySize, LDS_BYTES) != hipSuccess) { fprintf(stderr, "kernel_launch: hipFuncSetAttribute failed\n"); grid = -1; return; }
        if (hipOccupancyMaxActiveBlocksPerMultiprocessor(&per_cu, (const void*)mk_fwd, NWAVES * 64, LDS_BYTES) != hipSuccess || per_cu < 1) { fprintf(stderr, "kernel_launch: occupancy query reports %d\n", per_cu); }
        (void)hipGetLastError();
        grid = cus;
    }
    if (grid < 0) return;
    if (hipMemsetAsync((char*)d_ws + WS_CTL, 0, CTL_ZERO_BYTES, stream) != hipSuccess) return;
    Args a{};
    for (int i = 0; i < 21; ++i) a.in[i] = (const float*)d_in[i];
    a.out = (float*)d_out; a.ws = (unsigned char*)d_ws;
    for (int li = 0; li < N_LAUNCHES; ++li) {
        a.ph_lo = (N_LAUNCHES == 1) ? 0 : li; a.ph_hi = (N_LAUNCHES == 1) ? PER_PHASE : li + 1; a.li = li;
        hipLaunchKernelGGL(mk_fwd, dim3(grid), dim3(NWAVES * 64), LDS_BYTES, stream, a);
    }
}
```

```cpp
#include <hip/hip_runtime.h>
#include <cstdio>
#include <cstdint>

#ifndef MK_SPIN
#define MK_SPIN -1
#endif
#ifndef MK_DUP
#define MK_DUP 0
#endif
#ifndef MK_SEAM23
#define MK_SEAM23 1
#endif
#ifndef MK_SEAM34
#define MK_SEAM34 1
#endif
#ifndef MK_MOE_MERGE
#define MK_MOE_MERGE 1
#endif
#ifndef MK_N_LAUNCHES
#define MK_N_LAUNCHES 1
#endif

__device__ __forceinline__ int lane_id() { int l = (int)__builtin_amdgcn_mbcnt_hi(~0u, __builtin_amdgcn_mbcnt_lo(~0u, 0u)); asm volatile("" : "+v"(l)); return l; }
namespace pg8 {
#define PG8_LAS __attribute__((address_space(3)))
typedef unsigned short bf16_t;
typedef short bf16x8 __attribute__((ext_vector_type(8)));
typedef float f32x4 __attribute__((ext_vector_type(4)));
typedef float f32x2 __attribute__((ext_vector_type(2)));
typedef unsigned u32x4 __attribute__((ext_vector_type(4)));
typedef unsigned u32x2 __attribute__((ext_vector_type(2)));
constexpr int BM = 256, BK = 64, HALF = 128, HTB = HALF * BK * 2  , STAGE_BYTES = 8 * HTB, NXCD = 8, WGM = 8;

__host__ __device__ __forceinline__ int lds_byte(int r, int c) { const int st = (r >> 4) * 2 + (c >> 5), rr = r & 15, cc = c & 31, ob = rr * 64 + cc * 2; return st * 1024 + (ob ^ (((ob >> 9) & 1) << 5)); }
__host__ __device__ __forceinline__ void stage_rc(int b, int& R, int& C) { const int st = b / 1024, sb = b % 1024, swz = sb ^ (((sb >> 9) & 1) << 5); R = (st >> 1) * 16 + swz / 64; C = (st & 1) * 32 + (swz % 64) / 2; }
__host__ __device__ __forceinline__ int perm32(int rho) { const int n = rho >> 4, i = rho & 15; return 8 * (i >> 2) + 4 * n + (i & 3); }

struct Unit { int pm, pn; long a_byte, b_byte; int e, mt, cnt; };
struct Gemm { const bf16_t* A; const bf16_t* Bt; int lda; int K; int tmid; };

__device__ __forceinline__ unsigned cvt_pk_bf16(float lo, float hi) { unsigned r; asm volatile("v_cvt_pk_bf16_f32 %0, %1, %2" : "=v"(r) : "v"(lo), "v"(hi)); return r; }
__device__ __forceinline__ float bf_lo(unsigned u) { return __builtin_bit_cast(float, u << 16); }
__device__ __forceinline__ float bf_hi(unsigned u) { return __builtin_bit_cast(float, u & 0xffff0000u); }

template <class Epi, class Sched, bool ALIGN_EPI>
__device__ __forceinline__ void gemm_phase(PG8_LAS unsigned char* lds, const Gemm g, const Sched& S, const Epi& E) {
    constexpr bool GATHER = Sched::GATHER;
    const int lane = lane_id(), wid = S.wave, tid = wid * 64 + lane, wr = wid >> 2, wc = wid & 3, fr = lane & 15, fq = lane >> 4;
    const int K = g.K, nt = K / BK, lda = g.lda;
    unsigned voffA[2], voffB[2]; int rA[2]; unsigned cA2[2];
#pragma unroll
    for (int i = 0; i < 2; ++i) { int R, C; stage_rc(tid * 16 + i * 8192, R, C); const int Rb = Epi::PERM ? ((R & ~31) + perm32(R & 31)) : R;
        voffA[i] = (unsigned)(R * lda + C) * 2u; voffB[i] = (unsigned)(Rb * K + C) * 2u; rA[i] = R; cA2[i] = (unsigned)C * 2u; }
    const size_t kstep = (size_t)(BK * 2);
    const size_t hstepA = (size_t)HALF * lda * 2, hstepB = (size_t)HALF * K * 2;
    const unsigned ldsw = (unsigned)wid * 1024u;
    const int aoff = lds_byte(wr * 64 + fr, fq * 8), boff = lds_byte(wc * 32 + fr, fq * 8);
#define PG8_SA(b, h) (((b) * 2 + (h)) * HTB)
#define PG8_SB(b, h) ((4 + (b) * 2 + (h)) * HTB)
#define PG8_GLDS(gp, ldsoff) __builtin_amdgcn_global_load_lds((const unsigned*)(gp), (PG8_LAS unsigned*)(lds + (ldsoff)), 16, 0, 0)
#define PG8_STAGE_O(bufoff, gbase, o0, o1) do { PG8_GLDS((const char*)(gbase) + (o0), (bufoff) + ldsw); PG8_GLDS((const char*)(gbase) + (o1), (bufoff) + ldsw + 8192); } while (0)
#define PG8_STB(bufoff, gbase) PG8_STAGE_O(bufoff, gbase, voffB[0], voffB[1])
#define PG8_STA(bufoff, ap, h, V) do { if constexpr (GATHER) PG8_STAGE_O(bufoff, ap, V[h][0], V[h][1]); else PG8_STAGE_O(bufoff, (ap) + (h) * hstepA, voffA[0], voffA[1]); } while (0)
#define PG8_LDA(dst, b, h) do { _Pragma("unroll") for (int m = 0; m < 4; ++m) _Pragma("unroll") for (int k = 0; k < 2; ++k) dst[m][k] = *(const PG8_LAS bf16x8*)(lds + PG8_SA(b, h) + aoff + m * 2048 + k * 1024); } while (0)
#define PG8_LDB(dst, b, h) do { _Pragma("unroll") for (int n = 0; n < 2; ++n) _Pragma("unroll") for (int k = 0; k < 2; ++k) dst[n][k] = *(const PG8_LAS bf16x8*)(lds + PG8_SB(b, h) + boff + n * 2048 + k * 1024); } while (0)
#define PG8_MMA(ai, bj, At, Bt) do { __builtin_amdgcn_s_setprio(1); _Pragma("unroll") for (int m = 0; m < 4; ++m) _Pragma("unroll") for (int n = 0; n < 2; ++n) _Pragma("unroll") for (int k = 0; k < 2; ++k) \
        acc[ai][bj][m][n] = __builtin_amdgcn_mfma_f32_16x16x32_bf16(Bt[n][k], At[m][k], acc[ai][bj][m][n], 0, 0, 0); __builtin_amdgcn_s_setprio(0); } while (0)
#define PG8_WAIT_V(n) asm volatile("s_waitcnt vmcnt(" #n ")" ::: "memory")
#define PG8_WAIT_L(n) asm volatile("s_waitcnt lgkmcnt(" #n ")" ::: "memory")
#define PG8_BAR __builtin_amdgcn_s_barrier()
#define PG8_SCHED __builtin_amdgcn_sched_barrier(0)
    Unit cur, nxt; int ui = 0;
    if (!S.next(0, cur)) return;
    f32x4 acc[2][2][4][2];
#pragma unroll
    for (int a = 0; a < 2; ++a)
#pragma unroll
        for (int b = 0; b < 2; ++b)
#pragma unroll
            for (int m = 0; m < 4; ++m)
#pragma unroll
                for (int n = 0; n < 2; ++n) acc[a][b][m][n] = (f32x4){0.f, 0.f, 0.f, 0.f};
    bf16x8 At[4][2], B0[2][2], B1[2][2];
    unsigned va[2][2], nva[2][2];
    if constexpr (GATHER) {
#pragma unroll
        for (int h = 0; h < 2; ++h)
#pragma unroll
            for (int i = 0; i < 2; ++i) { va[h][i] = S.row_byte(cur, h * HALF + rA[i]) + cA2[i]; nva[h][i] = va[h][i]; }
    } else { va[0][0] = va[0][1] = va[1][0] = va[1][1] = 0u; nva[0][0] = nva[0][1] = nva[1][0] = nva[1][1] = 0u; }
    const char* cA = (const char*)g.A + cur.a_byte; const char* cB = (const char*)g.Bt + cur.b_byte;
    S.a_ready(cur);
    PG8_STB(PG8_SB(0, 0), cB); PG8_STB(PG8_SB(0, 1), cB + hstepB); PG8_STA(PG8_SA(0, 0), cA, 0, va); PG8_STA(PG8_SA(0, 1), cA, 1, va);
    if (wr == 1) PG8_BAR;
    PG8_WAIT_V(2); PG8_BAR;
    PG8_STB(PG8_SB(1, 0), cB + kstep); PG8_STA(PG8_SA(1, 0), cA + kstep, 0, va); PG8_STB(PG8_SB(1, 1), cB + hstepB + kstep);
    PG8_WAIT_V(6); PG8_BAR;
    for (;;) {
        const bool has_next = S.next(ui + 1, nxt);
        const char* nA = has_next ? (const char*)g.A + nxt.a_byte : cA; const char* nB = has_next ? (const char*)g.Bt + nxt.b_byte : cB;
        if constexpr (GATHER) {
            if (has_next) {
#pragma unroll
                for (int h = 0; h < 2; ++h)
#pragma unroll
                    for (int i = 0; i < 2; ++i) nva[h][i] = S.row_byte(nxt, h * HALF + rA[i]) + cA2[i];
            }
            asm volatile("" : "+v"(nva[0][0]), "+v"(nva[0][1]), "+v"(nva[1][0]), "+v"(nva[1][1]));
        }
        for (int t = 0; t < nt; t += 2) {
            const bool last = (t == nt - 2);
            if constexpr (Epi::MID) { if (t == g.tmid) E.mid(acc, cur, wr, wc, fr, fq); }
            if (last && has_next) S.a_ready(nxt);
            const char* a1 = cA + (size_t)(t + 1) * kstep;
            const char* a2 = last ? nA : cA + (size_t)(t + 2) * kstep; const char* b2 = last ? nB : cB + (size_t)(t + 2) * kstep;
            const char* a3 = a2 + kstep; const char* b3 = b2 + kstep;
            unsigned xa[2][2];
#pragma unroll
            for (int h = 0; h < 2; ++h)
#pragma unroll
                for (int i = 0; i < 2; ++i) xa[h][i] = last ? nva[h][i] : va[h][i];
            PG8_LDB(B0, 0, 0); PG8_LDB(B1, 0, 1); PG8_SCHED; PG8_LDA(At, 0, 0); PG8_STA(PG8_SA(1, 1), a1, 1, va);
            PG8_WAIT_V(8); PG8_WAIT_L(0); PG8_BAR; PG8_MMA(0, 0, At, B0); PG8_MMA(0, 1, At, B1); PG8_BAR; PG8_SCHED;
            PG8_LDA(At, 0, 1); PG8_STB(PG8_SB(0, 0), b2); PG8_STB(PG8_SB(0, 1), b2 + hstepB); PG8_STA(PG8_SA(0, 0), a2, 0, xa);
            PG8_WAIT_V(8); PG8_WAIT_L(0); PG8_BAR; PG8_MMA(1, 0, At, B0); PG8_MMA(1, 1, At, B1); PG8_BAR; PG8_SCHED;
            PG8_LDB(B0, 1, 0); PG8_LDB(B1, 1, 1); PG8_SCHED; PG8_LDA(At, 1, 0); PG8_STA(PG8_SA(0, 1), a2, 1, xa);
            PG8_WAIT_V(8); PG8_WAIT_L(0); PG8_BAR; PG8_MMA(0, 0, At, B0); PG8_MMA(0, 1, At, B1); PG8_BAR; PG8_SCHED;
            PG8_LDA(At, 1, 1); PG8_STB(PG8_SB(1, 0), b3); PG8_STB(PG8_SB(1, 1), b3 + hstepB); PG8_STA(PG8_SA(1, 0), a3, 0, xa);
            PG8_WAIT_V(8); PG8_WAIT_L(0); PG8_BAR; PG8_MMA(1, 0, At, B0); PG8_MMA(1, 1, At, B1); PG8_BAR; PG8_SCHED;
        }
        if constexpr (ALIGN_EPI) { if (wr == 0) PG8_BAR; }
        E(acc, cur, wr, wc, fr, fq);
        if (!has_next) break;
#pragma unroll
        for (int a = 0; a < 2; ++a)
#pragma unroll
            for (int b = 0; b < 2; ++b)
#pragma unroll
                for (int m = 0; m < 4; ++m)
#pragma unroll
                    for (int n = 0; n < 2; ++n) acc[a][b][m][n] = (f32x4){0.f, 0.f, 0.f, 0.f};
        cur = nxt; cA = nA; cB = nB; ++ui;
        if constexpr (GATHER) {
#pragma unroll
            for (int h = 0; h < 2; ++h)
#pragma unroll
                for (int i = 0; i < 2; ++i) va[h][i] = nva[h][i];
        }
        if constexpr (ALIGN_EPI) { if (wr == 1) PG8_BAR; }
    }
    PG8_WAIT_V(0);
    if constexpr (!ALIGN_EPI) { if (wr == 0) PG8_BAR; }
    PG8_BAR;
#undef PG8_SA
#undef PG8_SB
#undef PG8_GLDS
#undef PG8_STAGE_O
#undef PG8_STB
#undef PG8_STA
#undef PG8_LDA
#undef PG8_LDB
#undef PG8_MMA
#undef PG8_WAIT_V
#undef PG8_WAIT_L
#undef PG8_BAR
#undef PG8_SCHED
}
}

constexpr int NWAVES = 8;
constexpr int N_LAUNCHES = MK_N_LAUNCHES;
constexpr int PER_PHASE = 9;
constexpr int BATCH = 4, SEQ = 2048, DM = 2048, NMETA = 16;
constexpr int MREAL = BATCH * SEQ;
constexpr int MPAD = MREAL + 256;
constexpr int LDP = 12800;
constexpr int PC_Q = 0, PC_CB = 2048, PC_K = 4096, PC_V = 4352, PC_CC = 4608, PC_CH = 6656, PC_GA = 8704, PC_GC = 10752;
constexpr int NQH = 32, NKVH = 4, HD = 64, WIN = 128;
constexpr int NEXP = 32, NGRP = 4, EPG = 8, DE = 512;
constexpr float LN_EPS = 1e-5f;
constexpr float ALPHA = 1.189207115002721f;
constexpr int MOE_ROWS_MAX = 2 * MREAL + NEXP * 256;

constexpr int CT_IN = 32 * 50, CT_SQ = 32 * 8, CT_GU = 32 * 64, CT_DN = 32 * 64;
constexpr size_t MiB = 1u << 20;
constexpr size_t WS_CTL = 0, CTL_ZERO_BYTES = 131072;
constexpr size_t WS_ROWIDX = 1 * MiB;
constexpr size_t WS_TOKW = 2 * MiB;
constexpr size_t WS_SLOT = 2 * MiB + 128 * 1024;
constexpr size_t WS_REWG = 3 * MiB;
constexpr size_t WS_WIN = 4 * MiB;
constexpr size_t WS_WB2 = 54 * MiB;
constexpr size_t WS_WOUT = 70 * MiB;
constexpr size_t WS_WGU = 78 * MiB;
constexpr size_t WS_WD = 206 * MiB;
constexpr size_t WS_XN = 270 * MiB;
constexpr size_t WS_P = 303 * MiB;
constexpr size_t WS_ACT = WS_P;
constexpr size_t WS_Y = WS_P + 24 * MiB;
constexpr size_t WS_MRG = 512 * MiB;
constexpr size_t WS_END = 544 * MiB;
static_assert(WS_P + (size_t)MPAD * LDP * 2 <= WS_MRG && WS_Y + (size_t)MOE_ROWS_MAX * DM * 2 <= WS_MRG && (size_t)MOE_ROWS_MAX * DE * 2 <= 24 * MiB, "ws map");
constexpr int CW_TMO = 0, CW_CODE = 1;
constexpr int CW_CNT = 256;
constexpr int CW_Q = 64;
constexpr int CW_BAR = 4096;
constexpr int CW_P2 = 16384 + 4096, CW_P3 = 16384, CW_P4 = 16384 + 2048;
constexpr int CW_WD = 192;
constexpr int CW_RDY = 8192;
static_assert((CW_RDY + 64 * 96) * 4 <= 65536 && (CW_P2 + 2048) * 4 <= 131072, "control words inside the memset");

constexpr int RING_OFF = 0, RING_BYTES = 131072;
constexpr int LDSCTL_OFF = RING_BYTES, MISC_OFF = LDSCTL_OFF + 320;
constexpr int LDS_BYTES = 147456;

#define GAS __attribute__((address_space(1)))
#define LAS __attribute__((address_space(3)))
typedef unsigned short bf16;
typedef unsigned v4u __attribute__((ext_vector_type(4)));
typedef unsigned v2u __attribute__((ext_vector_type(2)));
typedef float f32x4 __attribute__((ext_vector_type(4)));
typedef float f32x16 __attribute__((ext_vector_type(16)));
typedef short bf16x8 __attribute__((ext_vector_type(8)));
typedef short s16x4 __attribute__((ext_vector_type(4)));
typedef GAS unsigned gu32;
#define RLX_AGENT __ATOMIC_RELAXED, __HIP_MEMORY_SCOPE_AGENT
#define LDS_WAIT() asm volatile("s_waitcnt lgkmcnt(0)" ::: "memory")
#define VM_WAIT() asm volatile("s_waitcnt vmcnt(0)" ::: "memory")
__device__ __forceinline__ unsigned f2bf(float f) { unsigned u = __builtin_bit_cast(unsigned, f); return (u + 0x7fffu + ((u >> 16) & 1u)) >> 16; }
__device__ __forceinline__ unsigned pk2(float lo, float hi) { return f2bf(lo) | (f2bf(hi) << 16); }
using pg8::bf_lo; using pg8::bf_hi; using pg8::cvt_pk_bf16;

#define XB_TMO      128
#define XB_XCNT(j)  (256  + 64 * (j))
#define XB_XSUB(j)  (1280 + 64 * (j))
#define XB_XGEN(j)  (2304 + 64 * (j))
#define XB_TOP      3328
#define XB_TOPGEN   3392
#define XCD_BAR_WORDS 3456
#define XB_SPIN_CAP (1u << 18)
__device__ __forceinline__ unsigned xb_ld(unsigned* p)              { return __hip_atomic_load(p, __ATOMIC_RELAXED, __HIP_MEMORY_SCOPE_AGENT); }
__device__ __forceinline__ unsigned xb_add(unsigned* p, unsigned v) { return __hip_atomic_fetch_add(p, v, __ATOMIC_RELAXED, __HIP_MEMORY_SCOPE_AGENT); }
__device__ __forceinline__ unsigned xb_xcc_id() { return (unsigned)__builtin_amdgcn_s_getreg((3 << 11) | 20) & 0xFu; }
#define XB_SPIN(cond, bar) do { unsigned _sp = 0; while (cond) { __builtin_amdgcn_s_sleep(1); \
    if ((++_sp & 255u) == 0u) { if (xb_ld(&(bar)[XB_TMO])) break; if (_sp > XB_SPIN_CAP) { atomicAdd(&(bar)[XB_TMO], 1u); break; } } } } while (0)
struct XcdBarrier { unsigned* bar; unsigned x; volatile LAS unsigned* st; int wave; };
__device__ __forceinline__ XcdBarrier xcd_barrier_post(unsigned* bar, volatile LAS unsigned* st) {
    XcdBarrier b; b.bar = bar; b.x = xb_xcc_id(); b.st = st; b.wave = 0;
    if (threadIdx.x == 0) (void)xb_add(&bar[XB_XCNT(b.x)], 1u);
    return b;
}
__device__ __forceinline__ void xcd_barrier_complete(unsigned* bar, unsigned x, unsigned& nloc, unsigned& nx) {
    const unsigned G = gridDim.x * gridDim.y * gridDim.z;
    unsigned sum, cnt, mine, sp = 0u;
    for (;;) {
        sum = 0u; cnt = 0u; mine = 0u;
#pragma unroll
        for (unsigned j = 0; j < 16; ++j) { const unsigned c = xb_ld(&bar[XB_XCNT(j)]); sum += c; cnt += (c > 0u) ? 1u : 0u; mine = (j == x) ? c : mine; }
        if (sum == G) break;
        __builtin_amdgcn_s_sleep(1);
        if ((++sp & 255u) == 0u) { if (xb_ld(&bar[XB_TMO])) break; if (sp > XB_SPIN_CAP) { atomicAdd(&bar[XB_TMO], 1u); break; } }
    }
    nloc = mine > 0u ? mine : 1u; nx = cnt > 0u ? cnt : 1u;
}
__device__ __forceinline__ void xcd_barrier(const XcdBarrier& b) {
    asm volatile("s_waitcnt vmcnt(0)" ::: "memory");
    __syncthreads();
    if (b.wave == 0 && lane_id() == 0) {
        unsigned* bar = b.bar;
        __builtin_amdgcn_s_waitcnt(0);
        unsigned nloc = b.st[0], nx = b.st[1];
        if (nloc == 0u) { xcd_barrier_complete(bar, b.x, nloc, nx); b.st[0] = nloc; b.st[1] = nx; }
        const unsigned old = xb_add(&bar[XB_XSUB(b.x)], 1u);
        const unsigned gen = old / nloc;
        if (old + 1u == (gen + 1u) * nloc) {
            __builtin_amdgcn_fence(__ATOMIC_RELEASE, "agent");
            asm volatile("s_waitcnt vmcnt(0)" ::: "memory");
            const unsigned og = xb_add(&bar[XB_TOP], 1u);
            const unsigned tg = og / nx;
            if (og + 1u == (tg + 1u) * nx) xb_add(&bar[XB_TOPGEN], 1u);
            else XB_SPIN(xb_ld(&bar[XB_TOPGEN]) == tg, bar);
            __builtin_amdgcn_fence(__ATOMIC_ACQUIRE, "agent");
            xb_add(&bar[XB_XGEN(b.x)], 1u);
            asm volatile("s_waitcnt vmcnt(0)" ::: "memory");
        } else {
            XB_SPIN(xb_ld(&bar[XB_XGEN(b.x)]) == gen, bar);
            __builtin_amdgcn_fence(__ATOMIC_ACQUIRE, "agent");
            asm volatile("s_waitcnt vmcnt(0)" ::: "memory");
        }
    }
    __syncthreads();
}

struct Frame {
    LAS unsigned char* lds;
    volatile LAS unsigned* MISC;
    gu32* ctl;
    int wave;
    int vcu, G;
    float* out;
    unsigned char* ws;
};
struct Args { const float* in[21]; float* out; unsigned char* ws; int ph_lo, ph_hi, li, pad; };
__device__ __forceinline__ const float* arg_in(int i) {
    const __attribute__((address_space(4))) char* ka = (const __attribute__((address_space(4))) char*)__builtin_amdgcn_kernarg_segment_ptr();
    unsigned off = (unsigned)i * 8u; asm volatile("" : "+s"(off));
    return *(const float* const __attribute__((address_space(4)))*)(ka + off);
}
__device__ __forceinline__ float wave_sum(float v) {
#pragma unroll
    for (int o = 1; o < 64; o <<= 1) v += __shfl_xor(v, o);
    return v;
}

struct DenseOrder {
    static constexpr bool GATHER = false;
    int nM, nN, nwg, G, c, extra, ex0, wave; long a_tile, b_tile;
    __device__ void init(int wave_, int nM_, int nN_, int G_, int c_, long a_tile_, long b_tile_, int extra_ = 0, int ex0_ = 0) { wave = wave_; nM = nM_; nN = nN_; nwg = nM * nN; G = G_; c = c_; a_tile = a_tile_; b_tile = b_tile_; extra = extra_; ex0 = ex0_; }
    __device__ bool next(int i, pg8::Unit& u) const {
        const long L = (long)i * G + c; if (L >= nwg + extra) return false;
        if (L >= nwg) { u.pm = nM; u.pn = ex0 + (int)(L - nwg); }
        else {
            int wgid = (int)L; { const int q = nwg / pg8::NXCD, r = nwg % pg8::NXCD, xcd = wgid % pg8::NXCD, off = wgid / pg8::NXCD; wgid = (xcd < r ? xcd * (q + 1) : r * (q + 1) + (xcd - r) * q) + off; }
            const int nig = pg8::WGM * nN, gid = wgid / nig, fm = gid * pg8::WGM, gsz = (nM - fm) < pg8::WGM ? (nM - fm) : pg8::WGM;
            u.pm = fm + ((wgid % nig) % gsz); u.pn = (wgid % nig) / gsz;
        }
        u.a_byte = (long)u.pm * a_tile; u.b_byte = (long)u.pn * b_tile; u.e = 0; u.mt = 0; u.cnt = 0; return true;
    }
    __device__ __forceinline__ unsigned row_byte(const pg8::Unit&, int) const { return 0u; }
    __device__ __forceinline__ void a_ready(const pg8::Unit&) const {}
};
__device__ __forceinline__ void wait_count(unsigned* word, unsigned need, unsigned* tmo) {
    unsigned sp = 0;
    while ((unsigned)__builtin_amdgcn_readfirstlane((int)__hip_atomic_load(word, RLX_AGENT)) < need) {
        __builtin_amdgcn_s_sleep(2);
        if (++sp > (1u << 22)) { if (lane_id() == 0) __hip_atomic_store(tmo, 1u, RLX_AGENT); break; }
    }
    __builtin_amdgcn_fence(__ATOMIC_ACQUIRE, "agent");
    asm volatile("s_waitcnt vmcnt(0)" ::: "memory");
}
struct DenseOrderDep : DenseOrder {
    unsigned* rdy; unsigned need; unsigned* tmo;
    __device__ __forceinline__ void a_ready(const pg8::Unit& u) const {
        if (wave == 0) wait_count(rdy + 64 * u.pm, need, tmo);
        asm volatile("" ::: "memory"); __builtin_amdgcn_s_barrier(); asm volatile("" ::: "memory");
    }
};
__device__ __forceinline__ void moe_decode(volatile LAS int* tp, int L, int NT, int& e, int& mt, int& n) {
    const int l_ = lane_id(); const int tv_ = tp[l_ & 31];
    e = (int)__builtin_popcountll(__ballot(l_ >= 1 && l_ < 32 && NT * tv_ <= L));
    const int base = __builtin_amdgcn_readfirstlane(tp[e]), nte = __builtin_amdgcn_readfirstlane(tp[e + 1]) - base, r = L - NT * base;
    n = __builtin_amdgcn_readfirstlane(r / nte); mt = r - n * nte;
}
template <int NT, bool GATH>
struct MoeOrder {
    static constexpr bool GATHER = GATH;
    int wave; volatile LAS int* tp; volatile LAS int* cn; int G, c; long b_exp, b_tile, a_tile; const int* rowidx; unsigned row_bytes;
    __device__ bool next(int i, pg8::Unit& u) const {
        const int total = __builtin_amdgcn_readfirstlane(tp[32]) * NT;
        const long L = (long)i * G + c; if (L >= total) return false;
        int e, mt, n; moe_decode(tp, (int)L, NT, e, mt, n);
        const int T = __builtin_amdgcn_readfirstlane(tp[e]) + mt;
        u.e = e; u.mt = mt; u.cnt = __builtin_amdgcn_readfirstlane(cn[e]); u.pm = T; u.pn = n;
        u.a_byte = GATH ? 0 : (long)T * a_tile; u.b_byte = (long)e * b_exp + (long)n * b_tile; return true;
    }
    __device__ __forceinline__ unsigned row_byte(const pg8::Unit& u, int r) const {
        const int pos = u.mt * 256 + r;
        int tk = 0; if (pos < u.cnt) tk = rowidx[u.e * MREAL + pos];
        return (unsigned)(tk >> 1) * row_bytes;
    }
    __device__ __forceinline__ void a_ready(const pg8::Unit&) const {}
};
struct MoeDownOrder {
    static constexpr bool GATHER = false;
    int wave; volatile LAS int* tp; volatile LAS int* cn; int G, c; long b_exp, b_tile, a_tile; unsigned* rdy; unsigned* wd; unsigned* tmo;
    __device__ bool next(int i, pg8::Unit& u) const {
        const int T = __builtin_amdgcn_readfirstlane(tp[32]), nb2 = 4 * T > G ? 4 * T - G : 0;
        const int lq = lane_id(); const int tq = tp[lq <= 32 ? lq : 32];
        const int T1 = __builtin_amdgcn_readfirstlane(tp[(int)__builtin_popcountll(__ballot(lq <= 32 && 4 * tq <= G)) - 1]);
        int j;
        if (c >= nb2) { j = (c - nb2) + i * (G - nb2); if (j >= 8 * T1) return false; }
        else { j = c + i * nb2; if (j >= 8 * (T - T1)) return false; j += 8 * T1; }
        int e, mt, n; moe_decode(tp, j, 8, e, mt, n);
        const int Tt = __builtin_amdgcn_readfirstlane(tp[e]) + mt;
        u.e = e; u.mt = mt; u.cnt = __builtin_amdgcn_readfirstlane(cn[e]); u.pm = Tt; u.pn = n;
        u.a_byte = (long)Tt * a_tile; u.b_byte = (long)e * b_exp + (long)n * b_tile; return true;
    }
    __device__ __forceinline__ unsigned row_byte(const pg8::Unit&, int) const { return 0u; }
    __device__ __forceinline__ void a_ready(const pg8::Unit& u) const {
        if (wave == 0) {
            unsigned sp = 0;
            while ((unsigned)__builtin_amdgcn_readfirstlane((int)__hip_atomic_load(rdy + 64 * u.pm, RLX_AGENT)) < 32u) {
                __builtin_amdgcn_s_sleep(2);
                if (++sp > (1u << 22)) { if (lane_id() == 0) __hip_atomic_store(tmo, 1u, RLX_AGENT); break; }
            }
            __builtin_amdgcn_fence(__ATOMIC_ACQUIRE, "agent");
            asm volatile("s_waitcnt vmcnt(0)" ::: "memory");
        }
        asm volatile("" ::: "memory"); __builtin_amdgcn_s_barrier(); asm volatile("" ::: "memory");
    }
};

__device__ __forceinline__ void st16_wt(void* p, v4u v) { asm volatile("global_store_dwordx4 %0, %1, off sc1\n\ts_nop 1" :: "v"(p), "v"(v) : "memory"); }
using pg8::Unit; using pg8::HALF; using pg8::BM;
struct EpiBf16 {
    static constexpr bool PERM = true, MID = false;
    bf16* O; int ldc; int pp_lo, pp_hi, pp_col, sg_lo;
    __device__ __forceinline__ void mid(f32x4 (&)[2][2][4][2], const Unit&, int, int, int, int) const {}
    __device__ __forceinline__ void operator()(const f32x4 (&acc)[2][2][4][2], const Unit& u, int wr, int wc, int fr, int fq) const {
        const int row0 = u.pm * BM + wr * 64 + fr, col0 = u.pn * BM + wc * 32 + 8 * fq;
        if (pp_lo <= u.pn && u.pn < pp_hi) {
            const int pc = pp_col + (u.pn - pp_lo) * HALF + wc * 32 + 8 * fq;
#pragma unroll
            for (int ai = 0; ai < 2; ++ai)
#pragma unroll
                for (int m = 0; m < 4; ++m) { bf16* rowp = O + (size_t)(row0 + ai * HALF + m * 16) * ldc + pc;
                    const f32x4 v0 = acc[ai][0][m][0] * acc[ai][1][m][0], v1 = acc[ai][0][m][1] * acc[ai][1][m][1];
                    v4u w; w.x = cvt_pk_bf16(v0[0], v0[1]); w.y = cvt_pk_bf16(v0[2], v0[3]); w.z = cvt_pk_bf16(v1[0], v1[1]); w.w = cvt_pk_bf16(v1[2], v1[3]);
                    *(v4u*)rowp = w; }
            return;
        }
        const bool sg = u.pn >= sg_lo;
#pragma unroll
        for (int ai = 0; ai < 2; ++ai)
#pragma unroll
            for (int m = 0; m < 4; ++m) { bf16* rowp = O + (size_t)(row0 + ai * HALF + m * 16) * ldc + col0;
#pragma unroll
                for (int bj = 0; bj < 2; ++bj) { f32x4 v0 = acc[ai][bj][m][0], v1 = acc[ai][bj][m][1];
                    if (sg) {
#pragma unroll
                        for (int j = 0; j < 4; ++j) { v0[j] = __builtin_amdgcn_rcpf(1.0f + __expf(-v0[j])); v1[j] = __builtin_amdgcn_rcpf(1.0f + __expf(-v1[j])); } }
                    v4u w; w.x = cvt_pk_bf16(v0[0], v0[1]); w.y = cvt_pk_bf16(v0[2], v0[3]); w.z = cvt_pk_bf16(v1[0], v1[1]); w.w = cvt_pk_bf16(v1[2], v1[3]);
                    *(v4u*)(rowp + bj * HALF) = w; } }
    }
};
__device__ __forceinline__ float sigm(float x) { return __builtin_amdgcn_rcpf(1.0f + __expf(-x)); }
struct EpiGate {
    static constexpr bool PERM = true, MID = true;
    bf16* P; bf16* MRG; unsigned* rdy;
    __device__ __forceinline__ void mid(f32x4 (&acc)[2][2][4][2], const Unit& u, int wr, int wc, int fr, int fq) const {
        int row0 = u.pm * BM + wr * 64 + fr, col0 = u.pn * BM + wc * 32 + 8 * fq;
        asm volatile("" : "+v"(row0), "+v"(col0));
#pragma unroll
        for (int ai = 0; ai < 2; ++ai)
#pragma unroll
            for (int m = 0; m < 4; ++m) { const bf16* rowp = P + (size_t)(row0 + ai * HALF + m * 16) * LDP + col0;
#pragma unroll
                for (int bj = 0; bj < 2; ++bj) { const v4u a = *(const v4u*)(rowp + PC_GA + bj * HALF), c = *(const v4u*)(rowp + PC_GC + bj * HALF);
                    const unsigned aw[4] = {a.x, a.y, a.z, a.w}, cw[4] = {c.x, c.y, c.z, c.w};
#pragma unroll
                    for (int q = 0; q < 4; ++q) {
                        const float r0 = bf_lo(aw[q]) * __builtin_amdgcn_rcpf(bf_lo(cw[q]));
                        const float r1 = bf_hi(aw[q]) * __builtin_amdgcn_rcpf(bf_hi(cw[q]));
                        acc[ai][bj][m][q >> 1][(q & 1) * 2] *= r0; acc[ai][bj][m][q >> 1][(q & 1) * 2 + 1] *= r1; } }
                asm volatile("" ::: "memory"); }
    }
    __device__ __forceinline__ void operator()(const f32x4 (&acc)[2][2][4][2], const Unit& u, int wr, int wc, int fr, int fq) const {
        const int row0 = u.pm * BM + wr * 64 + fr, col0 = u.pn * BM + wc * 32 + 8 * fq;
#pragma unroll
        for (int ai = 0; ai < 2; ++ai)
#pragma unroll
            for (int m = 0; m < 4; ++m) { bf16* rowp = P + (size_t)(row0 + ai * HALF + m * 16) * LDP + col0;
#pragma unroll
                for (int bj = 0; bj < 2; ++bj) { const v4u c = *(const v4u*)(rowp + PC_GC + bj * HALF); const unsigned cw[4] = {c.x, c.y, c.z, c.w};
                    const f32x4 v0 = acc[ai][bj][m][0], v1 = acc[ai][bj][m][1];
                    v4u w;
                    w.x = cvt_pk_bf16(v0[0] * bf_lo(cw[0]), v0[1] * bf_hi(cw[0])); w.y = cvt_pk_bf16(v0[2] * bf_lo(cw[1]), v0[3] * bf_hi(cw[1]));
                    w.z = cvt_pk_bf16(v1[0] * bf_lo(cw[2]), v1[1] * bf_hi(cw[2])); w.w = cvt_pk_bf16(v1[2] * bf_lo(cw[3]), v1[3] * bf_hi(cw[3]));
                    bf16* mp = MRG + (size_t)(row0 + ai * HALF + m * 16) * DM + col0 + bj * HALF;
                    if (rdy) st16_wt(mp, w); else *(v4u*)mp = w; }
                asm volatile("" ::: "memory"); }
        if (rdy) { asm volatile("s_waitcnt vmcnt(0)" ::: "memory"); if (fr == 0 && fq == 0) __hip_atomic_fetch_add(rdy + 64 * u.pm, 1u, RLX_AGENT); }
    }
};
struct EpiPre {
    static constexpr bool PERM = true, MID = false;
    const bf16* XN; bf16* pre; int ldo; unsigned* rdy;
    __device__ __forceinline__ void mid(f32x4 (&)[2][2][4][2], const Unit&, int, int, int, int) const {}
    __device__ __forceinline__ void operator()(const f32x4 (&acc)[2][2][4][2], const Unit& u, int wr, int wc, int fr, int fq) const {
        const int row0 = u.pm * BM + wr * 64 + fr, col0 = u.pn * BM + wc * 32 + 8 * fq;
#pragma unroll
        for (int ai = 0; ai < 2; ++ai)
#pragma unroll
            for (int m = 0; m < 4; ++m) { const int r = row0 + ai * HALF + m * 16; const bf16* xr = XN + (size_t)r * DM + col0; bf16* orow = pre + (size_t)r * ldo + col0;
#pragma unroll
                for (int bj = 0; bj < 2; ++bj) { const v4u h = *(const v4u*)(xr + bj * HALF); const f32x4 a0 = acc[ai][bj][m][0], a1 = acc[ai][bj][m][1];
                    v4u o; o.x = cvt_pk_bf16(ALPHA * bf_lo(h.x) + a0[0], ALPHA * bf_hi(h.x) + a0[1]); o.y = cvt_pk_bf16(ALPHA * bf_lo(h.y) + a0[2], ALPHA * bf_hi(h.y) + a0[3]);
                    o.z = cvt_pk_bf16(ALPHA * bf_lo(h.z) + a1[0], ALPHA * bf_hi(h.z) + a1[1]); o.w = cvt_pk_bf16(ALPHA * bf_lo(h.w) + a1[2], ALPHA * bf_hi(h.w) + a1[3]);
                    if (rdy) st16_wt(orow + bj * HALF, o); else *(v4u*)(orow + bj * HALF) = o; } }
        if (rdy) { asm volatile("s_waitcnt vmcnt(0)" ::: "memory"); if (fr == 0 && fq == 0) __hip_atomic_fetch_add(rdy + 64 * u.pm, 1u, RLX_AGENT); }
    }
};
struct EpiAct {
    static constexpr bool PERM = true, MID = false;
    bf16* act; unsigned* rdy;
    __device__ __forceinline__ void mid(f32x4 (&)[2][2][4][2], const Unit&, int, int, int, int) const {}
    __device__ __forceinline__ void operator()(const f32x4 (&acc)[2][2][4][2], const Unit& u, int wr, int wc, int fr, int fq) const {
        const int row0 = u.pm * BM + wr * 64 + fr, col0 = u.pn * HALF + wc * 32 + 8 * fq;
#pragma unroll
        for (int ai = 0; ai < 2; ++ai)
#pragma unroll
            for (int m = 0; m < 4; ++m) { bf16* rowp = act + (size_t)(row0 + ai * HALF + m * 16) * DE + col0;
                float o[8];
#pragma unroll
                for (int n = 0; n < 2; ++n)
#pragma unroll
                    for (int j = 0; j < 4; ++j) { const float gt = acc[ai][0][m][n][j], up = acc[ai][1][m][n][j]; o[n * 4 + j] = gt * sigm(gt) * up; }
                v4u w; w.x = cvt_pk_bf16(o[0], o[1]); w.y = cvt_pk_bf16(o[2], o[3]); w.z = cvt_pk_bf16(o[4], o[5]); w.w = cvt_pk_bf16(o[6], o[7]);
                if (MK_MOE_MERGE && N_LAUNCHES == 1) st16_wt(rowp, w); else *(v4u*)rowp = w; }
        if (MK_MOE_MERGE && N_LAUNCHES == 1) {
            asm volatile("s_waitcnt vmcnt(0)" ::: "memory");
            if (fr == 0 && fq == 0) __hip_atomic_fetch_add(rdy + 64 * u.pm, 1u, RLX_AGENT);
        }
    }
};
struct EpiDown {
    static constexpr bool PERM = true, MID = false;
    bf16* Y;
    __device__ __forceinline__ void mid(f32x4 (&)[2][2][4][2], const Unit&, int, int, int, int) const {}
    __device__ __forceinline__ void operator()(const f32x4 (&acc)[2][2][4][2], const Unit& u, int wr, int wc, int fr, int fq) const {
        const int row0 = u.pm * BM + wr * 64 + fr, col0 = u.pn * BM + wc * 32 + 8 * fq;
#pragma unroll
        for (int ai = 0; ai < 2; ++ai)
#pragma unroll
            for (int m = 0; m < 4; ++m) { bf16* rowp = Y + (size_t)(row0 + ai * HALF + m * 16) * DM + col0;
#pragma unroll
                for (int bj = 0; bj < 2; ++bj) { const f32x4 v0 = acc[ai][bj][m][0], v1 = acc[ai][bj][m][1];
                    v4u o; o.x = cvt_pk_bf16(v0[0], v0[1]); o.y = cvt_pk_bf16(v0[2], v0[3]); o.z = cvt_pk_bf16(v1[0], v1[1]); o.w = cvt_pk_bf16(v1[2], v1[3]);
                    *(v4u*)(rowp + bj * HALF) = o; } }
    }
};

struct ConvTile { const float* src; bf16* dst0; bf16* dst1; int ld_src, ld_dst; };
constexpr int CT_A = CT_IN;
constexpr int CT_B = 3 * CT_SQ + 2 * CT_GU + CT_DN;
constexpr int CT_PITCH = 144, CT_BUF = 256 * CT_PITCH;
__device__ __forceinline__ ConvTile conv_tile_a(int r, unsigned char* ws) {
    const int nt = r >> 5, kg = r & 31, ns = nt * 256, k0 = 64 * kg;
    int nn = ns; if (ns >= 2048 && ns < 2560) nn = ns + 2048; else if (ns >= 2560 && ns < 4608) nn = ns - 512;
    bf16* d = (bf16*)(ws + WS_WIN) + (size_t)nn * DM + k0; bf16* d1 = d + (size_t)128 * DM;
    if (ns >= PC_CC && ns < PC_GA) {
        const int ch = ns >= PC_CH ? 1 : 0, sidx = (ns - (ch ? PC_CH : PC_CC)) >> 8;
        d = (bf16*)(ws + WS_WIN) + (size_t)(256 * (18 + 2 * sidx) + 128 * ch) * DM + k0; d1 = d + (size_t)256 * DM; }
    return ConvTile{arg_in(4) + (size_t)k0 * LDP + ns, d, d1, LDP, DM};
}
__device__ __forceinline__ ConvTile conv_tile_b(int r, unsigned char* ws) {
    bf16* Wb2_t = (bf16*)(ws + WS_WB2); bf16* Wout_t = (bf16*)(ws + WS_WOUT); bf16* Wgu_t = (bf16*)(ws + WS_WGU); bf16* Wd_t = (bf16*)(ws + WS_WD);
    if (r < 2 * CT_SQ) { const int cv = r >= CT_SQ ? 1 : 0; r -= cv * CT_SQ; const int nt = r >> 5, k0 = 64 * (r & 31), n = nt * 256;
        bf16* d = Wb2_t + (size_t)n * 4096 + cv * 2048 + k0; return ConvTile{arg_in(7 + cv) + (size_t)k0 * DM + n, d, d + (size_t)128 * 4096, DM, 4096}; }
    r -= 2 * CT_SQ;
    if (r < CT_SQ) { const int nt = r >> 5, k0 = 64 * (r & 31), n = nt * 256; bf16* d = Wout_t + (size_t)n * DM + k0; return ConvTile{arg_in(9) + (size_t)k0 * DM + n, d, d + (size_t)128 * DM, DM, DM}; }
    r -= CT_SQ;
    if (r < 2 * CT_GU) { const int up = r >= CT_GU ? 1 : 0; r -= up * CT_GU; const int e = r >> 6, q = r & 63, nt = q >> 5, k0 = 64 * (q & 31), n = nt * 256;
        bf16* d = Wgu_t + ((size_t)e * 1024 + (size_t)(n >> 7) * 256 + up * 128) * DM + k0;
        return ConvTile{arg_in(16 + up) + (size_t)e * DM * DE + (size_t)k0 * DE + n, d, d + (size_t)256 * DM, DE, DM}; }
    r -= 2 * CT_GU;
    { const int e = r >> 6, q = r & 63, nt = q >> 3, k0 = 64 * (q & 7), n = nt * 256;
      bf16* d = Wd_t + ((size_t)e * DM + n) * DE + k0; return ConvTile{arg_in(18) + (size_t)e * DE * DM + (size_t)k0 * DM + n, d, d + (size_t)128 * DE, DM, DE}; }
}
struct ConvRegs { f32x4 v[8]; };
__device__ __forceinline__ void conv_load(ConvRegs& R, const ConvTile& t, int w, int lane) {
    const float* p = t.src + (size_t)(8 * w) * t.ld_src + 4 * lane;
#pragma unroll
    for (int i = 0; i < 8; ++i) R.v[i] = __builtin_nontemporal_load((const f32x4*)(p + (size_t)i * t.ld_src));
}
__device__ __forceinline__ void conv_lds_write(const ConvRegs& R, LAS unsigned char* buf, int w, int lane) {
#pragma unroll
    for (int j = 0; j < 4; ++j) { v4u o; o.x = cvt_pk_bf16(R.v[0][j], R.v[1][j]); o.y = cvt_pk_bf16(R.v[2][j], R.v[3][j]); o.z = cvt_pk_bf16(R.v[4][j], R.v[5][j]); o.w = cvt_pk_bf16(R.v[6][j], R.v[7][j]);
        *(LAS v4u*)(buf + (4 * lane + j) * CT_PITCH + 16 * w) = o; }
}
template <bool WT>
__device__ __forceinline__ void conv_store(const ConvTile& t, LAS const unsigned char* buf, int w, int lane) {
    const int c = lane & 7, nr = 8 * w + (lane >> 3);
#pragma unroll
    for (int p = 0; p < 4; ++p) { const int n = nr + 64 * p; const v4u o = *(LAS const v4u*)(buf + n * CT_PITCH + 16 * c);
        bf16* d = (p < 2 ? t.dst0 + (size_t)n * t.ld_dst : t.dst1 + (size_t)(n - 128) * t.ld_dst) + 8 * c;
        if (WT) st16_wt(d, o); else *(GAS v4u*)d = o; }
}
template <int LIST, bool WT = false>
__device__ __forceinline__ void conv_run(int first, int last, int stride, unsigned char* ws, LAS unsigned char* lds, int w, int lane, int& par) {
    if (first >= last) return;
    ConvTile t0 = LIST ? conv_tile_b(first, ws) : conv_tile_a(first, ws), t1 = t0;
    ConvRegs r0, r1;
    conv_load(r0, t0, w, lane);
    r1 = r0;
    for (int it = first; it < last; it += stride) {
        const int nx = it + stride;
        if (nx < last) { t1 = LIST ? conv_tile_b(nx, ws) : conv_tile_a(nx, ws); conv_load(r1, t1, w, lane); }
        LAS unsigned char* buf = lds + par * CT_BUF; par ^= 1;
        conv_lds_write(r0, buf, w, lane);
        __syncthreads();
        conv_store<WT>(t0, buf, w, lane);
        r0 = r1; t0 = t1;
    }
}
constexpr int CT_CHUNK = 4;
constexpr int CT_B1 = 3 * CT_SQ + 2 * CT_GU;
template <bool WT = false>
__device__ __forceinline__ void conv_queue(unsigned* qhead, int lo, int hi, unsigned char* ws, LAS unsigned char* lds, volatile LAS unsigned* slot, int w, int lane, unsigned* done = nullptr) {
    int par = 0;
    for (;;) {
        __syncthreads();
        if (w == 0 && lane == 0) slot[0] = __hip_atomic_fetch_add(qhead, (unsigned)CT_CHUNK, RLX_AGENT);
        __syncthreads();
        const int base = lo + __builtin_amdgcn_readfirstlane((int)slot[0]);
        if (base >= hi) break;
        const int end = base + CT_CHUNK < hi ? base + CT_CHUNK : hi;
        conv_run<1, WT>(base, end, 1, ws, lds, w, lane, par);
        if (WT) {
            asm volatile("s_waitcnt vmcnt(0)" ::: "memory");
            __syncthreads();
            if (w == 0 && lane == 0) __hip_atomic_fetch_add(done, (unsigned)(end - base), RLX_AGENT);
        }
    }
}
__device__ __forceinline__ void ln_regs_to_bf16(f32x4 (&v)[8], const float* g, const float* b, bf16* orow, int lane) {
    asm volatile("" : "+v"(lane));
    float s = 0.f;
#pragma unroll
    for (int j = 0; j < 8; ++j) s += (v[j][0] + v[j][1]) + (v[j][2] + v[j][3]);
    const float mean = wave_sum(s) * (1.f / DM); float s2 = 0.f;
#pragma unroll
    for (int j = 0; j < 8; ++j) { v[j] = v[j] - mean; s2 += (v[j][0] * v[j][0] + v[j][1] * v[j][1]) + (v[j][2] * v[j][2] + v[j][3] * v[j][3]); }
    const float rstd = 1.f / sqrtf(wave_sum(s2) * (1.f / DM) + LN_EPS);
    v2u* o8 = (v2u*)orow + lane;
#pragma unroll
    for (int j = 0; j < 8; ++j) { const f32x4 gg = ((const f32x4*)g)[lane + 64 * j], bb = ((const f32x4*)b)[lane + 64 * j]; const f32x4 y = v[j] * rstd * gg + bb;
        v2u w; w.x = pk2(y[0], y[1]); w.y = pk2(y[2], y[3]); o8[64 * j] = w; }
}
__device__ __forceinline__ void ln_row_to_bf16(const float* xrow, const float* g, const float* b, bf16* orow, int lane) {
    asm volatile("" : "+v"(lane));
    const f32x4* xr = (const f32x4*)xrow + lane;
    f32x4 v[8]; float s = 0.f;
#pragma unroll
    for (int j = 0; j < 8; ++j) { v[j] = xr[64 * j]; s += (v[j][0] + v[j][1]) + (v[j][2] + v[j][3]); }
    const float mean = wave_sum(s) * (1.f / DM); float s2 = 0.f;
#pragma unroll
    for (int j = 0; j < 8; ++j) { v[j] = v[j] - mean; s2 += (v[j][0] * v[j][0] + v[j][1] * v[j][1]) + (v[j][2] * v[j][2] + v[j][3] * v[j][3]); }
    const float rstd = 1.f / sqrtf(wave_sum(s2) * (1.f / DM) + LN_EPS);
    v2u* o8 = (v2u*)orow + lane;
#pragma unroll
    for (int j = 0; j < 8; ++j) { const f32x4 gg = ((const f32x4*)g)[lane + 64 * j], bb = ((const f32x4*)b)[lane + 64 * j]; const f32x4 y = v[j] * rstd * gg + bb;
        v2u w; w.x = pk2(y[0], y[1]); w.y = pk2(y[2], y[3]); o8[64 * j] = w; }
}
__device__ __forceinline__ void p0_prologue(Frame& F, const Args& A) {
    const int lane0 = lane_id(), tid0 = F.wave * 64 + lane0;
    const int gw = F.vcu * NWAVES + F.wave, NGW = F.G * NWAVES;
    bf16* XN = (bf16*)(F.ws + WS_XN);
    { int par = 0; conv_run<0>((int)blockIdx.x, CT_A, F.G, F.ws, F.lds + RING_OFF, F.wave, lane0, par); __syncthreads(); }
    { bf16* whi = (bf16*)(F.ws + WS_REWG); bf16* wlo = whi + 48 * DM; const float* rgw = arg_in(12); const float* rew = arg_in(14);
      for (int i = (F.vcu * NWAVES * 64) + tid0; i < 48 * DM; i += F.G * NWAVES * 64) { const int n = i / DM, k = i % DM;
          const float w = n < NGRP ? rgw[k * NGRP + n] : (n < NGRP + NEXP ? rew[k * NEXP + (n - NGRP)] : 0.f);
          const unsigned hi = f2bf(w); const float rem = w - __builtin_bit_cast(float, hi << 16);
          whi[i] = (bf16)hi; wlo[i] = (bf16)f2bf(rem); } }
    {
        const float* xin = arg_in(0); const float* g = arg_in(2); const float* b = arg_in(3);
        f32x4 va[8], vb[8];
        int m = gw;
        if (m < MREAL) {
#pragma unroll
            for (int j = 0; j < 8; ++j) va[j] = __builtin_nontemporal_load((const f32x4*)(xin + (size_t)m * DM) + lane0 + 64 * j);
        }
        for (; m < MREAL; m += 2 * NGW) {
            const int m1 = m + NGW, m2 = m + 2 * NGW;
            if (m1 < MREAL) {
#pragma unroll
                for (int j = 0; j < 8; ++j) vb[j] = __builtin_nontemporal_load((const f32x4*)(xin + (size_t)m1 * DM) + lane0 + 64 * j);
            }
            ln_regs_to_bf16(va, g, b, XN + (size_t)m * DM, lane0);
            if (m2 < MREAL) {
#pragma unroll
                for (int j = 0; j < 8; ++j) va[j] = __builtin_nontemporal_load((const f32x4*)(xin + (size_t)m2 * DM) + lane0 + 64 * j);
            }
            if (m1 < MREAL) ln_regs_to_bf16(vb, g, b, XN + (size_t)m1 * DM, lane0);
        }
    }
    for (int m = MREAL + gw; m < MPAD; m += NGW) {
        if (m < MREAL + NMETA) ln_row_to_bf16(arg_in(1) + (size_t)(m - MREAL) * DM, arg_in(2), arg_in(3), XN + (size_t)m * DM, lane0);
        else { v2u* o8 = (v2u*)(XN + (size_t)m * DM) + lane0;
#pragma unroll
            for (int j = 0; j < 8; ++j) o8[64 * j] = (v2u){0u, 0u}; }
    }
}

constexpr int KS_PITCH = 144;
constexpr int VT_PITCH = 584;
constexpr int KROWS = 288;
constexpr int ATT_KS = 0, ATT_VT = KROWS * KS_PITCH, ATT_LDS = ATT_VT + 64 * VT_PITCH;
static_assert(ATT_LDS <= RING_BYTES, "attention LDS");
constexpr float LOG2E = 1.4426950408889634f;

template <int R>
__device__ __forceinline__ void attn_qblock(LAS const unsigned char* lds, bf16* P, int qrow0, int head, float sink_l2, bool has_prev, int lane) {
    asm volatile("" : "+v"(lane));
    const int ql = lane & 31, hh = lane >> 5;
    bf16* qp = P + (size_t)(qrow0 + 32 * R + ql) * LDP + PC_Q + head * HD;
    bf16x8 qf[4];
#pragma unroll
    for (int s = 0; s < 4; ++s) qf[s] = *(const bf16x8*)(qp + 16 * s + 8 * hh);
    f32x16 S[6];
#define KB_ROW(i) ((i) == 0 ? 0 : ((i) <= 4 - R ? 32 + 32 * (R + (i) - 1) : 160 + 32 * ((i) - (5 - R))))
#pragma unroll
    for (int i = 0; i < 6; ++i) {
        const int kr = KB_ROW(i);
        f32x16 a = {0.f, 0.f, 0.f, 0.f, 0.f, 0.f, 0.f, 0.f, 0.f, 0.f, 0.f, 0.f, 0.f, 0.f, 0.f, 0.f};
        const LAS unsigned char* kp = lds + ATT_KS + (kr + ql) * KS_PITCH + 16 * hh;
#pragma unroll
        for (int s = 0; s < 4; ++s) { const bf16x8 kf = *(const LAS bf16x8*)(kp + 32 * s); a = __builtin_amdgcn_mfma_f32_32x32x16_bf16(kf, qf[s], a, 0, 0, 0); }
        S[i] = a;
    }
    const float NEG = -INFINITY; const float sc = 0.125f * LOG2E;
    float mx = sink_l2;
#pragma unroll
    for (int i = 0; i < 6; ++i)
#pragma unroll
        for (int r = 0; r < 16; ++r) {
            const int kvl = (r & 3) + 8 * (r >> 2) + 4 * hh;
            float t = S[i][r] * sc;
            bool ok = true;
            if (i == 0) ok = kvl < NMETA;
            else if (i <= 4 - R) { ok = has_prev; if (i == 1) ok = ok && (kvl > ql); }
            else { if (i == 5) ok = (kvl <= ql); }
            t = ok ? t : NEG; S[i][r] = t; mx = fmaxf(mx, t);
        }
    mx = fmaxf(mx, __shfl_xor(mx, 32));
    float l = 0.f;
#pragma unroll
    for (int i = 0; i < 6; ++i)
#pragma unroll
        for (int r = 0; r < 16; ++r) { const float p = __builtin_amdgcn_exp2f(S[i][r] - mx); S[i][r] = p; l += p; }
    l += __shfl_xor(l, 32);
    l += __builtin_amdgcn_exp2f(sink_l2 - mx);
    const float inv = 1.0f / l;
    f32x16 O[2];
#pragma unroll
    for (int d = 0; d < 2; ++d) O[d] = (f32x16){0.f, 0.f, 0.f, 0.f, 0.f, 0.f, 0.f, 0.f, 0.f, 0.f, 0.f, 0.f, 0.f, 0.f, 0.f, 0.f};
#pragma unroll
    for (int i = 0; i < 6; ++i) {
        const int kr = KB_ROW(i);
#pragma unroll
        for (int s2 = 0; s2 < 2; ++s2) {
            unsigned pw[4];
#pragma unroll
            for (int j = 0; j < 4; ++j) pw[j] = cvt_pk_bf16(S[i][8 * s2 + 2 * j] * inv, S[i][8 * s2 + 2 * j + 1] * inv);
            const v4u pv = {pw[0], pw[1], pw[2], pw[3]};
            const bf16x8 pf = __builtin_bit_cast(bf16x8, pv);
#pragma unroll
            for (int d = 0; d < 2; ++d) {
                const LAS unsigned char* vp = lds + ATT_VT + (ql + 32 * d) * VT_PITCH + (kr + 16 * s2 + 4 * hh) * 2;
                const v2u lo = *(const LAS v2u*)vp, hi = *(const LAS v2u*)(vp + 16);
                const v4u vv = {lo.x, lo.y, hi.x, hi.y};
                O[d] = __builtin_amdgcn_mfma_f32_32x32x16_bf16(pf, __builtin_bit_cast(bf16x8, vv), O[d], 0, 0, 0);
            }
        }
    }
#undef KB_ROW
#pragma unroll
    for (int d = 0; d < 2; ++d)
#pragma unroll
        for (int r = 0; r < 16; ++r) { const int q = (r & 3) + 8 * (r >> 2) + 4 * hh;
            P[(size_t)(qrow0 + 32 * R + q) * LDP + PC_Q + head * HD + 32 * d + ql] = (bf16)f2bf(O[d][r]); }
}

__device__ __forceinline__ f32x4 conv_p(v2u a) { return (f32x4){bf_lo(a.x), bf_hi(a.x), bf_lo(a.y), bf_hi(a.y)}; }
__device__ __forceinline__ void p2_attention_conv(Frame& F, const Args& A) {
    bf16* P = (bf16*)(F.ws + WS_P);
    const float* sinks = arg_in(5);
    const float* cw = arg_in(6);
    const int lane0 = lane_id(), tid0 = F.wave * 64 + lane0;
    const int c0 = 4 * tid0;
    for (int it = blockIdx.x; it < BATCH * NKVH * (SEQ / WIN); it += F.G) {
        const int b = it / (NKVH * 16), kvh = (it / 16) % NKVH, nb = it % 16;
        const int row_own = b * SEQ + nb * WIN, row_prev = row_own - WIN;
        const int r0 = it * 32, s0 = r0 % SEQ;
        const int rm2 = (s0 == 0) ? MREAL + NMETA - 2 : r0 - 2, rm1 = (s0 == 0) ? MREAL + NMETA - 1 : r0 - 1;
        const f32x4 w0 = *(const f32x4*)(cw + c0), w1 = *(const f32x4*)(cw + DM + c0), w2 = *(const f32x4*)(cw + 2 * DM + c0);
        const v2u a2 = *(const v2u*)(P + (size_t)rm2 * LDP + PC_CC + c0);
        const v2u a1 = *(const v2u*)(P + (size_t)rm1 * LDP + PC_CC + c0);
        __syncthreads();
        v4u kq[5], vq[5];
#pragma unroll
        for (int i = 0; i < 5; ++i) { const int q = tid0 + i * (NWAVES * 64); const int row = q >> 3, c = q & 7;
            int grow = -1;
            if (row < NMETA) grow = MREAL + row;
            else if (row >= 32 && row < 160) { if (nb > 0) grow = row_prev + (row - 32); }
            else if (row >= 160 && row < KROWS) grow = row_own + (row - 160);
            kq[i] = (v4u){0u, 0u, 0u, 0u}; vq[i] = (v4u){0u, 0u, 0u, 0u};
            if (grow >= 0) { const bf16* rp = P + (size_t)grow * LDP; kq[i] = *(const v4u*)(rp + PC_K + kvh * HD + 8 * c); vq[i] = *(const v4u*)(rp + PC_V + kvh * HD + 8 * c); } }
#pragma unroll
        for (int i = 0; i < 5; ++i) { const int q = tid0 + i * (NWAVES * 64); const int row = q >> 3, c = q & 7;
            if (q < KROWS * 8) {
                *(LAS v4u*)(F.lds + ATT_KS + row * KS_PITCH + c * 16) = kq[i];
                const unsigned vw[4] = {vq[i].x, vq[i].y, vq[i].z, vq[i].w};
#pragma unroll
                for (int e = 0; e < 4; ++e) {
                    *(LAS unsigned short*)(F.lds + ATT_VT + (8 * c + 2 * e) * VT_PITCH + row * 2) = (unsigned short)(vw[e] & 0xffffu);
                    *(LAS unsigned short*)(F.lds + ATT_VT + (8 * c + 2 * e + 1) * VT_PITCH + row * 2) = (unsigned short)(vw[e] >> 16);
                } } }
        __syncthreads();
        const int head = kvh * 8 + F.wave;
        const float sink_l2 = sinks[head] * LOG2E;
        f32x4 pm2 = conv_p(a2), pm1 = conv_p(a1);
        const unsigned voff0 = (unsigned)c0 * 2u;
#define P2_STEP(R) do { \
            unsigned voff = voff0; asm volatile("" : "+v"(voff)); \
            v2u ca[8], cbb[8]; \
            _Pragma("unroll") for (int i = 0; i < 8; ++i) { const char* rp = (const char*)(P + (size_t)(r0 + 8 * (R) + i) * LDP);     \
                ca[i] = *(const v2u*)(rp + PC_CC * 2 + voff); cbb[i] = *(const v2u*)(rp + PC_CB * 2 + voff); } \
            asm volatile("" ::: "memory"); \
            attn_qblock<R>((LAS const unsigned char*)F.lds, P, row_own, head, sink_l2, nb > 0, lane0); \
            asm volatile("" ::: "memory"); \
            _Pragma("unroll") for (int i = 0; i < 8; ++i) { char* rp = (char*)(P + (size_t)(r0 + 8 * (R) + i) * LDP); \
                const f32x4 p = conv_p(ca[i]); const f32x4 cbv = {bf_lo(cbb[i].x), bf_hi(cbb[i].x), bf_lo(cbb[i].y), bf_hi(cbb[i].y)}; \
                const f32x4 uu = cbv * (w0 * pm2 + w1 * pm1 + w2 * p); \
                v2u o; o.x = pk2(uu[0], uu[1]); o.y = pk2(uu[2], uu[3]); *(v2u*)(rp + PC_CB * 2 + voff) = o; pm2 = pm1; pm1 = p; } } while (0)
        P2_STEP(0); P2_STEP(1); P2_STEP(2); P2_STEP(3);
        if (MK_SEAM23 && N_LAUNCHES == 1 && MK_DUP == 0) {
            asm volatile("s_waitcnt vmcnt(0)" ::: "memory"); __syncthreads();
            if (F.wave == 0 && lane0 == 0) { __builtin_amdgcn_fence(__ATOMIC_RELEASE, "agent"); asm volatile("s_waitcnt vmcnt(0)" ::: "memory");
                __hip_atomic_fetch_add(F.ctl + CW_P2 + 64 * (b * 8 + (nb >> 1)), 1u, RLX_AGENT); __hip_atomic_fetch_add(F.ctl + CW_P2 + 64 * (it >> 3), 1u, RLX_AGENT); }
        }
    }
}

#undef P2_STEP
__device__ __forceinline__ void p5_ln1_router(Frame& F, const Args& A) {
    const int lane = lane_id(), w = F.wave, tid = w * 64 + lane;
    const int rl = lane & 15, kq = lane >> 4;
    bf16* P = (bf16*)(F.ws + WS_P); bf16* XN = (bf16*)(F.ws + WS_XN);
    const float* g1 = arg_in(10); const float* b1 = arg_in(11);
    const float* rgb = arg_in(13); const float* reb = arg_in(15);
    const bf16* whi = (const bf16*)(F.ws + WS_REWG); const bf16* wlo = whi + 48 * DM;
    int* rowidx = (int*)(F.ws + WS_ROWIDX); float* tokw = (float*)(F.ws + WS_TOKW); int* slot = (int*)(F.ws + WS_SLOT);
    unsigned* cnt = (unsigned*)(F.ctl + CW_CNT);
    LAS float* red = (LAS float*)(F.lds + RING_OFF);
    LAS float* plog = (LAS float*)(F.lds + RING_OFF + 4096);
    LAS float* flog = (LAS float*)(F.lds + RING_OFF + 4096 + 49152);
    LAS float* bias = (LAS float*)(F.lds + RING_OFF + 4096 + 49152 + 6144);
    if (tid < NGRP + NEXP) bias[tid] = tid < NGRP ? rgb[tid] : reb[tid - NGRP];
    __syncthreads();
    const int kbase0 = 256 * w + 8 * kq, rl0 = rl;
    for (int rg = blockIdx.x; rg < MREAL / 32; rg += F.G) {
        if (MK_SEAM34 && N_LAUNCHES == 1 && MK_DUP == 0) { if (w == 0) wait_count((unsigned*)(F.ctl + CW_P4) + 64 * (rg >> 3), 64u, (unsigned*)(F.ctl + CW_TMO)); __syncthreads(); }
        int kbase = kbase0, rl = rl0; asm volatile("" : "+v"(kbase), "+v"(rl));
        f32x4 x[2][8][2];
#pragma unroll
        for (int hq = 0; hq < 2; ++hq) { const bf16* xp = P + (size_t)(rg * 32 + 16 * hq + rl) * LDP + PC_GA + kbase;
#pragma unroll
            for (int s = 0; s < 8; ++s) { const v4u q = *(const v4u*)(xp + 32 * s);
                x[hq][s][0] = (f32x4){bf_lo(q.x), bf_hi(q.x), bf_lo(q.y), bf_hi(q.y)}; x[hq][s][1] = (f32x4){bf_lo(q.z), bf_hi(q.z), bf_lo(q.w), bf_hi(q.w)}; } }
#pragma unroll
        for (int hq = 0; hq < 2; ++hq) { float sm = 0.f;
#pragma unroll
            for (int s = 0; s < 8; ++s) sm += ((x[hq][s][0][0] + x[hq][s][0][1]) + (x[hq][s][0][2] + x[hq][s][0][3])) + ((x[hq][s][1][0] + x[hq][s][1][1]) + (x[hq][s][1][2] + x[hq][s][1][3]));
            sm += __shfl_xor(sm, 16); sm += __shfl_xor(sm, 32);
            if (kq == 0) red[w * 32 + 16 * hq + rl] = sm; }
        __syncthreads();
        float rstd[2];
#pragma unroll
        for (int hq = 0; hq < 2; ++hq) { float tot = 0.f;
#pragma unroll
            for (int j = 0; j < 8; ++j) tot += red[j * 32 + 16 * hq + rl];
            const float mean = tot * (1.f / DM); float sq = 0.f;
#pragma unroll
            for (int s = 0; s < 8; ++s)
#pragma unroll
                for (int h = 0; h < 2; ++h) { x[hq][s][h] = x[hq][s][h] - mean; sq += (x[hq][s][h][0] * x[hq][s][h][0] + x[hq][s][h][1] * x[hq][s][h][1]) + (x[hq][s][h][2] * x[hq][s][h][2] + x[hq][s][h][3] * x[hq][s][h][3]); }
            sq += __shfl_xor(sq, 16); sq += __shfl_xor(sq, 32);
            if (kq == 0) red[256 + w * 32 + 16 * hq + rl] = sq; }
        __syncthreads();
#pragma unroll
        for (int hq = 0; hq < 2; ++hq) { float tq = 0.f;
#pragma unroll
            for (int j = 0; j < 8; ++j) tq += red[256 + j * 32 + 16 * hq + rl];
            rstd[hq] = 1.f / sqrtf(tq * (1.f / DM) + LN_EPS); }
        f32x4 acc[2][3];
#pragma unroll
        for (int hq = 0; hq < 2; ++hq)
#pragma unroll
            for (int nb = 0; nb < 3; ++nb) acc[hq][nb] = (f32x4){0.f, 0.f, 0.f, 0.f};
#pragma unroll
        for (int s = 0; s < 8; ++s) {
            const int k0 = kbase + 32 * s;
            const f32x4 ga = *(const f32x4*)(g1 + k0), gb = *(const f32x4*)(g1 + k0 + 4), ba = *(const f32x4*)(b1 + k0), bb = *(const f32x4*)(b1 + k0 + 4);
            bf16x8 bh[3], bl[3];
#pragma unroll
            for (int nb = 0; nb < 3; ++nb) { bh[nb] = *(const bf16x8*)(whi + (size_t)(16 * nb + rl) * DM + k0); bl[nb] = *(const bf16x8*)(wlo + (size_t)(16 * nb + rl) * DM + k0); }
#pragma unroll
            for (int hq = 0; hq < 2; ++hq) {
                const f32x4 ha = x[hq][s][0] * rstd[hq] * ga + ba, hb = x[hq][s][1] * rstd[hq] * gb + bb;
                v4u uh; uh.x = cvt_pk_bf16(ha[0], ha[1]); uh.y = cvt_pk_bf16(ha[2], ha[3]); uh.z = cvt_pk_bf16(hb[0], hb[1]); uh.w = cvt_pk_bf16(hb[2], hb[3]);
                *(v4u*)(XN + (size_t)(rg * 32 + 16 * hq + rl) * DM + k0) = uh;
                v4u ul; ul.x = cvt_pk_bf16(ha[0] - bf_lo(uh.x), ha[1] - bf_hi(uh.x)); ul.y = cvt_pk_bf16(ha[2] - bf_lo(uh.y), ha[3] - bf_hi(uh.y));
                ul.z = cvt_pk_bf16(hb[0] - bf_lo(uh.z), hb[1] - bf_hi(uh.z)); ul.w = cvt_pk_bf16(hb[2] - bf_lo(uh.w), hb[3] - bf_hi(uh.w));
                const bf16x8 ahi = __builtin_bit_cast(bf16x8, uh), alo = __builtin_bit_cast(bf16x8, ul);
#pragma unroll
                for (int nb = 0; nb < 3; ++nb) {
                    acc[hq][nb] = __builtin_amdgcn_mfma_f32_16x16x32_bf16(ahi, bh[nb], acc[hq][nb], 0, 0, 0);
                    acc[hq][nb] = __builtin_amdgcn_mfma_f32_16x16x32_bf16(alo, bh[nb], acc[hq][nb], 0, 0, 0);
                    acc[hq][nb] = __builtin_amdgcn_mfma_f32_16x16x32_bf16(ahi, bl[nb], acc[hq][nb], 0, 0, 0);
                }
            }
            asm volatile("" ::: "memory");
        }
#pragma unroll
        for (int hq = 0; hq < 2; ++hq)
#pragma unroll
            for (int nb = 0; nb < 3; ++nb)
#pragma unroll
                for (int i = 0; i < 4; ++i) plog[(w * 32 + 16 * hq + 4 * kq + i) * 48 + 16 * nb + rl] = acc[hq][nb][i];
        __syncthreads();
        for (int o = tid; o < 32 * 48; o += NWAVES * 64) { float t = 0.f;
#pragma unroll
            for (int j = 0; j < 8; ++j) t += plog[j * 1536 + o];
            flog[o] = t; }
        __syncthreads();
        if (tid < 32) {
            const LAS float* fl = flog + tid * 48; const int m = rg * 32 + tid;
            float gl[4];
#pragma unroll
            for (int c = 0; c < 4; ++c) gl[c] = fl[c] + bias[c];
            int gsel = 0; float gmax = gl[0];
#pragma unroll
            for (int c = 1; c < 4; ++c) if (gl[c] > gmax) { gmax = gl[c]; gsel = c; }
            float gden = 0.f;
#pragma unroll
            for (int c = 0; c < 4; ++c) gden += __expf(gl[c] - gmax);
            const float pgroup = 1.0f / gden;
            float el[8];
#pragma unroll
            for (int c = 0; c < 8; ++c) el[c] = fl[4 + gsel * EPG + c] + bias[NGRP + gsel * EPG + c];
            int i0 = 0; float l0 = el[0];
#pragma unroll
            for (int c = 1; c < 8; ++c) if (el[c] > l0) { l0 = el[c]; i0 = c; }
            int i1 = -1; float l1 = -INFINITY;
#pragma unroll
            for (int c = 0; c < 8; ++c) if (c != i0 && el[c] > l1) { l1 = el[c]; i1 = c; }
            const float e10 = __expf(l1 - l0);
            const float w0 = pgroup / (1.0f + e10), w1 = pgroup * e10 / (1.0f + e10);
            const int e0 = gsel * EPG + i0, e1 = gsel * EPG + i1;
            const unsigned p0 = __hip_atomic_fetch_add(cnt + 64 * e0, 1u, RLX_AGENT), p1 = __hip_atomic_fetch_add(cnt + 64 * e1, 1u, RLX_AGENT);
            rowidx[e0 * MREAL + p0] = m * 2; rowidx[e1 * MREAL + p1] = m * 2 + 1;
            tokw[m * 2] = w0; tokw[m * 2 + 1] = w1;
            slot[m * 2] = (e0 << 16) | (int)p0; slot[m * 2 + 1] = (e1 << 16) | (int)p1;
        }
    }
}

__device__ __forceinline__ void p8_ln2(Frame& F, const Args& A, volatile LAS int* tp) {
    const int gw = F.vcu * NWAVES + F.wave, NGW = F.G * NWAVES;
    const bf16* XN = (const bf16*)(F.ws + WS_XN); const bf16* Y = (const bf16*)(F.ws + WS_Y);
    const float* g2 = arg_in(19); const float* b2 = arg_in(20);
    const int* slot = (const int*)(F.ws + WS_SLOT); const float* tokw = (const float*)(F.ws + WS_TOKW);
    for (int base = gw; base < MREAL; base += 4 * NGW) {
    int sl[4][2]; float wl[4][2];
#pragma unroll
    for (int k = 0; k < 4; ++k) { const int m = base + k * NGW; const int mm = m < MREAL ? m : 0; sl[k][0] = slot[2 * mm]; sl[k][1] = slot[2 * mm + 1]; wl[k][0] = tokw[2 * mm]; wl[k][1] = tokw[2 * mm + 1]; }
#pragma unroll
    for (int k = 0; k < 4; ++k) {
        const int m = base + k * NGW; if (m >= MREAL) break;
        int lane = lane_id();
        const int s0 = sl[k][0], s1 = sl[k][1]; const float w0 = wl[k][0], w1 = wl[k][1];
        const int r0 = __builtin_amdgcn_readfirstlane(tp[s0 >> 16]) * 256 + (s0 & 0xffff), r1 = __builtin_amdgcn_readfirstlane(tp[s1 >> 16]) * 256 + (s1 & 0xffff);
        const v2u* hp = (const v2u*)(XN + (size_t)m * DM) + lane; const v2u* y0 = (const v2u*)(Y + (size_t)r0 * DM) + lane; const v2u* y1 = (const v2u*)(Y + (size_t)r1 * DM) + lane;
        f32x4 v[8]; float s = 0.f;
#pragma unroll
        for (int j = 0; j < 8; ++j) { const v2u h = __builtin_nontemporal_load(hp + 64 * j), a = __builtin_nontemporal_load(y0 + 64 * j), c = __builtin_nontemporal_load(y1 + 64 * j);
            v[j] = (f32x4){ALPHA * bf_lo(h.x) + (w0 * bf_lo(a.x) + w1 * bf_lo(c.x)), ALPHA * bf_hi(h.x) + (w0 * bf_hi(a.x) + w1 * bf_hi(c.x)), ALPHA * bf_lo(h.y) + (w0 * bf_lo(a.y) + w1 * bf_lo(c.y)), ALPHA * bf_hi(h.y) + (w0 * bf_hi(a.y) + w1 * bf_hi(c.y))};
            s += (v[j][0] + v[j][1]) + (v[j][2] + v[j][3]); }
        const float mean = wave_sum(s) * (1.f / DM); float s2 = 0.f;
#pragma unroll
        for (int j = 0; j < 8; ++j) { v[j] = v[j] - mean; s2 += (v[j][0] * v[j][0] + v[j][1] * v[j][1]) + (v[j][2] * v[j][2] + v[j][3] * v[j][3]); }
        const float rstd = 1.f / sqrtf(wave_sum(s2) * (1.f / DM) + LN_EPS);
        f32x4* op = (f32x4*)(F.out + (size_t)m * DM) + lane;
#pragma unroll
        for (int j = 0; j < 8; ++j) { const f32x4 gg = ((const f32x4*)g2)[lane + 64 * j], bb = ((const f32x4*)b2)[lane + 64 * j]; __builtin_nontemporal_store(v[j] * rstd * gg + bb, op + 64 * j); }
    }
    }
}

__global__ void __launch_bounds__(NWAVES * 64, 2) mk_fwd(Args args) {
    extern __shared__ __attribute__((aligned(16))) unsigned char lds[];
    Frame F;
    F.lds = (LAS unsigned char*)lds;
    F.MISC = (volatile LAS unsigned*)(F.lds + MISC_OFF);
    F.wave = __builtin_amdgcn_readfirstlane((int)(threadIdx.x >> 6));
    F.G = gridDim.x; { const int bx = blockIdx.x; F.vcu = (F.G % 8 == 0) ? (bx % 8) * (F.G / 8) + bx / 8 : bx; }
    F.ws = args.ws; F.out = args.out;
    F.ctl = (gu32*)(F.ws + WS_CTL);
    for (int u = threadIdx.x; u < (LDS_BYTES - LDSCTL_OFF) / 4; u += NWAVES * 64) ((LAS unsigned*)(F.lds + LDSCTL_OFF))[u] = 0u;
    __syncthreads();
    XcdBarrier bar; bar.bar = (unsigned*)(F.ctl + CW_BAR); bar.x = 0; bar.st = nullptr; bar.wave = F.wave;
    if (N_LAUNCHES == 1) { bar = xcd_barrier_post((unsigned*)(F.ctl + CW_BAR), F.MISC + 8); bar.wave = F.wave; }
#define GRID_BAR() do { if (N_LAUNCHES == 1) xcd_barrier(bar); } while (0)
    volatile LAS unsigned long long* stamps = (volatile LAS unsigned long long*)(F.lds + LDSCTL_OFF + 4096);
    int n_stamp = 0;
#define STAMP() do { if (MK_SPIN >= 0 && blockIdx.x == 0 && F.wave == 0 && lane_id() == 0) stamps[n_stamp] = __builtin_amdgcn_s_memrealtime(); ++n_stamp; } while (0)
    STAMP();
    const int lo = args.ph_lo, hi = args.ph_hi;
#define REP(k) for (int rep_ = 0; rep_ < 1 + ((MK_DUP >> (k)) & 1); ++rep_)
#ifndef MK_PH_MASK
#define MK_PH_MASK 0x1ff
#endif
#define IN(k) (((MK_PH_MASK >> (k)) & 1) && lo <= (k) && (k) < hi)
    bf16* P = (bf16*)(F.ws + WS_P); bf16* XN = (bf16*)(F.ws + WS_XN);

    if (IN(0)) REP(0) { p0_prologue(F, args); GRID_BAR(); }
    STAMP();

    if (IN(1)) REP(1) {
        const int NSPARE = (F.G == 256) ? 24 : 0;
        if ((int)blockIdx.x < F.G - NSPARE) {
            pg8::Gemm g{XN, (const bf16*)(F.ws + WS_WIN), DM, DM, -1};
            DenseOrder S; S.init(F.wave, MREAL / 256, LDP / 256, F.G - NSPARE, (int)blockIdx.x, (long)256 * DM * 2, (long)256 * DM * 2, (PC_GA - PC_K) / 256, PC_K / 256);
            EpiBf16 E{P, LDP, PC_CC / 256, PC_GA / 256, PC_CC, PC_GA / 256};
            pg8::gemm_phase<EpiBf16, DenseOrder, true>(F.lds + RING_OFF, g, S, E);
        }
        conv_queue((unsigned*)(F.ctl + CW_Q), 0, CT_B1, F.ws, F.lds + RING_OFF, F.MISC + 16, F.wave, lane_id());
        GRID_BAR();
    }
    STAMP();
    constexpr bool SEAM23 = MK_SEAM23 && N_LAUNCHES == 1 && MK_DUP == 0;
    if (IN(2)) { p2_attention_conv(F, args); if (!SEAM23) GRID_BAR(); }
    STAMP();
    constexpr bool SEAM34 = MK_SEAM34 && N_LAUNCHES == 1 && MK_DUP == 0;
    if (IN(3)) REP(3) {
        pg8::Gemm g{P, (const bf16*)(F.ws + WS_WB2), LDP, 2 * DM, DM / 64};
        EpiGate E{P, (bf16*)(F.ws + WS_MRG), SEAM34 ? (unsigned*)(F.ctl + CW_P3) : nullptr};
        if (SEAM23) {
            DenseOrderDep S; S.init(F.wave, MREAL / 256, DM / 256, F.G, (int)blockIdx.x, (long)256 * LDP * 2, (long)256 * 2 * DM * 2);
            S.rdy = (unsigned*)(F.ctl + CW_P2); S.need = 16u; S.tmo = (unsigned*)(F.ctl + CW_TMO);
            pg8::gemm_phase<EpiGate, DenseOrderDep, true>(F.lds + RING_OFF, g, S, E);
        } else {
            DenseOrder S; S.init(F.wave, MREAL / 256, DM / 256, F.G, (int)blockIdx.x, (long)256 * LDP * 2, (long)256 * 2 * DM * 2);
            pg8::gemm_phase<EpiGate, DenseOrder, true>(F.lds + RING_OFF, g, S, E);
        }
        if (!SEAM34) GRID_BAR();
    }
    STAMP();
    if (IN(4)) REP(4) {
        pg8::Gemm g{(const bf16*)(F.ws + WS_MRG), (const bf16*)(F.ws + WS_WOUT), DM, DM, -1};
        EpiPre E{XN, P + PC_GA, LDP, SEAM34 ? (unsigned*)(F.ctl + CW_P4) : nullptr};
        if (SEAM34) {
            DenseOrderDep S; S.init(F.wave, MREAL / 256, DM / 256, F.G, (int)blockIdx.x, (long)256 * DM * 2, (long)256 * DM * 2);
            S.rdy = (unsigned*)(F.ctl + CW_P3); S.need = 64u; S.tmo = (unsigned*)(F.ctl + CW_TMO);
            pg8::gemm_phase<EpiPre, DenseOrderDep, true>(F.lds + RING_OFF, g, S, E);
        } else {
            DenseOrder S; S.init(F.wave, MREAL / 256, DM / 256, F.G, (int)blockIdx.x, (long)256 * DM * 2, (long)256 * DM * 2);
            pg8::gemm_phase<EpiPre, DenseOrder, true>(F.lds + RING_OFF, g, S, E);
            GRID_BAR();
        }
    }
    STAMP();
    if (IN(5)) { p5_ln1_router(F, args); GRID_BAR(); }
    STAMP();
    volatile LAS int* tp = (volatile LAS int*)(F.MISC + 32);
    volatile LAS int* cn = (volatile LAS int*)(F.MISC + 72);
    if (IN(6) || IN(7) || IN(8)) {
        if (F.wave == 0) {
            const int l = lane_id(); const int c = l < NEXP ? (int)__hip_atomic_load(F.ctl + CW_CNT + 64 * (l & 31), RLX_AGENT) : 0;
            const int nt_e = (c + 255) >> 8; int inc = nt_e;
#pragma unroll
            for (int o = 1; o < 32; o <<= 1) { const int v = __shfl_up(inc, o); if ((l & 31) >= o) inc += v; }
            if (l < NEXP) { tp[l] = inc - nt_e; cn[l] = c; if (l == NEXP - 1) tp[32] = inc; }
        }
        __syncthreads();
    }
    constexpr bool MERGE = MK_MOE_MERGE && N_LAUNCHES == 1;
    if (IN(6)) REP(6) {
        pg8::Gemm g{XN, (const bf16*)(F.ws + WS_WGU), DM, DM, -1};
        MoeOrder<4, true> S{F.wave, tp, cn, F.G, F.vcu, (long)1024 * DM * 2, (long)256 * DM * 2, 0, (const int*)(F.ws + WS_ROWIDX), (unsigned)(DM * 2)};
        EpiAct E{(bf16*)(F.ws + WS_ACT), (unsigned*)(F.ctl + CW_RDY)};
        pg8::gemm_phase<EpiAct, MoeOrder<4, true>, true>(F.lds + RING_OFF, g, S, E);
        if (MERGE) conv_queue<true>((unsigned*)(F.ctl + CW_Q + 64), CT_B1, CT_B, F.ws, F.lds + RING_OFF, F.MISC + 16, F.wave, lane_id(), (unsigned*)(F.ctl + CW_WD));
        else { conv_queue<false>((unsigned*)(F.ctl + CW_Q + 64), CT_B1, CT_B, F.ws, F.lds + RING_OFF, F.MISC + 16, F.wave, lane_id()); GRID_BAR(); }
    }
    STAMP();
    if (IN(7)) REP(7) {
        pg8::Gemm g{(const bf16*)(F.ws + WS_ACT), (const bf16*)(F.ws + WS_WD), DE, DE, -1};
        EpiDown E{(bf16*)(F.ws + WS_Y)};
        if (MERGE) {
            if (F.wave == 0) wait_count((unsigned*)(F.ctl + CW_WD), (unsigned)CT_DN, (unsigned*)(F.ctl + CW_TMO));
            MoeDownOrder S{F.wave, tp, cn, F.G, F.vcu, (long)DM * DE * 2, (long)256 * DE * 2, (long)256 * DE * 2, (unsigned*)(F.ctl + CW_RDY), (unsigned*)(F.ctl + CW_WD), (unsigned*)(F.ctl + CW_TMO)};
            pg8::gemm_phase<EpiDown, MoeDownOrder, true>(F.lds + RING_OFF, g, S, E);
        } else {
            MoeOrder<8, false> S{F.wave, tp, cn, F.G, F.vcu, (long)DM * DE * 2, (long)256 * DE * 2, (long)256 * DE * 2, (const int*)(F.ws + WS_ROWIDX), 0u};
            pg8::gemm_phase<EpiDown, MoeOrder<8, false>, true>(F.lds + RING_OFF, g, S, E);
        }
        GRID_BAR();
    }
    STAMP();
    if (IN(8)) REP(8) { p8_ln2(F, args, tp); }
    STAMP();
    if (MK_SPIN >= 0 && blockIdx.x == 0 && F.wave == 0 && lane_id() == 0) {
        const unsigned long long t_end = __builtin_amdgcn_s_memrealtime();
        const unsigned long long span = (MK_SPIN >= 100) ? (unsigned long long)MK_SPIN * 100ull : (stamps[(MK_SPIN < 9 ? MK_SPIN : 8) + 1] - stamps[MK_SPIN < 9 ? MK_SPIN : 8]);
        while (__builtin_amdgcn_s_memrealtime() - t_end < span) __builtin_amdgcn_s_sleep(8);
    }
#undef IN
#undef GRID_BAR
}

extern "C" void kernel_launch(void* const* d_in, const int* in_sizes, int n_in, void* d_out, int out_size, void* d_ws, size_t ws_size, hipStream_t stream) {
    static int grid = 0;
    if (grid == 0) {
        if (n_in != 21 || in_sizes[0] != MREAL * DM || out_size != MREAL * DM || ws_size < WS_END) { fprintf(stderr, "kernel_launch: unexpected shapes / workspace (n_in %d, ws %zu); nothing launched\n", n_in, ws_size); grid = -1; return; }
        int dev = 0, cus = 0, per_cu = 0;
        if (hipGetDevice(&dev) != hipSuccess || hipDeviceGetAttribute(&cus, hipDeviceAttributeMultiprocessorCount, dev) != hipSuccess) { grid = -1; return; }
        if (hipFuncSetAttribute((const void*)mk_fwd, hipFuncAttributeMaxDynamicSharedMemorySize, LDS_BYTES) != hipSuccess) { fprintf(stderr, "kernel_launch: hipFuncSetAttribute failed\n"); grid = -1; return; }
        if (hipOccupancyMaxActiveBlocksPerMultiprocessor(&per_cu, (const void*)mk_fwd, NWAVES * 64, LDS_BYTES) != hipSuccess || per_cu < 1) { fprintf(stderr, "kernel_launch: occupancy query reports %d\n", per_cu); }
        (void)hipGetLastError();
        grid = cus;
    }
    if (grid < 0) return;
    if (hipMemsetAsync((char*)d_ws + WS_CTL, 0, CTL_ZERO_BYTES, stream) != hipSuccess) return;
    Args a{};
    for (int i = 0; i < 21; ++i) a.in[i] = (const float*)d_in[i];
    a.out = (float*)d_out; a.ws = (unsigned char*)d_ws;
    for (int li = 0; li < N_LAUNCHES; ++li) {
        a.ph_lo = (N_LAUNCHES == 1) ? 0 : li; a.ph_hi = (N_LAUNCHES == 1) ? PER_PHASE : li + 1; a.li = li;
        hipLaunchKernelGGL(mk_fwd, dim3(grid), dim3(NWAVES * 64), LDS_BYTES, stream, a);
    }
}
```

```cpp
#include <hip/hip_runtime.h>
#include <cstdio>
#include <cstdint>

#ifndef MK_SPIN
#define MK_SPIN -1
#endif
#ifndef MK_DUP
#define MK_DUP 0
#endif
#ifndef MK_SEAM23
#define MK_SEAM23 1
#endif
#ifndef MK_SEAM34
#define MK_SEAM34 1
#endif
#ifndef MK_LNFUSE
#define MK_LNFUSE 1
#endif
#ifndef MK_MOE_MERGE
#define MK_MOE_MERGE 1
#endif
#ifndef MK_N_LAUNCHES
#define MK_N_LAUNCHES 1
#endif

__device__ __forceinline__ int lane_id() { int l = (int)__builtin_amdgcn_mbcnt_hi(~0u, __builtin_amdgcn_mbcnt_lo(~0u, 0u)); asm volatile("" : "+v"(l)); return l; }
namespace pg8 {
#define PG8_LAS __attribute__((address_space(3)))
typedef unsigned short bf16_t;
typedef short bf16x8 __attribute__((ext_vector_type(8)));
typedef float f32x4 __attribute__((ext_vector_type(4)));
typedef float f32x2 __attribute__((ext_vector_type(2)));
typedef unsigned u32x4 __attribute__((ext_vector_type(4)));
typedef unsigned u32x2 __attribute__((ext_vector_type(2)));
constexpr int BM = 256, BK = 64, HALF = 128, HTB = HALF * BK * 2  , STAGE_BYTES = 8 * HTB, NXCD = 8, WGM = 8;

__host__ __device__ __forceinline__ int lds_byte(int r, int c) { const int st = (r >> 4) * 2 + (c >> 5), rr = r & 15, cc = c & 31, ob = rr * 64 + cc * 2; return st * 1024 + (ob ^ (((ob >> 9) & 1) << 5)); }
__host__ __device__ __forceinline__ void stage_rc(int b, int& R, int& C) { const int st = b / 1024, sb = b % 1024, swz = sb ^ (((sb >> 9) & 1) << 5); R = (st >> 1) * 16 + swz / 64; C = (st & 1) * 32 + (swz % 64) / 2; }
__host__ __device__ __forceinline__ int perm32(int rho) { const int n = rho >> 4, i = rho & 15; return 8 * (i >> 2) + 4 * n + (i & 3); }

struct Unit { int pm, pn; long a_byte, b_byte; int e, mt, cnt; };
struct Gemm { const bf16_t* A; const bf16_t* Bt; int lda; int K; int tmid; };

__device__ __forceinline__ unsigned cvt_pk_bf16(float lo, float hi) { unsigned r; asm volatile("v_cvt_pk_bf16_f32 %0, %1, %2" : "=v"(r) : "v"(lo), "v"(hi)); return r; }
__device__ __forceinline__ float bf_lo(unsigned u) { return __builtin_bit_cast(float, u << 16); }
__device__ __forceinline__ float bf_hi(unsigned u) { return __builtin_bit_cast(float, u & 0xffff0000u); }

template <class Epi, class Sched, bool ALIGN_EPI>
__device__ __forceinline__ void gemm_phase(PG8_LAS unsigned char* lds, const Gemm g, const Sched& S, const Epi& E) {
    constexpr bool GATHER = Sched::GATHER;
    const int lane = lane_id(), wid = S.wave, tid = wid * 64 + lane, wr = wid >> 2, wc = wid & 3, fr = lane & 15, fq = lane >> 4;
    const int K = g.K, nt = K / BK, lda = g.lda;
    unsigned voffA[2], voffB[2]; int rA[2]; unsigned cA2[2];
#pragma unroll
    for (int i = 0; i < 2; ++i) { int R, C; stage_rc(tid * 16 + i * 8192, R, C); const int Rb = Epi::PERM ? ((R & ~31) + perm32(R & 31)) : R;
        voffA[i] = (unsigned)(R * lda + C) * 2u; voffB[i] = (unsigned)(Rb * K + C) * 2u; rA[i] = R; cA2[i] = (unsigned)C * 2u; }
    const size_t kstep = (size_t)(BK * 2);
    const size_t hstepA = (size_t)HALF * lda * 2, hstepB = (size_t)HALF * K * 2;
    const unsigned ldsw = (unsigned)wid * 1024u;
    const int aoff = lds_byte(wr * 64 + fr, fq * 8), boff = lds_byte(wc * 32 + fr, fq * 8);
#define PG8_SA(b, h) (((b) * 2 + (h)) * HTB)
#define PG8_SB(b, h) ((4 + (b) * 2 + (h)) * HTB)
#define PG8_GLDS(gp, ldsoff) __builtin_amdgcn_global_load_lds((const unsigned*)(gp), (PG8_LAS unsigned*)(lds + (ldsoff)), 16, 0, 0)
#define PG8_STAGE_O(bufoff, gbase, o0, o1) do { PG8_GLDS((const char*)(gbase) + (o0), (bufoff) + ldsw); PG8_GLDS((const char*)(gbase) + (o1), (bufoff) + ldsw + 8192); } while (0)
#define PG8_STB(bufoff, gbase) PG8_STAGE_O(bufoff, gbase, voffB[0], voffB[1])
#define PG8_STA(bufoff, ap, h, V) do { if constexpr (GATHER) PG8_STAGE_O(bufoff, ap, V[h][0], V[h][1]); else PG8_STAGE_O(bufoff, (ap) + (h) * hstepA, voffA[0], voffA[1]); } while (0)
#define PG8_LDA(dst, b, h) do { _Pragma("unroll") for (int m = 0; m < 4; ++m) _Pragma("unroll") for (int k = 0; k < 2; ++k) dst[m][k] = *(const PG8_LAS bf16x8*)(lds + PG8_SA(b, h) + aoff + m * 2048 + k * 1024); } while (0)
#define PG8_LDB(dst, b, h) do { _Pragma("unroll") for (int n = 0; n < 2; ++n) _Pragma("unroll") for (int k = 0; k < 2; ++k) dst[n][k] = *(const PG8_LAS bf16x8*)(lds + PG8_SB(b, h) + boff + n * 2048 + k * 1024); } while (0)
#define PG8_MMA(ai, bj, At, Bt) do { __builtin_amdgcn_s_setprio(1); _Pragma("unroll") for (int m = 0; m < 4; ++m) _Pragma("unroll") for (int n = 0; n < 2; ++n) _Pragma("unroll") for (int k = 0; k < 2; ++k) \
        acc[ai][bj][m][n] = __builtin_amdgcn_mfma_f32_16x16x32_bf16(Bt[n][k], At[m][k], acc[ai][bj][m][n], 0, 0, 0); __builtin_amdgcn_s_setprio(0); } while (0)
#define PG8_MMAZ(ai, bj, At, Bt) do { __builtin_amdgcn_s_setprio(1); _Pragma("unroll") for (int m = 0; m < 4; ++m) _Pragma("unroll") for (int n = 0; n < 2; ++n) { \
        acc[ai][bj][m][n] = __builtin_amdgcn_mfma_f32_16x16x32_bf16(Bt[n][0], At[m][0], (f32x4){0.f, 0.f, 0.f, 0.f}, 0, 0, 0); \
        acc[ai][bj][m][n] = __builtin_amdgcn_mfma_f32_16x16x32_bf16(Bt[n][1], At[m][1], acc[ai][bj][m][n], 0, 0, 0); } __builtin_amdgcn_s_setprio(0); } while (0)
#define PG8_KITER(T, MMX) { const int t = (T); \
            const bool last = (t == nt - 2); \
            if constexpr (Epi::MID) { if (t == g.tmid) E.mid(acc, cur, wr, wc, fr, fq); } \
            if (last && has_next) S.a_ready(nxt); \
            const char* a1 = cA + (size_t)(t + 1) * kstep; \
            const char* a2 = last ? nA : cA + (size_t)(t + 2) * kstep; const char* b2 = last ? nB : cB + (size_t)(t + 2) * kstep; \
            const char* a3 = a2 + kstep; const char* b3 = b2 + kstep; \
            unsigned xa[2][2]; \
            _Pragma("unroll") for (int h = 0; h < 2; ++h) _Pragma("unroll") for (int i = 0; i < 2; ++i) xa[h][i] = last ? nva[h][i] : va[h][i]; \
              \
            PG8_LDB(B0, 0, 0); PG8_LDB(B1, 0, 1); PG8_SCHED; PG8_LDA(At, 0, 0); PG8_STA(PG8_SA(1, 1), a1, 1, va); \
            PG8_WAIT_V(8); PG8_WAIT_L(0); PG8_BAR; MMX(0, 0, At, B0); MMX(0, 1, At, B1); PG8_BAR; PG8_SCHED; \
              \
            PG8_LDA(At, 0, 1); PG8_STB(PG8_SB(0, 0), b2); PG8_STB(PG8_SB(0, 1), b2 + hstepB); PG8_STA(PG8_SA(0, 0), a2, 0, xa); \
            PG8_WAIT_V(8); PG8_WAIT_L(0); PG8_BAR; MMX(1, 0, At, B0); MMX(1, 1, At, B1); PG8_BAR; PG8_SCHED; \
              \
            PG8_LDB(B0, 1, 0); PG8_LDB(B1, 1, 1); PG8_SCHED; PG8_LDA(At, 1, 0); PG8_STA(PG8_SA(0, 1), a2, 1, xa); \
            PG8_WAIT_V(8); PG8_WAIT_L(0); PG8_BAR; PG8_MMA(0, 0, At, B0); PG8_MMA(0, 1, At, B1); PG8_BAR; PG8_SCHED; \
              \
            PG8_LDA(At, 1, 1); PG8_STB(PG8_SB(1, 0), b3); PG8_STB(PG8_SB(1, 1), b3 + hstepB); PG8_STA(PG8_SA(1, 0), a3, 0, xa); \
            PG8_WAIT_V(8); PG8_WAIT_L(0); PG8_BAR; PG8_MMA(1, 0, At, B0); PG8_MMA(1, 1, At, B1); PG8_BAR; PG8_SCHED; }
#define PG8_WAIT_V(n) asm volatile("s_waitcnt vmcnt(" #n ")" ::: "memory")
#define PG8_WAIT_L(n) asm volatile("s_waitcnt lgkmcnt(" #n ")" ::: "memory")
#define PG8_BAR __builtin_amdgcn_s_barrier()
#define PG8_SCHED __builtin_amdgcn_sched_barrier(0)
#define PG8_ZERO_ACC do { _Pragma("unroll") for (int a = 0; a < 2; ++a) _Pragma("unroll") for (int b = 0; b < 2; ++b) _Pragma("unroll") for (int m = 0; m < 4; ++m) _Pragma("unroll") for (int n = 0; n < 2; ++n) { \
        f32x2 z0, z1; asm volatile("v_mov_b64 %0, 0" : "=v"(z0)); asm volatile("v_mov_b64 %0, 0" : "=v"(z1)); acc[a][b][m][n] = (f32x4){z0[0], z0[1], z1[0], z1[1]}; } } while (0)
    Unit cur, nxt; int ui = 0;
    if (!S.next(0, cur)) return;
    f32x4 acc[2][2][4][2];
    if constexpr (!Sched::PEEL) PG8_ZERO_ACC;
    bf16x8 At[4][2], B0[2][2], B1[2][2];
    unsigned va[2][2], nva[2][2];
    if constexpr (GATHER) {
#pragma unroll
        for (int h = 0; h < 2; ++h)
#pragma unroll
            for (int i = 0; i < 2; ++i) { va[h][i] = S.row_byte(cur, h * HALF + rA[i]) + cA2[i]; nva[h][i] = va[h][i]; }
    } else { va[0][0] = va[0][1] = va[1][0] = va[1][1] = 0u; nva[0][0] = nva[0][1] = nva[1][0] = nva[1][1] = 0u; }
    const char* cA = (const char*)g.A + cur.a_byte; const char* cB = (const char*)g.Bt + cur.b_byte;
    S.a_ready(cur);
    PG8_STB(PG8_SB(0, 0), cB); PG8_STB(PG8_SB(0, 1), cB + hstepB); PG8_STA(PG8_SA(0, 0), cA, 0, va); PG8_STA(PG8_SA(0, 1), cA, 1, va);
    if (wr == 1) PG8_BAR;
    PG8_WAIT_V(2); PG8_BAR;
    PG8_STB(PG8_SB(1, 0), cB + kstep); PG8_STA(PG8_SA(1, 0), cA + kstep, 0, va); PG8_STB(PG8_SB(1, 1), cB + hstepB + kstep);
    PG8_WAIT_V(6); PG8_BAR;
    for (;;) {
        const bool has_next = S.next(ui + 1, nxt);
        const char* nA = has_next ? (const char*)g.A + nxt.a_byte : cA; const char* nB = has_next ? (const char*)g.Bt + nxt.b_byte : cB;
        if constexpr (GATHER) {
            if (has_next) {
#pragma unroll
                for (int h = 0; h < 2; ++h)
#pragma unroll
                    for (int i = 0; i < 2; ++i) nva[h][i] = S.row_byte(nxt, h * HALF + rA[i]) + cA2[i];
            }
            asm volatile("" : "+v"(nva[0][0]), "+v"(nva[0][1]), "+v"(nva[1][0]), "+v"(nva[1][1]));
        }
        if constexpr (Sched::PEEL) { PG8_KITER(0, PG8_MMAZ) for (int tt = 2; tt < nt; tt += 2) PG8_KITER(tt, PG8_MMA) }
        else { for (int tt = 0; tt < nt; tt += 2) PG8_KITER(tt, PG8_MMA) }
        if constexpr (ALIGN_EPI) { if (wr == 0) PG8_BAR; }
        if constexpr (!Epi::AFTER_DRAIN) E(acc, cur, wr, wc, fr, fq);
        if (!has_next) break;
        if constexpr (!Sched::PEEL) PG8_ZERO_ACC;
        cur = nxt; cA = nA; cB = nB; ++ui;
        if constexpr (GATHER) {
#pragma unroll
            for (int h = 0; h < 2; ++h)
#pragma unroll
                for (int i = 0; i < 2; ++i) va[h][i] = nva[h][i];
        }
        if constexpr (ALIGN_EPI) { if (wr == 1) PG8_BAR; }
    }
    PG8_WAIT_V(0);
    if constexpr (!ALIGN_EPI) { if (wr == 0) PG8_BAR; }
    PG8_BAR;
    if constexpr (Epi::AFTER_DRAIN) E.fused(acc, cur, wr, wc, fr, fq, lds, wid, lane);
#undef PG8_SA
#undef PG8_SB
#undef PG8_GLDS
#undef PG8_STAGE_O
#undef PG8_STB
#undef PG8_STA
#undef PG8_LDA
#undef PG8_LDB
#undef PG8_MMA
#undef PG8_MMAZ
#undef PG8_KITER
#undef PG8_WAIT_V
#undef PG8_WAIT_L
#undef PG8_BAR
#undef PG8_SCHED
#undef PG8_ZERO_ACC
}
}

constexpr int NWAVES = 8;
constexpr int N_LAUNCHES = MK_N_LAUNCHES;
constexpr int PER_PHASE = 9;
constexpr int BATCH = 4, SEQ = 2048, DM = 2048, NMETA = 16;
constexpr int MREAL = BATCH * SEQ;
constexpr int MPAD = MREAL + 256;
constexpr int LDP = 12800;
constexpr int PC_Q = 0, PC_CB = 2048, PC_K = 4096, PC_V = 4352, PC_CC = 4608, PC_CH = 6656, PC_GA = 8704, PC_GC = 10752;
constexpr int NQH = 32, NKVH = 4, HD = 64, WIN = 128;
constexpr int NEXP = 32, NGRP = 4, EPG = 8, DE = 512;
constexpr float LN_EPS = 1e-5f;
constexpr float ALPHA = 1.189207115002721f;
constexpr int MOE_ROWS_MAX = 2 * MREAL + NEXP * 256;

constexpr int CT_IN = 32 * 50, CT_SQ = 32 * 8, CT_GU = 32 * 64, CT_DN = 32 * 64;
constexpr size_t MiB = 1u << 20;
constexpr size_t WS_CTL = 0, CTL_ZERO_BYTES = 131072;
constexpr size_t WS_ROWIDX = 1 * MiB;
constexpr size_t WS_TOKW = 2 * MiB;
constexpr size_t WS_SLOT = 2 * MiB + 128 * 1024;
constexpr size_t WS_REWG = 3 * MiB;
constexpr size_t WS_WIN = 4 * MiB;
constexpr size_t WS_WB2 = 54 * MiB;
constexpr size_t WS_WOUT = 70 * MiB;
constexpr size_t WS_WGU = 78 * MiB;
constexpr size_t WS_WD = 206 * MiB;
constexpr size_t WS_XN = 270 * MiB;
constexpr size_t WS_P = 303 * MiB;
constexpr size_t WS_ACT = WS_P;
constexpr size_t WS_Y = WS_P + 24 * MiB;
constexpr size_t WS_MRG = 512 * MiB;
constexpr size_t WS_RP = 544 * MiB;
constexpr size_t WS_XB = 557 * MiB;
constexpr size_t WS_END = 558 * MiB;
static_assert(WS_P + (size_t)MPAD * LDP * 2 <= WS_MRG && WS_Y + (size_t)MOE_ROWS_MAX * DM * 2 <= WS_MRG && (size_t)MOE_ROWS_MAX * DE * 2 <= 24 * MiB, "ws map");
constexpr int CW_TMO = 0, CW_CODE = 1;
constexpr int CW_CNT = 256;
constexpr int CW_Q = 64;
constexpr int CW_BAR = 4096;
constexpr int CW_ST = 16384 + 6144;
constexpr int CW_P2 = 16384 + 4096, CW_P3 = 16384, CW_P4 = 16384 + 2048;
constexpr int CW_WD = 192;
constexpr int CW_RDY = 8192;
static_assert((CW_RDY + 64 * 96) * 4 <= 65536 && (CW_ST + 2048) * 4 <= 131072, "control words inside the memset");

constexpr int RING_OFF = 0, RING_BYTES = 131072;
constexpr int LDSCTL_OFF = RING_BYTES, MISC_OFF = LDSCTL_OFF + 320;
constexpr int LDS_BYTES = 147456;

#define GAS __attribute__((address_space(1)))
#define LAS __attribute__((address_space(3)))
typedef unsigned short bf16;
typedef unsigned v4u __attribute__((ext_vector_type(4)));
typedef unsigned v2u __attribute__((ext_vector_type(2)));
typedef float f32x4 __attribute__((ext_vector_type(4)));
typedef float f32x16 __attribute__((ext_vector_type(16)));
typedef short bf16x8 __attribute__((ext_vector_type(8)));
typedef short s16x4 __attribute__((ext_vector_type(4)));
typedef GAS unsigned gu32;
#define RLX_AGENT __ATOMIC_RELAXED, __HIP_MEMORY_SCOPE_AGENT
#define LDS_WAIT() asm volatile("s_waitcnt lgkmcnt(0)" ::: "memory")
#define VM_WAIT() asm volatile("s_waitcnt vmcnt(0)" ::: "memory")
__device__ __forceinline__ unsigned f2bf(float f) { unsigned u = __builtin_bit_cast(unsigned, f); return (u + 0x7fffu + ((u >> 16) & 1u)) >> 16; }
__device__ __forceinline__ unsigned pk2(float lo, float hi) { return f2bf(lo) | (f2bf(hi) << 16); }
using pg8::bf_lo; using pg8::bf_hi; using pg8::cvt_pk_bf16;

#define XB_TMO      128
#define XB_XCNT(j)  (256  + 64 * (j))
#define XB_XSUB(j)  (1280 + 64 * (j))
#define XB_XGEN(j)  (2304 + 64 * (j))
#define XB_TOP      3328
#define XB_TOPGEN   3392
#define XCD_BAR_WORDS 3456
#define XB_SPIN_CAP (1u << 18)
__device__ __forceinline__ unsigned xb_ld(unsigned* p)              { return __hip_atomic_load(p, __ATOMIC_RELAXED, __HIP_MEMORY_SCOPE_AGENT); }
__device__ __forceinline__ unsigned xb_add(unsigned* p, unsigned v) { return __hip_atomic_fetch_add(p, v, __ATOMIC_RELAXED, __HIP_MEMORY_SCOPE_AGENT); }
__device__ __forceinline__ unsigned xb_xcc_id() { return (unsigned)__builtin_amdgcn_s_getreg((3 << 11) | 20) & 0xFu; }
#define XB_SPIN(cond, bar) do { unsigned _sp = 0; while (cond) { __builtin_amdgcn_s_sleep(1); \
    if ((++_sp & 255u) == 0u) { if (xb_ld(&(bar)[XB_TMO])) break; if (_sp > XB_SPIN_CAP) { atomicAdd(&(bar)[XB_TMO], 1u); break; } } } } while (0)
struct XcdBarrier { unsigned* bar; unsigned x; volatile LAS unsigned* st; int wave; };
__device__ __forceinline__ XcdBarrier xcd_barrier_post(unsigned* bar, volatile LAS unsigned* st) {
    XcdBarrier b; b.bar = bar; b.x = xb_xcc_id(); b.st = st; b.wave = 0;
    if (threadIdx.x == 0) (void)xb_add(&bar[XB_XCNT(b.x)], 1u);
    return b;
}
__device__ __forceinline__ void xcd_barrier_complete(unsigned* bar, unsigned x, unsigned& nloc, unsigned& nx) {
    const unsigned G = gridDim.x * gridDim.y * gridDim.z;
    unsigned sum, cnt, mine, sp = 0u;
    for (;;) {
        sum = 0u; cnt = 0u; mine = 0u;
#pragma unroll
        for (unsigned j = 0; j < 16; ++j) { const unsigned c = xb_ld(&bar[XB_XCNT(j)]); sum += c; cnt += (c > 0u) ? 1u : 0u; mine = (j == x) ? c : mine; }
        if (sum == G) break;
        __builtin_amdgcn_s_sleep(1);
        if ((++sp & 255u) == 0u) { if (xb_ld(&bar[XB_TMO])) break; if (sp > XB_SPIN_CAP) { atomicAdd(&bar[XB_TMO], 1u); break; } }
    }
    nloc = mine > 0u ? mine : 1u; nx = cnt > 0u ? cnt : 1u;
}
__device__ __forceinline__ void xcd_barrier(const XcdBarrier& b) {
    asm volatile("s_waitcnt vmcnt(0)" ::: "memory");
    __syncthreads();
    if (b.wave == 0 && lane_id() == 0) {
        unsigned* bar = b.bar;
        __builtin_amdgcn_s_waitcnt(0);
        unsigned nloc = b.st[0], nx = b.st[1];
        if (nloc == 0u) { xcd_barrier_complete(bar, b.x, nloc, nx); b.st[0] = nloc; b.st[1] = nx; }
        const unsigned old = xb_add(&bar[XB_XSUB(b.x)], 1u);
        const unsigned gen = old / nloc;
        if (old + 1u == (gen + 1u) * nloc) {
            __builtin_amdgcn_fence(__ATOMIC_RELEASE, "agent");
            asm volatile("s_waitcnt vmcnt(0)" ::: "memory");
            const unsigned og = xb_add(&bar[XB_TOP], 1u);
            const unsigned tg = og / nx;
            if (og + 1u == (tg + 1u) * nx) xb_add(&bar[XB_TOPGEN], 1u);
            else XB_SPIN(xb_ld(&bar[XB_TOPGEN]) == tg, bar);
            __builtin_amdgcn_fence(__ATOMIC_ACQUIRE, "agent");
            xb_add(&bar[XB_XGEN(b.x)], 1u);
            asm volatile("s_waitcnt vmcnt(0)" ::: "memory");
        } else {
            XB_SPIN(xb_ld(&bar[XB_XGEN(b.x)]) == gen, bar);
            __builtin_amdgcn_fence(__ATOMIC_ACQUIRE, "agent");
            asm volatile("s_waitcnt vmcnt(0)" ::: "memory");
        }
    }
    __syncthreads();
}

struct Frame {
    LAS unsigned char* lds;
    volatile LAS unsigned* MISC;
    gu32* ctl;
    int wave;
    int vcu, G;
    float* out;
    unsigned char* ws;
};
struct Args { const float* in[21]; float* out; unsigned char* ws; int ph_lo, ph_hi, li, pad; };
__device__ __forceinline__ const float* arg_in(int i) {
    const __attribute__((address_space(4))) char* ka = (const __attribute__((address_space(4))) char*)__builtin_amdgcn_kernarg_segment_ptr();
    unsigned off = (unsigned)i * 8u; asm volatile("" : "+s"(off));
    return *(const float* const __attribute__((address_space(4)))*)(ka + off);
}
__device__ __forceinline__ float wave_sum(float v) {
#pragma unroll
    for (int o = 1; o < 64; o <<= 1) v += __shfl_xor(v, o);
    return v;
}

struct DenseOrder {
    static constexpr bool GATHER = false, PEEL = true;
    int nM, nN, nwg, G, c, extra, ex0, wave; long a_tile, b_tile;
    __device__ void init(int wave_, int nM_, int nN_, int G_, int c_, long a_tile_, long b_tile_, int extra_ = 0, int ex0_ = 0) { wave = wave_; nM = nM_; nN = nN_; nwg = nM * nN; G = G_; c = c_; a_tile = a_tile_; b_tile = b_tile_; extra = extra_; ex0 = ex0_; }
    __device__ bool next(int i, pg8::Unit& u) const {
        const long L = (long)i * G + c; if (L >= nwg + extra) return false;
        if (L >= nwg) { u.pm = nM; u.pn = ex0 + (int)(L - nwg); }
        else {
            int wgid = (int)L; { const int q = nwg / pg8::NXCD, r = nwg % pg8::NXCD, xcd = wgid % pg8::NXCD, off = wgid / pg8::NXCD; wgid = (xcd < r ? xcd * (q + 1) : r * (q + 1) + (xcd - r) * q) + off; }
            const int nig = pg8::WGM * nN, gid = wgid / nig, fm = gid * pg8::WGM, gsz = (nM - fm) < pg8::WGM ? (nM - fm) : pg8::WGM;
            u.pm = fm + ((wgid % nig) % gsz); u.pn = (wgid % nig) / gsz;
        }
        u.a_byte = (long)u.pm * a_tile; u.b_byte = (long)u.pn * b_tile; u.e = 0; u.mt = 0; u.cnt = 0; return true;
    }
    __device__ __forceinline__ unsigned row_byte(const pg8::Unit&, int) const { return 0u; }
    __device__ __forceinline__ void a_ready(const pg8::Unit&) const {}
};
__device__ __forceinline__ void wait_count(unsigned* word, unsigned need, unsigned* tmo) {
    unsigned sp = 0;
    while ((unsigned)__builtin_amdgcn_readfirstlane((int)__hip_atomic_load(word, RLX_AGENT)) < need) {
        __builtin_amdgcn_s_sleep(2);
        if (++sp > (1u << 22)) { if (lane_id() == 0) __hip_atomic_store(tmo, 1u, RLX_AGENT); break; }
    }
    __builtin_amdgcn_fence(__ATOMIC_ACQUIRE, "agent");
    asm volatile("s_waitcnt vmcnt(0)" ::: "memory");
}
struct DenseOrderDep : DenseOrder {
    unsigned* rdy; unsigned need; unsigned* tmo;
    __device__ __forceinline__ void a_ready(const pg8::Unit& u) const {
        if (wave == 0) wait_count(rdy + 64 * u.pm, need, tmo);
        asm volatile("" ::: "memory"); __builtin_amdgcn_s_barrier(); asm volatile("" ::: "memory");
    }
};
__device__ __forceinline__ void moe_decode(volatile LAS int* tp, int L, int NT, int& e, int& mt, int& n) {
    const int l_ = lane_id(); const int tv_ = tp[l_ & 31];
    e = (int)__builtin_popcountll(__ballot(l_ >= 1 && l_ < 32 && NT * tv_ <= L));
    const int base = __builtin_amdgcn_readfirstlane(tp[e]), nte = __builtin_amdgcn_readfirstlane(tp[e + 1]) - base, r = L - NT * base;
    n = __builtin_amdgcn_readfirstlane(r / nte); mt = r - n * nte;
}
template <int NT, bool GATH>
struct MoeOrder {
    static constexpr bool GATHER = GATH, PEEL = false;
    int wave; volatile LAS int* tp; volatile LAS int* cn; int G, c; long b_exp, b_tile, a_tile; const int* rowidx; unsigned row_bytes;
    __device__ bool next(int i, pg8::Unit& u) const {
        const int total = __builtin_amdgcn_readfirstlane(tp[32]) * NT;
        const long L = (long)i * G + c; if (L >= total) return false;
        int e, mt, n; moe_decode(tp, (int)L, NT, e, mt, n);
        const int T = __builtin_amdgcn_readfirstlane(tp[e]) + mt;
        u.e = e; u.mt = mt; u.cnt = __builtin_amdgcn_readfirstlane(cn[e]); u.pm = T; u.pn = n;
        u.a_byte = GATH ? 0 : (long)T * a_tile; u.b_byte = (long)e * b_exp + (long)n * b_tile; return true;
    }
    __device__ __forceinline__ unsigned row_byte(const pg8::Unit& u, int r) const {
        const int pos = u.mt * 256 + r;
        int tk = 0; if (pos < u.cnt) tk = rowidx[u.e * MREAL + pos];
        return (unsigned)(tk >> 1) * row_bytes;
    }
    __device__ __forceinline__ void a_ready(const pg8::Unit&) const {}
};
struct MoeDownOrder {
    static constexpr bool GATHER = false, PEEL = false;
    int wave; volatile LAS int* tp; volatile LAS int* cn; int G, c; long b_exp, b_tile, a_tile; unsigned* rdy; unsigned* wd; unsigned* tmo; bool pre;
    __device__ bool next(int i, pg8::Unit& u) const {
        const int T = __builtin_amdgcn_readfirstlane(tp[32]), nb2 = 4 * T > G ? 4 * T - G : 0;
        const int lq = lane_id(); const int tq = tp[lq <= 32 ? lq : 32];
        const int T1 = __builtin_amdgcn_readfirstlane(tp[(int)__builtin_popcountll(__ballot(lq <= 32 && 4 * tq <= G)) - 1]);
        int j;
        if (c >= nb2) { j = (c - nb2) + i * (G - nb2); if (j >= 8 * T1) return false; }
        else { j = c + i * nb2; if (j >= 8 * (T - T1)) return false; j += 8 * T1; }
        int e, mt, n; moe_decode(tp, j, 8, e, mt, n);
        const int Tt = __builtin_amdgcn_readfirstlane(tp[e]) + mt;
        u.e = e; u.mt = mt; u.cnt = __builtin_amdgcn_readfirstlane(cn[e]); u.pm = Tt; u.pn = n;
        u.a_byte = (long)Tt * a_tile; u.b_byte = (long)e * b_exp + (long)n * b_tile; return true;
    }
    __device__ __forceinline__ unsigned row_byte(const pg8::Unit&, int) const { return 0u; }
    __device__ __forceinline__ void a_ready(const pg8::Unit& u) const {
        if (pre) return;
        if (wave == 0) {
            unsigned sp = 0;
            while ((unsigned)__builtin_amdgcn_readfirstlane((int)__hip_atomic_load(rdy + 64 * u.pm, RLX_AGENT)) < 32u) {
                __builtin_amdgcn_s_sleep(2);
                if (++sp > (1u << 22)) { if (lane_id() == 0) __hip_atomic_store(tmo, 1u, RLX_AGENT); break; }
            }
            __builtin_amdgcn_fence(__ATOMIC_ACQUIRE, "agent");
            asm volatile("s_waitcnt vmcnt(0)" ::: "memory");
        }
        asm volatile("" ::: "memory"); __builtin_amdgcn_s_barrier(); asm volatile("" ::: "memory");
    }
};

__device__ __forceinline__ void st16_wt(void* p, v4u v) { asm volatile("global_store_dwordx4 %0, %1, off sc1\n\ts_nop 1" :: "v"(p), "v"(v) : "memory"); }
using pg8::Unit; using pg8::HALF; using pg8::BM;
__device__ __forceinline__ void st8_wt(void* p, v2u v) { asm volatile("global_store_dwordx2 %0, %1, off sc1" :: "v"(p), "v"(v) : "memory"); }
__device__ __forceinline__ void st2_wt(void* p, unsigned v) { asm volatile("global_store_short %0, %1, off sc1" :: "v"(p), "v"(v) : "memory"); }
struct EpiBf16 {
    static constexpr bool PERM = true, MID = false, AFTER_DRAIN = false;
    bf16* O; int ldc; int pp_lo, pp_hi, pp_col, sg_lo;
    __device__ __forceinline__ void mid(f32x4 (&)[2][2][4][2], const Unit&, int, int, int, int) const {}
    __device__ __forceinline__ void operator()(const f32x4 (&acc)[2][2][4][2], const Unit& u, int wr, int wc, int fr, int fq) const {
        const int row0 = u.pm * BM + wr * 64 + fr, col0 = u.pn * BM + wc * 32 + 8 * fq;
        if (pp_lo <= u.pn && u.pn < pp_hi) {
            const int pc = pp_col + (u.pn - pp_lo) * HALF + wc * 32 + 8 * fq;
#pragma unroll
            for (int ai = 0; ai < 2; ++ai)
#pragma unroll
                for (int m = 0; m < 4; ++m) { bf16* rowp = O + (size_t)(row0 + ai * HALF + m * 16) * ldc + pc;
                    const f32x4 v0 = acc[ai][0][m][0] * acc[ai][1][m][0], v1 = acc[ai][0][m][1] * acc[ai][1][m][1];
                    v4u w; w.x = cvt_pk_bf16(v0[0], v0[1]); w.y = cvt_pk_bf16(v0[2], v0[3]); w.z = cvt_pk_bf16(v1[0], v1[1]); w.w = cvt_pk_bf16(v1[2], v1[3]);
                    *(v4u*)rowp = w; }
            return;
        }
        if (u.pn >= sg_lo) {
            const int gcol = (u.pn - sg_lo) * HALF + wc * 32 + 8 * fq;
#pragma unroll
            for (int ai = 0; ai < 2; ++ai)
#pragma unroll
                for (int m = 0; m < 4; ++m) { bf16* rowp = O + (size_t)(row0 + ai * HALF + m * 16) * ldc + gcol;
                    float r[8], c[8];
#pragma unroll
                    for (int n = 0; n < 2; ++n)
#pragma unroll
                        for (int j = 0; j < 4; ++j) { const float ea = 1.0f + __expf(-acc[ai][0][m][n][j]), ec = 1.0f + __expf(-acc[ai][1][m][n][j]);
                            r[n * 4 + j] = ec * __builtin_amdgcn_rcpf(ea); c[n * 4 + j] = __builtin_amdgcn_rcpf(ec); }
                    v4u w; w.x = cvt_pk_bf16(r[0], r[1]); w.y = cvt_pk_bf16(r[2], r[3]); w.z = cvt_pk_bf16(r[4], r[5]); w.w = cvt_pk_bf16(r[6], r[7]);
                    *(v4u*)(rowp + PC_GA) = w;
                    w.x = cvt_pk_bf16(c[0], c[1]); w.y = cvt_pk_bf16(c[2], c[3]); w.z = cvt_pk_bf16(c[4], c[5]); w.w = cvt_pk_bf16(c[6], c[7]);
                    *(v4u*)(rowp + PC_GC) = w; }
            return;
        }
#pragma unroll
        for (int ai = 0; ai < 2; ++ai)
#pragma unroll
            for (int m = 0; m < 4; ++m) { bf16* rowp = O + (size_t)(row0 + ai * HALF + m * 16) * ldc + col0;
#pragma unroll
                for (int bj = 0; bj < 2; ++bj) { const f32x4 v0 = acc[ai][bj][m][0], v1 = acc[ai][bj][m][1];
                    v4u w; w.x = cvt_pk_bf16(v0[0], v0[1]); w.y = cvt_pk_bf16(v0[2], v0[3]); w.z = cvt_pk_bf16(v1[0], v1[1]); w.w = cvt_pk_bf16(v1[2], v1[3]);
                    *(v4u*)(rowp + bj * HALF) = w; } }
    }
};
__device__ __forceinline__ float sigm(float x) { return __builtin_amdgcn_rcpf(1.0f + __expf(-x)); }
struct EpiGate {
    static constexpr bool PERM = true, MID = true, AFTER_DRAIN = false;
    bf16* P; bf16* MRG; unsigned* rdy;
    __device__ __forceinline__ void mid(f32x4 (&acc)[2][2][4][2], const Unit& u, int wr, int wc, int fr, int fq) const {
        int row0 = u.pm * BM + wr * 64 + fr, col0 = u.pn * BM + wc * 32 + 8 * fq;
        asm volatile("" : "+v"(row0), "+v"(col0));
#pragma unroll
        for (int ai = 0; ai < 2; ++ai)
#pragma unroll
            for (int m = 0; m < 4; ++m) { const bf16* rowp = P + (size_t)(row0 + ai * HALF + m * 16) * LDP + col0;
#pragma unroll
                for (int bj = 0; bj < 2; ++bj) { const v4u a = *(const v4u*)(rowp + PC_GA + bj * HALF);
                    const unsigned aw[4] = {a.x, a.y, a.z, a.w};
#pragma unroll
                    for (int q = 0; q < 4; ++q) { acc[ai][bj][m][q >> 1][(q & 1) * 2] *= bf_lo(aw[q]); acc[ai][bj][m][q >> 1][(q & 1) * 2 + 1] *= bf_hi(aw[q]); } }
                asm volatile("" ::: "memory"); }
    }
    __device__ __forceinline__ void operator()(const f32x4 (&acc)[2][2][4][2], const Unit& u, int wr, int wc, int fr, int fq) const {
        const int row0 = u.pm * BM + wr * 64 + fr, col0 = u.pn * BM + wc * 32 + 8 * fq;
        v4u cg[2][4][2];
#pragma unroll
        for (int ai = 0; ai < 2; ++ai)
#pragma unroll
            for (int m = 0; m < 4; ++m) { const bf16* rowp = P + (size_t)(row0 + ai * HALF + m * 16) * LDP + col0;
#pragma unroll
                for (int bj = 0; bj < 2; ++bj) cg[ai][m][bj] = *(const v4u*)(rowp + PC_GC + bj * HALF); }
        asm volatile("" ::: "memory");
#pragma unroll
        for (int ai = 0; ai < 2; ++ai)
#pragma unroll
            for (int m = 0; m < 4; ++m) {
#pragma unroll
                for (int bj = 0; bj < 2; ++bj) { const v4u c = cg[ai][m][bj]; const unsigned cw[4] = {c.x, c.y, c.z, c.w};
                    const f32x4 v0 = acc[ai][bj][m][0], v1 = acc[ai][bj][m][1];
                    v4u w;
                    w.x = cvt_pk_bf16(v0[0] * bf_lo(cw[0]), v0[1] * bf_hi(cw[0])); w.y = cvt_pk_bf16(v0[2] * bf_lo(cw[1]), v0[3] * bf_hi(cw[1]));
                    w.z = cvt_pk_bf16(v1[0] * bf_lo(cw[2]), v1[1] * bf_hi(cw[2])); w.w = cvt_pk_bf16(v1[2] * bf_lo(cw[3]), v1[3] * bf_hi(cw[3]));
                    bf16* mp = MRG + (size_t)(row0 + ai * HALF + m * 16) * DM + col0 + bj * HALF;
                    if (rdy) st16_wt(mp, w); else *(v4u*)mp = w; } }
        if (rdy) { asm volatile("s_waitcnt vmcnt(0)" ::: "memory"); if (fr == 0 && fq == 0) __hip_atomic_fetch_add(rdy + 64 * u.pm, 1u, RLX_AGENT); }
    }
};
struct EpiPre {
    static constexpr bool PERM = true, MID = false, AFTER_DRAIN = false;
    const bf16* XN; bf16* pre; int ldo; unsigned* rdy;
    __device__ __forceinline__ void mid(f32x4 (&)[2][2][4][2], const Unit&, int, int, int, int) const {}
    __device__ __forceinline__ void operator()(const f32x4 (&acc)[2][2][4][2], const Unit& u, int wr, int wc, int fr, int fq) const {
        const int row0 = u.pm * BM + wr * 64 + fr, col0 = u.pn * BM + wc * 32 + 8 * fq;
#pragma unroll
        for (int ai = 0; ai < 2; ++ai)
#pragma unroll
            for (int m = 0; m < 4; ++m) { const int r = row0 + ai * HALF + m * 16; const bf16* xr = XN + (size_t)r * DM + col0; bf16* orow = pre + (size_t)r * ldo + col0;
#pragma unroll
                for (int bj = 0; bj < 2; ++bj) { const v4u h = *(const v4u*)(xr + bj * HALF); const f32x4 a0 = acc[ai][bj][m][0], a1 = acc[ai][bj][m][1];
                    v4u o; o.x = cvt_pk_bf16(ALPHA * bf_lo(h.x) + a0[0], ALPHA * bf_hi(h.x) + a0[1]); o.y = cvt_pk_bf16(ALPHA * bf_lo(h.y) + a0[2], ALPHA * bf_hi(h.y) + a0[3]);
                    o.z = cvt_pk_bf16(ALPHA * bf_lo(h.z) + a1[0], ALPHA * bf_hi(h.z) + a1[1]); o.w = cvt_pk_bf16(ALPHA * bf_lo(h.w) + a1[2], ALPHA * bf_hi(h.w) + a1[3]);
                    if (rdy) st16_wt(orow + bj * HALF, o); else *(v4u*)(orow + bj * HALF) = o; } }
        if (rdy) { asm volatile("s_waitcnt vmcnt(0)" ::: "memory"); if (fr == 0 && fq == 0) __hip_atomic_fetch_add(rdy + 64 * u.pm, 1u, RLX_AGENT); }
    }
};
struct EpiLn1 {
    static constexpr bool PERM = true, MID = false, AFTER_DRAIN = true;
    bf16* XN; const float* g1; const float* b1; const bf16* whi; const bf16* wlo; float* RP; unsigned long long* xbuf; unsigned* cst; unsigned* rdy; unsigned* tmo;
    __device__ __forceinline__ void mid(f32x4 (&)[2][2][4][2], const Unit&, int, int, int, int) const {}
    __device__ __forceinline__ void operator()(const f32x4 (&)[2][2][4][2], const Unit&, int, int, int, int) const {}
    __device__ __forceinline__ void fused(f32x4 (&acc)[2][2][4][2], const Unit& u, int wr, int wc, int fr, int fq, PG8_LAS unsigned char* lds, int wid, int lane) const {
        typedef float f32x2v __attribute__((ext_vector_type(2)));
        PG8_LAS f32x2v* Pt = (PG8_LAS f32x2v*)lds;
        PG8_LAS f32x2v* St = (PG8_LAS f32x2v*)(lds + 8192);
        PG8_LAS float* plog = (PG8_LAS float*)(lds + 12288);
        const int row0 = u.pm * BM + wr * 64 + fr, col0 = u.pn * BM + wc * 32 + 8 * fq;
#pragma unroll
        for (int ai = 0; ai < 2; ++ai)
#pragma unroll
            for (int m = 0; m < 4; ++m) { const bf16* xr = XN + (size_t)(row0 + ai * HALF + m * 16) * DM + col0;
#pragma unroll
                for (int bj = 0; bj < 2; ++bj) { const v4u h = __builtin_nontemporal_load((const v4u*)(xr + bj * HALF));
                    acc[ai][bj][m][0] += (f32x4){ALPHA * bf_lo(h.x), ALPHA * bf_hi(h.x), ALPHA * bf_lo(h.y), ALPHA * bf_hi(h.y)};
                    acc[ai][bj][m][1] += (f32x4){ALPHA * bf_lo(h.z), ALPHA * bf_hi(h.z), ALPHA * bf_lo(h.w), ALPHA * bf_hi(h.w)}; }
                if (m & 1) asm volatile("" ::: "memory"); }
#pragma unroll
        for (int ai = 0; ai < 2; ++ai)
#pragma unroll
            for (int m = 0; m < 4; ++m) {
                float sm = 0.f;
#pragma unroll
                for (int bj = 0; bj < 2; ++bj)
#pragma unroll
                    for (int n = 0; n < 2; ++n) { const f32x4 x = acc[ai][bj][m][n]; sm += (x[0] + x[1]) + (x[2] + x[3]); }
                sm += __shfl_xor(sm, 16); sm += __shfl_xor(sm, 32);
                const float mw = sm * (1.0f / 64.0f); float q = 0.f;
#pragma unroll
                for (int bj = 0; bj < 2; ++bj)
#pragma unroll
                    for (int n = 0; n < 2; ++n) { const f32x4 d = acc[ai][bj][m][n] - mw; q += (d[0] * d[0] + d[1] * d[1]) + (d[2] * d[2] + d[3] * d[3]); }
                q += __shfl_xor(q, 16); q += __shfl_xor(q, 32);
                if (fq == 0) Pt[(ai * HALF + wr * 64 + m * 16 + fr) * 4 + wc] = (f32x2v){mw, q};
            }
        asm volatile("s_waitcnt lgkmcnt(0)" ::: "memory"); __builtin_amdgcn_s_barrier(); asm volatile("" ::: "memory");
        const int prow = wid * 32 + (lane & 31);
        if (lane < 32) {
            const f32x2v a = Pt[prow * 4 + 0], b = Pt[prow * 4 + 1], c = Pt[prow * 4 + 2], d = Pt[prow * 4 + 3];
            const float mt = (a.x + b.x + c.x + d.x) * 0.25f;
            const float da = a.x - mt, db = b.x - mt, dc = c.x - mt, dd = d.x - mt;
            const float m2 = (a.y + b.y) + (c.y + d.y) + 64.0f * ((da * da + db * db) + (dc * dc + dd * dd));
            __hip_atomic_store(xbuf + ((size_t)(u.pm * BM + prow) * 8 + u.pn), ((unsigned long long)__float_as_uint(m2) << 32) | __float_as_uint(mt), __ATOMIC_RELAXED, __HIP_MEMORY_SCOPE_AGENT);
        }
        asm volatile("s_waitcnt vmcnt(0)" ::: "memory");
        if (lane == 0) __hip_atomic_fetch_add(cst + 64 * u.pm, 1u, __ATOMIC_RELAXED, __HIP_MEMORY_SCOPE_AGENT);
        if (wid == 0) wait_count(cst + 64 * u.pm, 64u, tmo);
        asm volatile("s_waitcnt vmcnt(0) lgkmcnt(0)" ::: "memory"); __builtin_amdgcn_s_barrier(); asm volatile("" ::: "memory");
        if (lane < 32) {
            const unsigned long long* slot = xbuf + (size_t)(u.pm * BM + prow) * 8; float mt[8], m2[8]; float ms = 0.f;
#pragma unroll
            for (int t = 0; t < 8; ++t) { const unsigned long long w = __hip_atomic_load(slot + t, __ATOMIC_RELAXED, __HIP_MEMORY_SCOPE_AGENT); mt[t] = __uint_as_float((unsigned)w); m2[t] = __uint_as_float((unsigned)(w >> 32)); ms += mt[t]; }
            const float mean = ms * 0.125f; float q = 0.f;
#pragma unroll
            for (int t = 0; t < 8; ++t) { const float dm = mt[t] - mean; q += m2[t] + 256.0f * dm * dm; }
            St[prow] = (f32x2v){mean, 1.0f / sqrtf(q * (1.0f / DM) + LN_EPS)};
        }
        asm volatile("s_waitcnt lgkmcnt(0)" ::: "memory"); __builtin_amdgcn_s_barrier(); asm volatile("" ::: "memory");
#pragma unroll
        for (int bj = 0; bj < 2; ++bj) {
            const f32x4 ga = *(const f32x4*)(g1 + col0 + bj * HALF), gb = *(const f32x4*)(g1 + col0 + bj * HALF + 4), ba = *(const f32x4*)(b1 + col0 + bj * HALF), bb = *(const f32x4*)(b1 + col0 + bj * HALF + 4);
#pragma unroll
            for (int ai = 0; ai < 2; ++ai)
#pragma unroll
                for (int m = 0; m < 4; ++m) { const int r = ai * HALF + wr * 64 + m * 16 + fr; const f32x2v sr = St[r];
                    const f32x4 ha = (acc[ai][bj][m][0] - sr.x) * sr.y * ga + ba, hb = (acc[ai][bj][m][1] - sr.x) * sr.y * gb + bb;
                    acc[ai][bj][m][0] = ha; acc[ai][bj][m][1] = hb;
                    v4u uh; uh.x = cvt_pk_bf16(ha[0], ha[1]); uh.y = cvt_pk_bf16(ha[2], ha[3]); uh.z = cvt_pk_bf16(hb[0], hb[1]); uh.w = cvt_pk_bf16(hb[2], hb[3]);
                    *(v4u*)(XN + (size_t)(u.pm * BM + r) * DM + col0 + bj * HALF) = uh; }
        }
        bf16x8 bh[3][2], bl[3][2];
#pragma unroll
        for (int nb = 0; nb < 3; ++nb)
#pragma unroll
            for (int bj = 0; bj < 2; ++bj) { bh[nb][bj] = *(const bf16x8*)(whi + (size_t)(16 * nb + fr) * DM + col0 + bj * HALF); bl[nb][bj] = *(const bf16x8*)(wlo + (size_t)(16 * nb + fr) * DM + col0 + bj * HALF); }
#pragma unroll
        for (int ai = 0; ai < 2; ++ai) {
#pragma unroll
            for (int m = 0; m < 4; ++m) {
                f32x4 pl[3];
#pragma unroll
                for (int nb = 0; nb < 3; ++nb) pl[nb] = (f32x4){0.f, 0.f, 0.f, 0.f};
#pragma unroll
                for (int bj = 0; bj < 2; ++bj) { const f32x4 ha = acc[ai][bj][m][0], hb = acc[ai][bj][m][1];
                    v4u uh; uh.x = cvt_pk_bf16(ha[0], ha[1]); uh.y = cvt_pk_bf16(ha[2], ha[3]); uh.z = cvt_pk_bf16(hb[0], hb[1]); uh.w = cvt_pk_bf16(hb[2], hb[3]);
                    v4u ul; ul.x = cvt_pk_bf16(ha[0] - bf_lo(uh.x), ha[1] - bf_hi(uh.x)); ul.y = cvt_pk_bf16(ha[2] - bf_lo(uh.y), ha[3] - bf_hi(uh.y));
                    ul.z = cvt_pk_bf16(hb[0] - bf_lo(uh.z), hb[1] - bf_hi(uh.z)); ul.w = cvt_pk_bf16(hb[2] - bf_lo(uh.w), hb[3] - bf_hi(uh.w));
                    const bf16x8 ahi = __builtin_bit_cast(bf16x8, uh), alo = __builtin_bit_cast(bf16x8, ul);
#pragma unroll
                    for (int nb = 0; nb < 3; ++nb) {
                        pl[nb] = __builtin_amdgcn_mfma_f32_16x16x32_bf16(ahi, bh[nb][bj], pl[nb], 0, 0, 0);
                        pl[nb] = __builtin_amdgcn_mfma_f32_16x16x32_bf16(alo, bh[nb][bj], pl[nb], 0, 0, 0);
                        pl[nb] = __builtin_amdgcn_mfma_f32_16x16x32_bf16(ahi, bl[nb][bj], pl[nb], 0, 0, 0);
                    } }
#pragma unroll
                for (int nb = 0; nb < 3; ++nb)
#pragma unroll
                    for (int i = 0; i < 4; ++i) plog[(wc * 128 + wr * 64 + m * 16 + 4 * fq + i) * 48 + 16 * nb + fr] = pl[nb][i];
            }
            asm volatile("s_waitcnt lgkmcnt(0)" ::: "memory"); __builtin_amdgcn_s_barrier(); asm volatile("" ::: "memory");
            const int tid = wid * 64 + lane;
#pragma unroll
            for (int q = 0; q < 3; ++q) { const int o4 = tid + 512 * q; const int rr = o4 / 12, c4 = (o4 - rr * 12) * 4; const int o = rr * 48 + c4;
                const f32x4 t = (*(const PG8_LAS f32x4*)(plog + o) + *(const PG8_LAS f32x4*)(plog + 6144 + o)) + (*(const PG8_LAS f32x4*)(plog + 2 * 6144 + o) + *(const PG8_LAS f32x4*)(plog + 3 * 6144 + o));
                st16_wt(RP + ((size_t)(u.pm * BM + ai * HALF + rr) * 8 + u.pn) * 48 + c4, __builtin_bit_cast(v4u, t)); }
            asm volatile("s_waitcnt lgkmcnt(0)" ::: "memory"); __builtin_amdgcn_s_barrier(); asm volatile("" ::: "memory");
        }
        asm volatile("s_waitcnt vmcnt(0)" ::: "memory"); __builtin_amdgcn_s_barrier(); asm volatile("" ::: "memory");
        if (wid == 0 && lane == 0) __hip_atomic_fetch_add(rdy + 64 * u.pm, 1u, __ATOMIC_RELAXED, __HIP_MEMORY_SCOPE_AGENT);
    }
};
struct EpiAct {
    static constexpr bool PERM = true, MID = false, AFTER_DRAIN = false;
    bf16* act; unsigned* rdy;
    __device__ __forceinline__ void mid(f32x4 (&)[2][2][4][2], const Unit&, int, int, int, int) const {}
    __device__ __forceinline__ void operator()(const f32x4 (&acc)[2][2][4][2], const Unit& u, int wr, int wc, int fr, int fq) const {
        const int row0 = u.pm * BM + wr * 64 + fr, col0 = u.pn * HALF + wc * 32 + 8 * fq;
#pragma unroll
        for (int ai = 0; ai < 2; ++ai)
#pragma unroll
            for (int m = 0; m < 4; ++m) { bf16* rowp = act + (size_t)(row0 + ai * HALF + m * 16) * DE + col0;
                float o[8];
#pragma unroll
                for (int n = 0; n < 2; ++n)
#pragma unroll
                    for (int j = 0; j < 4; ++j) { const float gt = acc[ai][0][m][n][j], up = acc[ai][1][m][n][j]; o[n * 4 + j] = gt * sigm(gt) * up; }
                v4u w; w.x = cvt_pk_bf16(o[0], o[1]); w.y = cvt_pk_bf16(o[2], o[3]); w.z = cvt_pk_bf16(o[4], o[5]); w.w = cvt_pk_bf16(o[6], o[7]);
                if (MK_MOE_MERGE && N_LAUNCHES == 1) st16_wt(rowp, w); else *(v4u*)rowp = w; }
        if (MK_MOE_MERGE && N_LAUNCHES == 1) {
            asm volatile("s_waitcnt vmcnt(0)" ::: "memory");
            if (fr == 0 && fq == 0) __hip_atomic_fetch_add(rdy + 64 * u.pm, 1u, RLX_AGENT);
        }
    }
};
struct EpiDown {
    static constexpr bool PERM = true, MID = false, AFTER_DRAIN = false;
    bf16* Y;
    __device__ __forceinline__ void mid(f32x4 (&)[2][2][4][2], const Unit&, int, int, int, int) const {}
    __device__ __forceinline__ void operator()(const f32x4 (&acc)[2][2][4][2], const Unit& u, int wr, int wc, int fr, int fq) const {
        const int row0 = u.pm * BM + wr * 64 + fr, col0 = u.pn * BM + wc * 32 + 8 * fq;
#pragma unroll
        for (int ai = 0; ai < 2; ++ai)
#pragma unroll
            for (int m = 0; m < 4; ++m) { bf16* rowp = Y + (size_t)(row0 + ai * HALF + m * 16) * DM + col0;
#pragma unroll
                for (int bj = 0; bj < 2; ++bj) { const f32x4 v0 = acc[ai][bj][m][0], v1 = acc[ai][bj][m][1];
                    v4u o; o.x = cvt_pk_bf16(v0[0], v0[1]); o.y = cvt_pk_bf16(v0[2], v0[3]); o.z = cvt_pk_bf16(v1[0], v1[1]); o.w = cvt_pk_bf16(v1[2], v1[3]);
                    *(v4u*)(rowp + bj * HALF) = o; } }
    }
};

struct ConvTile { const float* src; bf16* dst0; bf16* dst1; int ld_src, ld_dst; };
constexpr int CT_A = CT_IN;
constexpr int CT_B = 3 * CT_SQ + 2 * CT_GU + CT_DN;
constexpr int CT_PITCH = 144, CT_BUF = 256 * CT_PITCH;
__device__ __forceinline__ ConvTile conv_tile_a(int r, unsigned char* ws) {
    const int nt = r >> 5, kg = r & 31, ns = nt * 256, k0 = 64 * kg;
    int nn = ns; if (ns >= 2048 && ns < 2560) nn = ns + 2048; else if (ns >= 2560 && ns < 4608) nn = ns - 512;
    bf16* d = (bf16*)(ws + WS_WIN) + (size_t)nn * DM + k0; bf16* d1 = d + (size_t)128 * DM;
    if (ns >= PC_CC && ns < PC_GA) {
        const int ch = ns >= PC_CH ? 1 : 0, sidx = (ns - (ch ? PC_CH : PC_CC)) >> 8;
        d = (bf16*)(ws + WS_WIN) + (size_t)(256 * (18 + 2 * sidx) + 128 * ch) * DM + k0; d1 = d + (size_t)256 * DM; }
    if (ns >= PC_GA) {
        const int gq = ns >= PC_GC ? 1 : 0, sidx = (ns - (gq ? PC_GC : PC_GA)) >> 8;
        d = (bf16*)(ws + WS_WIN) + (size_t)(256 * (34 + 2 * sidx) + 128 * gq) * DM + k0; d1 = d + (size_t)256 * DM; }
    return ConvTile{arg_in(4) + (size_t)k0 * LDP + ns, d, d1, LDP, DM};
}
__device__ __forceinline__ ConvTile conv_tile_b(int r, unsigned char* ws) {
    bf16* Wb2_t = (bf16*)(ws + WS_WB2); bf16* Wout_t = (bf16*)(ws + WS_WOUT); bf16* Wgu_t = (bf16*)(ws + WS_WGU); bf16* Wd_t = (bf16*)(ws + WS_WD);
    if (r < 2 * CT_SQ) { const int cv = r >= CT_SQ ? 1 : 0; r -= cv * CT_SQ; const int nt = r >> 5, k0 = 64 * (r & 31), n = nt * 256;
        bf16* d = Wb2_t + (size_t)n * 4096 + cv * 2048 + k0; return ConvTile{arg_in(7 + cv) + (size_t)k0 * DM + n, d, d + (size_t)128 * 4096, DM, 4096}; }
    r -= 2 * CT_SQ;
    if (r < CT_SQ) { const int nt = r >> 5, k0 = 64 * (r & 31), n = nt * 256; bf16* d = Wout_t + (size_t)n * DM + k0; return ConvTile{arg_in(9) + (size_t)k0 * DM + n, d, d + (size_t)128 * DM, DM, DM}; }
    r -= CT_SQ;
    if (r < 2 * CT_GU) { const int up = r >= CT_GU ? 1 : 0; r -= up * CT_GU; const int e = r >> 6, q = r & 63, nt = q >> 5, k0 = 64 * (q & 31), n = nt * 256;
        bf16* d = Wgu_t + ((size_t)e * 1024 + (size_t)(n >> 7) * 256 + up * 128) * DM + k0;
        return ConvTile{arg_in(16 + up) + (size_t)e * DM * DE + (size_t)k0 * DE + n, d, d + (size_t)256 * DM, DE, DM}; }
    r -= 2 * CT_GU;
    { const int e = r >> 6, q = r & 63, nt = q >> 3, k0 = 64 * (q & 7), n = nt * 256;
      bf16* d = Wd_t + ((size_t)e * DM + n) * DE + k0; return ConvTile{arg_in(18) + (size_t)e * DE * DM + (size_t)k0 * DM + n, d, d + (size_t)128 * DE, DM, DE}; }
}
struct ConvRegs { f32x4 v[8]; };
__device__ __forceinline__ void conv_load(ConvRegs& R, const ConvTile& t, int w, int lane) {
    const float* p = t.src + (size_t)(8 * w) * t.ld_src + 4 * lane;
#pragma unroll
    for (int i = 0; i < 8; ++i) R.v[i] = __builtin_nontemporal_load((const f32x4*)(p + (size_t)i * t.ld_src));
}
__device__ __forceinline__ void conv_lds_write(const ConvRegs& R, LAS unsigned char* buf, int w, int lane) {
#pragma unroll
    for (int j = 0; j < 4; ++j) { v4u o; o.x = cvt_pk_bf16(R.v[0][j], R.v[1][j]); o.y = cvt_pk_bf16(R.v[2][j], R.v[3][j]); o.z = cvt_pk_bf16(R.v[4][j], R.v[5][j]); o.w = cvt_pk_bf16(R.v[6][j], R.v[7][j]);
        *(LAS v4u*)(buf + (4 * lane + j) * CT_PITCH + 16 * w) = o; }
}
template <bool WT>
__device__ __forceinline__ void conv_store(const ConvTile& t, LAS const unsigned char* buf, int w, int lane) {
    const int c = lane & 7, nr = 8 * w + (lane >> 3);
#pragma unroll
    for (int p = 0; p < 4; ++p) { const int n = nr + 64 * p; const v4u o = *(LAS const v4u*)(buf + n * CT_PITCH + 16 * c);
        bf16* d = (p < 2 ? t.dst0 + (size_t)n * t.ld_dst : t.dst1 + (size_t)(n - 128) * t.ld_dst) + 8 * c;
        if (WT) st16_wt(d, o); else *(GAS v4u*)d = o; }
}
template <int LIST, bool WT = false>
__device__ __forceinline__ void conv_run(int first, int last, int stride, unsigned char* ws, LAS unsigned char* lds, int w, int lane, int& par) {
    if (first >= last) return;
    ConvTile t0 = LIST ? conv_tile_b(first, ws) : conv_tile_a(first, ws), t1 = t0;
    ConvRegs r0, r1;
    conv_load(r0, t0, w, lane);
    r1 = r0;
    for (int it = first; it < last; it += stride) {
        const int nx = it + stride;
        if (nx < last) { t1 = LIST ? conv_tile_b(nx, ws) : conv_tile_a(nx, ws); conv_load(r1, t1, w, lane); }
        LAS unsigned char* buf = lds + par * CT_BUF; par ^= 1;
        conv_lds_write(r0, buf, w, lane);
        __syncthreads();
        conv_store<WT>(t0, buf, w, lane);
        r0 = r1; t0 = t1;
    }
}
constexpr int CT_CHUNK = 4;
constexpr int CT_B1 = 3 * CT_SQ + 2 * CT_GU;
template <bool WT = false>
__device__ __forceinline__ void conv_queue(unsigned* qhead, int lo, int hi, unsigned char* ws, LAS unsigned char* lds, volatile LAS unsigned* slot, int w, int lane, unsigned* done = nullptr) {
    int par = 0;
    for (;;) {
        __syncthreads();
        if (w == 0 && lane == 0) slot[0] = __hip_atomic_fetch_add(qhead, (unsigned)CT_CHUNK, RLX_AGENT);
        __syncthreads();
        const int base = lo + __builtin_amdgcn_readfirstlane((int)slot[0]);
        if (base >= hi) break;
        const int end = base + CT_CHUNK < hi ? base + CT_CHUNK : hi;
        conv_run<1, WT>(base, end, 1, ws, lds, w, lane, par);
        if (WT) {
            asm volatile("s_waitcnt vmcnt(0)" ::: "memory");
            __syncthreads();
            if (w == 0 && lane == 0) __hip_atomic_fetch_add(done, (unsigned)(end - base), RLX_AGENT);
        }
    }
}
__device__ __forceinline__ void ln_regs_to_bf16(f32x4 (&v)[8], const f32x4 (&gq)[8], const f32x4 (&bq)[8], bf16* orow, int lane) {
    asm volatile("" : "+v"(lane));
    float s = 0.f;
#pragma unroll
    for (int j = 0; j < 8; ++j) s += (v[j][0] + v[j][1]) + (v[j][2] + v[j][3]);
    const float mean = wave_sum(s) * (1.f / DM); float s2 = 0.f;
#pragma unroll
    for (int j = 0; j < 8; ++j) { v[j] = v[j] - mean; s2 += (v[j][0] * v[j][0] + v[j][1] * v[j][1]) + (v[j][2] * v[j][2] + v[j][3] * v[j][3]); }
    const float rstd = 1.f / sqrtf(wave_sum(s2) * (1.f / DM) + LN_EPS);
    v2u* o8 = (v2u*)orow + lane;
#pragma unroll
    for (int j = 0; j < 8; ++j) { const f32x4 y = v[j] * rstd * gq[j] + bq[j];
        v2u w; w.x = pk2(y[0], y[1]); w.y = pk2(y[2], y[3]); o8[64 * j] = w; }
}
__device__ __forceinline__ void ln_row_to_bf16(const float* xrow, const float* g, const float* b, bf16* orow, int lane) {
    asm volatile("" : "+v"(lane));
    const f32x4* xr = (const f32x4*)xrow + lane;
    f32x4 v[8]; float s = 0.f;
#pragma unroll
    for (int j = 0; j < 8; ++j) { v[j] = xr[64 * j]; s += (v[j][0] + v[j][1]) + (v[j][2] + v[j][3]); }
    const float mean = wave_sum(s) * (1.f / DM); float s2 = 0.f;
#pragma unroll
    for (int j = 0; j < 8; ++j) { v[j] = v[j] - mean; s2 += (v[j][0] * v[j][0] + v[j][1] * v[j][1]) + (v[j][2] * v[j][2] + v[j][3] * v[j][3]); }
    const float rstd = 1.f / sqrtf(wave_sum(s2) * (1.f / DM) + LN_EPS);
    v2u* o8 = (v2u*)orow + lane;
#pragma unroll
    for (int j = 0; j < 8; ++j) { const f32x4 gg = ((const f32x4*)g)[lane + 64 * j], bb = ((const f32x4*)b)[lane + 64 * j]; const f32x4 y = v[j] * rstd * gg + bb;
        v2u w; w.x = pk2(y[0], y[1]); w.y = pk2(y[2], y[3]); o8[64 * j] = w; }
}
__device__ __forceinline__ void p0_prologue(Frame& F, const Args& A) {
    const int lane0 = lane_id(), tid0 = F.wave * 64 + lane0;
    const int gw = F.vcu * NWAVES + F.wave, NGW = F.G * NWAVES;
    bf16* XN = (bf16*)(F.ws + WS_XN);
    { int par = 0; conv_run<0>((int)blockIdx.x, CT_A, F.G, F.ws, F.lds + RING_OFF, F.wave, lane0, par); __syncthreads(); }
    {
        const float* xin = arg_in(0); const float* g = arg_in(2); const float* b = arg_in(3);
        f32x4 va[8], vb[8], gq[8], bq[8];
#pragma unroll
        for (int j = 0; j < 8; ++j) { gq[j] = ((const f32x4*)g)[lane0 + 64 * j]; bq[j] = ((const f32x4*)b)[lane0 + 64 * j]; }
        int m = gw;
        if (m < MREAL) {
#pragma unroll
            for (int j = 0; j < 8; ++j) va[j] = __builtin_nontemporal_load((const f32x4*)(xin + (size_t)m * DM) + lane0 + 64 * j);
        }
        const int mx = MREAL + gw; const bool hasmeta = mx < MREAL + NMETA;
        f32x4 vc[8];
        if (hasmeta) {
#pragma unroll
            for (int j = 0; j < 8; ++j) vc[j] = ((const f32x4*)(arg_in(1) + (size_t)(mx - MREAL) * DM))[lane0 + 64 * j];
        }
    { bf16* whi = (bf16*)(F.ws + WS_REWG); bf16* wlo = whi + 48 * DM; const float* rgw = arg_in(12); const float* rew = arg_in(14);
      for (int i = (F.vcu * NWAVES * 64) + tid0; i < 48 * DM; i += F.G * NWAVES * 64) { const int n = i / DM, k = i % DM;
          const float w = n < NGRP ? rgw[k * NGRP + n] : (n < NGRP + NEXP ? rew[k * NEXP + (n - NGRP)] : 0.f);
          const unsigned hi = f2bf(w); const float rem = w - __builtin_bit_cast(float, hi << 16);
          whi[i] = (bf16)hi; wlo[i] = (bf16)f2bf(rem); } }
        for (; m < MREAL; m += 2 * NGW) {
            const int m1 = m + NGW, m2 = m + 2 * NGW;
            if (m1 < MREAL) {
#pragma unroll
                for (int j = 0; j < 8; ++j) vb[j] = __builtin_nontemporal_load((const f32x4*)(xin + (size_t)m1 * DM) + lane0 + 64 * j);
            }
            ln_regs_to_bf16(va, gq, bq, XN + (size_t)m * DM, lane0);
            if (m2 < MREAL) {
#pragma unroll
                for (int j = 0; j < 8; ++j) va[j] = __builtin_nontemporal_load((const f32x4*)(xin + (size_t)m2 * DM) + lane0 + 64 * j);
            }
            if (m1 < MREAL) ln_regs_to_bf16(vb, gq, bq, XN + (size_t)m1 * DM, lane0);
        }
        if (hasmeta) ln_regs_to_bf16(vc, gq, bq, XN + (size_t)mx * DM, lane0);
    }
    for (int m = MREAL + gw; m < MPAD; m += NGW) {
        if (m < MREAL + NMETA) { if (m != MREAL + gw) ln_row_to_bf16(arg_in(1) + (size_t)(m - MREAL) * DM, arg_in(2), arg_in(3), XN + (size_t)m * DM, lane0); }
        else { v2u* o8 = (v2u*)(XN + (size_t)m * DM) + lane0;
#pragma unroll
            for (int j = 0; j < 8; ++j) o8[64 * j] = (v2u){0u, 0u}; }
    }
}

constexpr int KS_PITCH = 144;
constexpr int VT_PITCH = 584;
constexpr int KROWS = 288;
constexpr int ATT_KS = 0, ATT_VT = KROWS * KS_PITCH, ATT_LDS = ATT_VT + 64 * VT_PITCH;
static_assert(ATT_LDS <= RING_BYTES, "attention LDS");
constexpr float LOG2E = 1.4426950408889634f;

template <int R>
__device__ __forceinline__ void attn_qload(bf16x8 (&qf)[4], const bf16* P, int qrow0, int head, int lane) {
    asm volatile("" : "+v"(lane));
    const int ql = lane & 31, hh = lane >> 5;
    const bf16* qp = P + (size_t)(qrow0 + 32 * R + ql) * LDP + PC_Q + head * HD;
#pragma unroll
    for (int s = 0; s < 4; ++s) qf[s] = *(const bf16x8*)(qp + 16 * s + 8 * hh);
}
template <int R>
__device__ __forceinline__ void attn_qblock(const bf16x8 (&qf)[4], LAS const unsigned char* lds, bf16* P, int qrow0, int head, float sink_l2, bool has_prev, int lane) {
    asm volatile("" : "+v"(lane));
    const int ql = lane & 31, hh = lane >> 5;
    f32x16 S[6];
#define KB_ROW(i) ((i) == 0 ? 0 : ((i) <= 4 - R ? 32 + 32 * (R + (i) - 1) : 160 + 32 * ((i) - (5 - R))))
#pragma unroll
    for (int i = 0; i < 6; ++i) {
        const int kr = KB_ROW(i);
        f32x16 a = {0.f, 0.f, 0.f, 0.f, 0.f, 0.f, 0.f, 0.f, 0.f, 0.f, 0.f, 0.f, 0.f, 0.f, 0.f, 0.f};
        const LAS unsigned char* kp = lds + ATT_KS + (kr + ql) * KS_PITCH + 16 * hh;
#pragma unroll
        for (int s = 0; s < 4; ++s) { const bf16x8 kf = *(const LAS bf16x8*)(kp + 32 * s); a = __builtin_amdgcn_mfma_f32_32x32x16_bf16(kf, qf[s], a, 0, 0, 0); }
        S[i] = a;
    }
    const float NEG = -INFINITY; const float sc = 0.125f * LOG2E;
    float mxr = NEG;
#pragma unroll
    for (int i = 0; i < 6; ++i)
#pragma unroll
        for (int r = 0; r < 16; ++r) {
            if (i == 0 && r >= 8) continue;
            const int kvl = (r & 3) + 8 * (r >> 2) + 4 * hh;
            float t = S[i][r];
            if (i >= 1 && i <= 4 - R) { bool ok = has_prev; if (i == 1) ok = ok && (kvl > ql); t = ok ? t : NEG; }
            else if (i == 5) t = (kvl <= ql) ? t : NEG;
            S[i][r] = t; mxr = fmaxf(mxr, t);
        }
    float mx = fmaxf(mxr * sc, sink_l2);
    mx = fmaxf(mx, __shfl_xor(mx, 32));
    typedef float f32x2s __attribute__((ext_vector_type(2)));
    f32x2s l2 = {0.f, 0.f};
#pragma unroll
    for (int i = 0; i < 6; ++i) {
        f32x16 a = S[i] * sc - mx;
#pragma unroll
        for (int r = 0; r < 16; ++r) a[r] = (i == 0 && r >= 8) ? 0.f : __builtin_amdgcn_exp2f(a[r]);
#pragma unroll
        for (int k = 0; k < (i == 0 ? 4 : 8); ++k) l2 += (f32x2s){a[2 * k], a[2 * k + 1]};
        S[i] = a;
    }
    float l = l2[0] + l2[1];
    l += __shfl_xor(l, 32);
    l += __builtin_amdgcn_exp2f(sink_l2 - mx);
    const float inv = 1.0f / l;
#pragma unroll
    for (int i = 0; i < 6; ++i) S[i] = S[i] * inv;
    f32x16 O[2];
#pragma unroll
    for (int d = 0; d < 2; ++d) O[d] = (f32x16){0.f, 0.f, 0.f, 0.f, 0.f, 0.f, 0.f, 0.f, 0.f, 0.f, 0.f, 0.f, 0.f, 0.f, 0.f, 0.f};
#pragma unroll
    for (int i = 0; i < 6; ++i) {
        const int kr = KB_ROW(i);
#pragma unroll
        for (int s2 = 0; s2 < 2; ++s2) {
            if (i == 0 && s2 == 1) continue;
            unsigned pw[4];
#pragma unroll
            for (int j = 0; j < 4; ++j) pw[j] = cvt_pk_bf16(S[i][8 * s2 + 2 * j], S[i][8 * s2 + 2 * j + 1]);
            const v4u pv = {pw[0], pw[1], pw[2], pw[3]};
            const bf16x8 pf = __builtin_bit_cast(bf16x8, pv);
#pragma unroll
            for (int d = 0; d < 2; ++d) {
                const LAS unsigned char* vp = lds + ATT_VT + (ql + 32 * d) * VT_PITCH + (kr + 16 * s2 + 4 * hh) * 2;
                const v2u lo = *(const LAS v2u*)vp, hi = *(const LAS v2u*)(vp + 16);
                const v4u vv = {lo.x, lo.y, hi.x, hi.y};
                O[d] = __builtin_amdgcn_mfma_f32_32x32x16_bf16(pf, __builtin_bit_cast(bf16x8, vv), O[d], 0, 0, 0);
            }
        }
    }
#undef KB_ROW
#pragma unroll
    for (int d = 0; d < 2; ++d)
#pragma unroll
        for (int r = 0; r < 16; ++r) { const int q = (r & 3) + 8 * (r >> 2) + 4 * hh;
            st2_wt(P + (size_t)(qrow0 + 32 * R + q) * LDP + PC_Q + head * HD + 32 * d + ql, f2bf(O[d][r])); }
}

__device__ __forceinline__ f32x4 conv_p(v2u a) { return (f32x4){bf_lo(a.x), bf_hi(a.x), bf_lo(a.y), bf_hi(a.y)}; }
__device__ __forceinline__ void p2_attention_conv(Frame& F, const Args& A) {
    bf16* P = (bf16*)(F.ws + WS_P);
    const float* sinks = arg_in(5);
    const float* cw = arg_in(6);
    const int lane0 = lane_id(), tid0 = F.wave * 64 + lane0;
    const int c0 = 4 * tid0;
    for (int it = F.vcu; it < BATCH * NKVH * (SEQ / WIN); it += F.G) {
        const int b = it / (NKVH * 16), kvh = (it / 16) % NKVH, nb = it % 16;
        const int row_own = b * SEQ + nb * WIN, row_prev = row_own - WIN;
        const int r0 = it * 32, s0 = r0 % SEQ;
        const int rm2 = (s0 == 0) ? MREAL + NMETA - 2 : r0 - 2, rm1 = (s0 == 0) ? MREAL + NMETA - 1 : r0 - 1;
        const v2u a2 = *(const v2u*)(P + (size_t)rm2 * LDP + PC_CC + c0);
        const v2u a1 = *(const v2u*)(P + (size_t)rm1 * LDP + PC_CC + c0);
        __syncthreads();
        v4u kq[5], vq[5];
#pragma unroll
        for (int i = 0; i < 5; ++i) { const int q = tid0 + i * (NWAVES * 64); const int row = q >> 3, c = q & 7;
            int grow = -1;
            if (row < NMETA) grow = MREAL + row;
            else if (row >= 32 && row < 160) { if (nb > 0) grow = row_prev + (row - 32); }
            else if (row >= 160 && row < KROWS) grow = row_own + (row - 160);
            kq[i] = (v4u){0u, 0u, 0u, 0u}; vq[i] = (v4u){0u, 0u, 0u, 0u};
            if (grow >= 0) { const bf16* rp = P + (size_t)grow * LDP; kq[i] = *(const v4u*)(rp + PC_K + kvh * HD + 8 * c); vq[i] = *(const v4u*)(rp + PC_V + kvh * HD + 8 * c); } }
#pragma unroll
        for (int i = 0; i < 5; ++i) { const int q = tid0 + i * (NWAVES * 64); const int row = q >> 3, c = q & 7;
            if (q < KROWS * 8) {
                *(LAS v4u*)(F.lds + ATT_KS + row * KS_PITCH + c * 16) = kq[i];
                const unsigned vw[4] = {vq[i].x, vq[i].y, vq[i].z, vq[i].w};
#pragma unroll
                for (int e = 0; e < 4; ++e) {
                    *(LAS unsigned short*)(F.lds + ATT_VT + (8 * c + 2 * e) * VT_PITCH + row * 2) = (unsigned short)(vw[e] & 0xffffu);
                    *(LAS unsigned short*)(F.lds + ATT_VT + (8 * c + 2 * e + 1) * VT_PITCH + row * 2) = (unsigned short)(vw[e] >> 16);
                } } }
        __syncthreads();
        const int head = kvh * 8 + F.wave;
        const float sink_l2 = sinks[head] * LOG2E;
        v2u pr2 = a2, pr1 = a1;
        const unsigned voff0 = (unsigned)c0 * 2u;
#define P2_STEP(R) do { \
            unsigned voff = voff0; asm volatile("" : "+v"(voff)); \
            v2u ca[8], cbb[8]; \
            _Pragma("unroll") for (int i = 0; i < 8; ++i) { const char* rp = (const char*)(P + (size_t)(r0 + 8 * (R) + i) * LDP);     \
                ca[i] = *(const v2u*)(rp + PC_CC * 2 + voff); cbb[i] = *(const v2u*)(rp + PC_CB * 2 + voff); } \
            bf16x8 qn[4]; if ((R) < 3) attn_qload<((R) < 3 ? (R) + 1 : 3)>(qn, P, row_own, head, lane0); else { qn[0] = qc[0]; qn[1] = qc[1]; qn[2] = qc[2]; qn[3] = qc[3]; } \
            asm volatile("" ::: "memory"); \
            attn_qblock<R>(qc, (LAS const unsigned char*)F.lds, P, row_own, head, sink_l2, nb > 0, lane0); \
            asm volatile("" ::: "memory"); \
            qc[0] = qn[0]; qc[1] = qn[1]; qc[2] = qn[2]; qc[3] = qn[3]; \
            const f32x4 w0 = *(const f32x4*)((const char*)cw + 2 * voff), w1 = *(const f32x4*)((const char*)(cw + DM) + 2 * voff), w2 = *(const f32x4*)((const char*)(cw + 2 * DM) + 2 * voff);     \
            _Pragma("unroll") for (int i = 0; i < 8; ++i) { char* rp = (char*)(P + (size_t)(r0 + 8 * (R) + i) * LDP); \
                const f32x4 p = conv_p(ca[i]); const f32x4 cbv = {bf_lo(cbb[i].x), bf_hi(cbb[i].x), bf_lo(cbb[i].y), bf_hi(cbb[i].y)}; \
                const f32x4 uu = cbv * (w0 * conv_p(pr2) + w1 * conv_p(pr1) + w2 * p); \
                v2u o; o.x = pk2(uu[0], uu[1]); o.y = pk2(uu[2], uu[3]); st8_wt(rp + PC_CB * 2 + voff, o); pr2 = pr1; pr1 = ca[i]; } } while (0)
        bf16x8 qc[4]; attn_qload<0>(qc, P, row_own, head, lane0);
        P2_STEP(0); P2_STEP(1); P2_STEP(2); P2_STEP(3);
        if (MK_SEAM23 && N_LAUNCHES == 1 && MK_DUP == 0) {
            asm volatile("s_waitcnt vmcnt(0)" ::: "memory"); __syncthreads();
            if (F.wave == 0 && lane0 == 0) {
                __hip_atomic_fetch_add(F.ctl + CW_P2 + 64 * (b * 8 + (nb >> 1)), 1u, RLX_AGENT); __hip_atomic_fetch_add(F.ctl + CW_P2 + 64 * (it >> 3), 1u, RLX_AGENT); }
        }
    }
}

#undef P2_STEP
__device__ __forceinline__ void p5_ln1_router(Frame& F, const Args& A) {
    const int lane = lane_id(), w = F.wave, tid = w * 64 + lane;
    const int rl = lane & 15, kq = lane >> 4;
    bf16* P = (bf16*)(F.ws + WS_P); bf16* XN = (bf16*)(F.ws + WS_XN);
    const float* g1 = arg_in(10); const float* b1 = arg_in(11);
    const float* rgb = arg_in(13); const float* reb = arg_in(15);
    const bf16* whi = (const bf16*)(F.ws + WS_REWG); const bf16* wlo = whi + 48 * DM;
    int* rowidx = (int*)(F.ws + WS_ROWIDX); float* tokw = (float*)(F.ws + WS_TOKW); int* slot = (int*)(F.ws + WS_SLOT);
    unsigned* cnt = (unsigned*)(F.ctl + CW_CNT);
    LAS float* red = (LAS float*)(F.lds + RING_OFF);
    LAS float* plog = (LAS float*)(F.lds + RING_OFF + 4096);
    LAS float* flog = (LAS float*)(F.lds + RING_OFF + 4096 + 49152);
    LAS float* bias = (LAS float*)(F.lds + RING_OFF + 4096 + 49152 + 6144);
    if (tid < NGRP + NEXP) bias[tid] = tid < NGRP ? rgb[tid] : reb[tid - NGRP];
    __syncthreads();
    const int kbase0 = 256 * w + 8 * kq, rl0 = rl;
    for (int rg = F.vcu; rg < MREAL / 32; rg += F.G) {
        if (MK_SEAM34 && N_LAUNCHES == 1 && MK_DUP == 0) { if (w == 0) wait_count((unsigned*)(F.ctl + CW_P4) + 64 * (rg >> 3), 64u, (unsigned*)(F.ctl + CW_TMO)); __syncthreads(); }
        int kbase = kbase0, rl = rl0; asm volatile("" : "+v"(kbase), "+v"(rl));
        f32x4 x[2][8][2];
#pragma unroll
        for (int hq = 0; hq < 2; ++hq) { const bf16* xp = P + (size_t)(rg * 32 + 16 * hq + rl) * LDP + PC_GA + kbase;
#pragma unroll
            for (int s = 0; s < 8; ++s) { const v4u q = *(const v4u*)(xp + 32 * s);
                x[hq][s][0] = (f32x4){bf_lo(q.x), bf_hi(q.x), bf_lo(q.y), bf_hi(q.y)}; x[hq][s][1] = (f32x4){bf_lo(q.z), bf_hi(q.z), bf_lo(q.w), bf_hi(q.w)}; } }
#pragma unroll
        for (int hq = 0; hq < 2; ++hq) { float sm = 0.f;
#pragma unroll
            for (int s = 0; s < 8; ++s) sm += ((x[hq][s][0][0] + x[hq][s][0][1]) + (x[hq][s][0][2] + x[hq][s][0][3])) + ((x[hq][s][1][0] + x[hq][s][1][1]) + (x[hq][s][1][2] + x[hq][s][1][3]));
            sm += __shfl_xor(sm, 16); sm += __shfl_xor(sm, 32);
            if (kq == 0) red[w * 32 + 16 * hq + rl] = sm; }
        __syncthreads();
        float rstd[2];
#pragma unroll
        for (int hq = 0; hq < 2; ++hq) { float tot = 0.f;
#pragma unroll
            for (int j = 0; j < 8; ++j) tot += red[j * 32 + 16 * hq + rl];
            const float mean = tot * (1.f / DM); float sq = 0.f;
#pragma unroll
            for (int s = 0; s < 8; ++s)
#pragma unroll
                for (int h = 0; h < 2; ++h) { x[hq][s][h] = x[hq][s][h] - mean; sq += (x[hq][s][h][0] * x[hq][s][h][0] + x[hq][s][h][1] * x[hq][s][h][1]) + (x[hq][s][h][2] * x[hq][s][h][2] + x[hq][s][h][3] * x[hq][s][h][3]); }
            sq += __shfl_xor(sq, 16); sq += __shfl_xor(sq, 32);
            if (kq == 0) red[256 + w * 32 + 16 * hq + rl] = sq; }
        __syncthreads();
#pragma unroll
        for (int hq = 0; hq < 2; ++hq) { float tq = 0.f;
#pragma unroll
            for (int j = 0; j < 8; ++j) tq += red[256 + j * 32 + 16 * hq + rl];
            rstd[hq] = 1.f / sqrtf(tq * (1.f / DM) + LN_EPS); }
        f32x4 acc[2][3];
#pragma unroll
        for (int hq = 0; hq < 2; ++hq)
#pragma unroll
            for (int nb = 0; nb < 3; ++nb) acc[hq][nb] = (f32x4){0.f, 0.f, 0.f, 0.f};
#pragma unroll
        for (int s = 0; s < 8; ++s) {
            const int k0 = kbase + 32 * s;
            const f32x4 ga = *(const f32x4*)(g1 + k0), gb = *(const f32x4*)(g1 + k0 + 4), ba = *(const f32x4*)(b1 + k0), bb = *(const f32x4*)(b1 + k0 + 4);
            bf16x8 bh[3], bl[3];
#pragma unroll
            for (int nb = 0; nb < 3; ++nb) { bh[nb] = *(const bf16x8*)(whi + (size_t)(16 * nb + rl) * DM + k0); bl[nb] = *(const bf16x8*)(wlo + (size_t)(16 * nb + rl) * DM + k0); }
#pragma unroll
            for (int hq = 0; hq < 2; ++hq) {
                const f32x4 ha = x[hq][s][0] * rstd[hq] * ga + ba, hb = x[hq][s][1] * rstd[hq] * gb + bb;
                v4u uh; uh.x = cvt_pk_bf16(ha[0], ha[1]); uh.y = cvt_pk_bf16(ha[2], ha[3]); uh.z = cvt_pk_bf16(hb[0], hb[1]); uh.w = cvt_pk_bf16(hb[2], hb[3]);
                *(v4u*)(XN + (size_t)(rg * 32 + 16 * hq + rl) * DM + k0) = uh;
                v4u ul; ul.x = cvt_pk_bf16(ha[0] - bf_lo(uh.x), ha[1] - bf_hi(uh.x)); ul.y = cvt_pk_bf16(ha[2] - bf_lo(uh.y), ha[3] - bf_hi(uh.y));
                ul.z = cvt_pk_bf16(hb[0] - bf_lo(uh.z), hb[1] - bf_hi(uh.z)); ul.w = cvt_pk_bf16(hb[2] - bf_lo(uh.w), hb[3] - bf_hi(uh.w));
                const bf16x8 ahi = __builtin_bit_cast(bf16x8, uh), alo = __builtin_bit_cast(bf16x8, ul);
#pragma unroll
                for (int nb = 0; nb < 3; ++nb) {
                    acc[hq][nb] = __builtin_amdgcn_mfma_f32_16x16x32_bf16(ahi, bh[nb], acc[hq][nb], 0, 0, 0);
                    acc[hq][nb] = __builtin_amdgcn_mfma_f32_16x16x32_bf16(alo, bh[nb], acc[hq][nb], 0, 0, 0);
                    acc[hq][nb] = __builtin_amdgcn_mfma_f32_16x16x32_bf16(ahi, bl[nb], acc[hq][nb], 0, 0, 0);
                }
            }
            asm volatile("" ::: "memory");
        }
#pragma unroll
        for (int hq = 0; hq < 2; ++hq)
#pragma unroll
            for (int nb = 0; nb < 3; ++nb)
#pragma unroll
                for (int i = 0; i < 4; ++i) plog[(w * 32 + 16 * hq + 4 * kq + i) * 48 + 16 * nb + rl] = acc[hq][nb][i];
        __syncthreads();
        for (int o = tid; o < 32 * 48; o += NWAVES * 64) { float t = 0.f;
#pragma unroll
            for (int j = 0; j < 8; ++j) t += plog[j * 1536 + o];
            flog[o] = t; }
        __syncthreads();
        if (tid < 32) {
            const LAS float* fl = flog + tid * 48; const int m = rg * 32 + tid;
            float gl[4];
#pragma unroll
            for (int c = 0; c < 4; ++c) gl[c] = fl[c] + bias[c];
            int gsel = 0; float gmax = gl[0];
#pragma unroll
            for (int c = 1; c < 4; ++c) if (gl[c] > gmax) { gmax = gl[c]; gsel = c; }
            float gden = 0.f;
#pragma unroll
            for (int c = 0; c < 4; ++c) gden += __expf(gl[c] - gmax);
            const float pgroup = 1.0f / gden;
            float el[8];
#pragma unroll
            for (int c = 0; c < 8; ++c) el[c] = fl[4 + gsel * EPG + c] + bias[NGRP + gsel * EPG + c];
            int i0 = 0; float l0 = el[0];
#pragma unroll
            for (int c = 1; c < 8; ++c) if (el[c] > l0) { l0 = el[c]; i0 = c; }
            int i1 = -1; float l1 = -INFINITY;
#pragma unroll
            for (int c = 0; c < 8; ++c) if (c != i0 && el[c] > l1) { l1 = el[c]; i1 = c; }
            const float e10 = __expf(l1 - l0);
            const float w0 = pgroup / (1.0f + e10), w1 = pgroup * e10 / (1.0f + e10);
            const int e0 = gsel * EPG + i0, e1 = gsel * EPG + i1;
            const unsigned p0 = __hip_atomic_fetch_add(cnt + 64 * e0, 1u, RLX_AGENT), p1 = __hip_atomic_fetch_add(cnt + 64 * e1, 1u, RLX_AGENT);
            rowidx[e0 * MREAL + p0] = m * 2; rowidx[e1 * MREAL + p1] = m * 2 + 1;
            tokw[m * 2] = w0; tokw[m * 2 + 1] = w1;
            slot[m * 2] = (e0 << 16) | (int)p0; slot[m * 2 + 1] = (e1 << 16) | (int)p1;
        }
    }
}

__device__ __forceinline__ void p5_router_final(Frame& F, const Args& A) {
    const int lane = lane_id(), w = F.wave, tid = w * 64 + lane;
    const float* rgb = arg_in(13); const float* reb = arg_in(15);
    const float* RP = (const float*)(F.ws + WS_RP);
    int* rowidx = (int*)(F.ws + WS_ROWIDX); float* tokw = (float*)(F.ws + WS_TOKW); int* slot = (int*)(F.ws + WS_SLOT);
    unsigned* cnt = (unsigned*)(F.ctl + CW_CNT);
    LAS float* flog = (LAS float*)(F.lds + RING_OFF);
    LAS float* bias = (LAS float*)(F.lds + RING_OFF + 8192);
    if (tid < NGRP + NEXP) bias[tid] = tid < NGRP ? rgb[tid] : reb[tid - NGRP];
    for (int rg = F.vcu; rg < MREAL / 32; rg += F.G) {
        __syncthreads();
        if (w == 0) wait_count((unsigned*)(F.ctl + CW_P4) + 64 * (rg >> 3), 8u, (unsigned*)(F.ctl + CW_TMO));
        __syncthreads();
#pragma unroll
        for (int q = 0; q < 3; ++q) { const int o = tid + 512 * q; const int rr = o / 48, cc = o - rr * 48; const float* p = RP + (size_t)(rg * 32 + rr) * 8 * 48 + cc;
            float t = 0.f;
#pragma unroll
            for (int j = 0; j < 8; ++j) t += p[j * 48];
            flog[o] = t; }
        __syncthreads();
        if (tid < 32) {
            const LAS float* fl = flog + tid * 48; const int m = rg * 32 + tid;
            float gl[4];
#pragma unroll
            for (int c = 0; c < 4; ++c) gl[c] = fl[c] + bias[c];
            int gsel = 0; float gmax = gl[0];
#pragma unroll
            for (int c = 1; c < 4; ++c) if (gl[c] > gmax) { gmax = gl[c]; gsel = c; }
            float gden = 0.f;
#pragma unroll
            for (int c = 0; c < 4; ++c) gden += __expf(gl[c] - gmax);
            const float pgroup = 1.0f / gden;
            float el[8];
#pragma unroll
            for (int c = 0; c < 8; ++c) el[c] = fl[4 + gsel * EPG + c] + bias[NGRP + gsel * EPG + c];
            int i0 = 0; float l0 = el[0];
#pragma unroll
            for (int c = 1; c < 8; ++c) if (el[c] > l0) { l0 = el[c]; i0 = c; }
            int i1 = -1; float l1 = -INFINITY;
#pragma unroll
            for (int c = 0; c < 8; ++c) if (c != i0 && el[c] > l1) { l1 = el[c]; i1 = c; }
            const float e10 = __expf(l1 - l0);
            const float w0 = pgroup / (1.0f + e10), w1 = pgroup * e10 / (1.0f + e10);
            const int e0 = gsel * EPG + i0, e1 = gsel * EPG + i1;
            const unsigned p0 = __hip_atomic_fetch_add(cnt + 64 * e0, 1u, RLX_AGENT), p1 = __hip_atomic_fetch_add(cnt + 64 * e1, 1u, RLX_AGENT);
            rowidx[e0 * MREAL + p0] = m * 2; rowidx[e1 * MREAL + p1] = m * 2 + 1;
            tokw[m * 2] = w0; tokw[m * 2 + 1] = w1;
            slot[m * 2] = (e0 << 16) | (int)p0; slot[m * 2 + 1] = (e1 << 16) | (int)p1;
        }
    }
}

__device__ __forceinline__ void p8_ln2(Frame& F, const Args& A, volatile LAS int* tp) {
    const int gw = F.vcu * NWAVES + F.wave, NGW = F.G * NWAVES;
    const bf16* XN = (const bf16*)(F.ws + WS_XN); const bf16* Y = (const bf16*)(F.ws + WS_Y);
    const float* g2 = arg_in(19); const float* b2 = arg_in(20);
    const int* slot = (const int*)(F.ws + WS_SLOT); const float* tokw = (const float*)(F.ws + WS_TOKW);
    LAS f32x4* lg = (LAS f32x4*)(F.lds + RING_OFF); LAS f32x4* lb = lg + 512;
    { const int t = F.wave * 64 + lane_id(); lg[t] = ((const f32x4*)g2)[t]; lb[t] = ((const f32x4*)b2)[t]; }
    __syncthreads();
    for (int base = gw; base < MREAL; base += 4 * NGW) {
    int sl[4][2]; float wl[4][2];
#pragma unroll
    for (int k = 0; k < 4; ++k) { const int m = base + k * NGW; const int mm = m < MREAL ? m : 0; sl[k][0] = slot[2 * mm]; sl[k][1] = slot[2 * mm + 1]; wl[k][0] = tokw[2 * mm]; wl[k][1] = tokw[2 * mm + 1]; }
#pragma unroll
    for (int kp = 0; kp < 4; kp += 4) {
        int lane = lane_id();
        v2u hv[4][8], av[4][8], cv[4][8]; int mrow[4]; bool ok[4];
#pragma unroll
        for (int q = 0; q < 4; ++q) { const int k = kp + q; const int m = base + k * NGW; ok[q] = m < MREAL; mrow[q] = ok[q] ? m : 0;
            const int s0 = sl[k][0], s1 = sl[k][1];
            const int r0 = __builtin_amdgcn_readfirstlane(tp[s0 >> 16]) * 256 + (s0 & 0xffff), r1 = __builtin_amdgcn_readfirstlane(tp[s1 >> 16]) * 256 + (s1 & 0xffff);
            const v2u* hp = (const v2u*)(XN + (size_t)mrow[q] * DM) + lane; const v2u* y0 = (const v2u*)(Y + (size_t)r0 * DM) + lane; const v2u* y1 = (const v2u*)(Y + (size_t)r1 * DM) + lane;
#pragma unroll
            for (int j = 0; j < 8; ++j) { hv[q][j] = __builtin_nontemporal_load(hp + 64 * j); av[q][j] = __builtin_nontemporal_load(y0 + 64 * j); cv[q][j] = __builtin_nontemporal_load(y1 + 64 * j); } }
#pragma unroll
        for (int q = 0; q < 4; ++q) { if (!ok[q]) continue; const int k = kp + q; const float w0 = wl[k][0], w1 = wl[k][1];
            f32x4 v[8]; float s = 0.f;
#pragma unroll
            for (int j = 0; j < 8; ++j) { const v2u h = hv[q][j], a = av[q][j], c = cv[q][j];
                v[j] = (f32x4){ALPHA * bf_lo(h.x) + (w0 * bf_lo(a.x) + w1 * bf_lo(c.x)), ALPHA * bf_hi(h.x) + (w0 * bf_hi(a.x) + w1 * bf_hi(c.x)), ALPHA * bf_lo(h.y) + (w0 * bf_lo(a.y) + w1 * bf_lo(c.y)), ALPHA * bf_hi(h.y) + (w0 * bf_hi(a.y) + w1 * bf_hi(c.y))};
                s += (v[j][0] + v[j][1]) + (v[j][2] + v[j][3]); }
            const float mean = wave_sum(s) * (1.f / DM); float s2 = 0.f;
#pragma unroll
            for (int j = 0; j < 8; ++j) { v[j] = v[j] - mean; s2 += (v[j][0] * v[j][0] + v[j][1] * v[j][1]) + (v[j][2] * v[j][2] + v[j][3] * v[j][3]); }
            const float rstd = 1.f / sqrtf(wave_sum(s2) * (1.f / DM) + LN_EPS);
            f32x4* op = (f32x4*)(F.out + (size_t)mrow[q] * DM) + lane;
#pragma unroll
            for (int j = 0; j < 8; ++j) { const f32x4 gg = lg[lane + 64 * j], bb = lb[lane + 64 * j]; __builtin_nontemporal_store(v[j] * rstd * gg + bb, op + 64 * j); }
        }
    }
    }
}

__global__ void __launch_bounds__(NWAVES * 64, 2) mk_fwd(Args args) {
    extern __shared__ __attribute__((aligned(16))) unsigned char lds[];
    Frame F;
    F.lds = (LAS unsigned char*)lds;
    F.MISC = (volatile LAS unsigned*)(F.lds + MISC_OFF);
    F.wave = __builtin_amdgcn_readfirstlane((int)(threadIdx.x >> 6));
    F.G = gridDim.x; { const int bx = blockIdx.x; F.vcu = (F.G % 8 == 0) ? (bx % 8) * (F.G / 8) + bx / 8 : bx; }
    F.ws = args.ws; F.out = args.out;
    F.ctl = (gu32*)(F.ws + WS_CTL);
    for (int u = threadIdx.x; u < (LDS_BYTES - LDSCTL_OFF) / 4; u += NWAVES * 64) ((LAS unsigned*)(F.lds + LDSCTL_OFF))[u] = 0u;
    __syncthreads();
    XcdBarrier bar; bar.bar = (unsigned*)(F.ctl + CW_BAR); bar.x = 0; bar.st = nullptr; bar.wave = F.wave;
    if (N_LAUNCHES == 1) { bar = xcd_barrier_post((unsigned*)(F.ctl + CW_BAR), F.MISC + 8); bar.wave = F.wave; }
#define GRID_BAR() do { if (N_LAUNCHES == 1) xcd_barrier(bar); } while (0)
    volatile LAS unsigned long long* stamps = (volatile LAS unsigned long long*)(F.lds + LDSCTL_OFF + 4096);
    int n_stamp = 0;
#define STAMP() do { if (MK_SPIN >= 0 && blockIdx.x == 0 && F.wave == 0 && lane_id() == 0) stamps[n_stamp] = __builtin_amdgcn_s_memrealtime(); ++n_stamp; } while (0)
    STAMP();
    const int lo = args.ph_lo, hi = args.ph_hi;
#define REP(k) for (int rep_ = 0; rep_ < 1 + ((MK_DUP >> (k)) & 1); ++rep_)
#ifndef MK_PH_MASK
#define MK_PH_MASK 0x1ff
#endif
#define IN(k) (((MK_PH_MASK >> (k)) & 1) && lo <= (k) && (k) < hi)
    bf16* P = (bf16*)(F.ws + WS_P); bf16* XN = (bf16*)(F.ws + WS_XN);

    if (IN(0)) REP(0) { p0_prologue(F, args); GRID_BAR(); }
    STAMP();

    if (IN(1)) REP(1) {
        const int NSPARE = (F.G == 256) ? 24 : 0;
        if ((int)blockIdx.x < F.G - NSPARE) {
            pg8::Gemm g{XN, (const bf16*)(F.ws + WS_WIN), DM, DM, -1};
            DenseOrder S; S.init(F.wave, MREAL / 256, LDP / 256, F.G - NSPARE, (int)blockIdx.x, (long)256 * DM * 2, (long)256 * DM * 2, (PC_GA - PC_K) / 256, PC_K / 256);
            EpiBf16 E{P, LDP, PC_CC / 256, PC_GA / 256, PC_CC, PC_GA / 256};
            pg8::gemm_phase<EpiBf16, DenseOrder, true>(F.lds + RING_OFF, g, S, E);
        }
        conv_queue((unsigned*)(F.ctl + CW_Q), 0, CT_B1, F.ws, F.lds + RING_OFF, F.MISC + 16, F.wave, lane_id());
        GRID_BAR();
    }
    STAMP();
    constexpr bool SEAM23 = MK_SEAM23 && N_LAUNCHES == 1 && MK_DUP == 0;
    if (IN(2)) { p2_attention_conv(F, args); if (!SEAM23) GRID_BAR(); }
    STAMP();
    constexpr bool SEAM34 = MK_SEAM34 && N_LAUNCHES == 1 && MK_DUP == 0;
    if (IN(3)) REP(3) {
        pg8::Gemm g{P, (const bf16*)(F.ws + WS_WB2), LDP, 2 * DM, DM / 64};
        EpiGate E{P, (bf16*)(F.ws + WS_MRG), SEAM34 ? (unsigned*)(F.ctl + CW_P3) : nullptr};
        if (SEAM23) {
            DenseOrderDep S; S.init(F.wave, MREAL / 256, DM / 256, F.G, (int)blockIdx.x, (long)256 * LDP * 2, (long)256 * 2 * DM * 2);
            S.rdy = (unsigned*)(F.ctl + CW_P2); S.need = 16u; S.tmo = (unsigned*)(F.ctl + CW_TMO);
            pg8::gemm_phase<EpiGate, DenseOrderDep, true>(F.lds + RING_OFF, g, S, E);
        } else {
            DenseOrder S; S.init(F.wave, MREAL / 256, DM / 256, F.G, (int)blockIdx.x, (long)256 * LDP * 2, (long)256 * 2 * DM * 2);
            pg8::gemm_phase<EpiGate, DenseOrder, true>(F.lds + RING_OFF, g, S, E);
        }
        if (!SEAM34) GRID_BAR();
    }
    STAMP();
    constexpr bool LNFUSE = MK_LNFUSE && SEAM34;
    if (IN(4)) REP(4) {
        pg8::Gemm g{(const bf16*)(F.ws + WS_MRG), (const bf16*)(F.ws + WS_WOUT), DM, DM, -1};
        if (LNFUSE) {
            DenseOrderDep S; S.init(F.wave, MREAL / 256, DM / 256, F.G, (int)blockIdx.x, (long)256 * DM * 2, (long)256 * DM * 2);
            S.rdy = (unsigned*)(F.ctl + CW_P3); S.need = 64u; S.tmo = (unsigned*)(F.ctl + CW_TMO);
            EpiLn1 E{XN, arg_in(10), arg_in(11), (const bf16*)(F.ws + WS_REWG), (const bf16*)(F.ws + WS_REWG) + 48 * DM, (float*)(F.ws + WS_RP), (unsigned long long*)(F.ws + WS_XB),
                     (unsigned*)(F.ctl + CW_ST), (unsigned*)(F.ctl + CW_P4), (unsigned*)(F.ctl + CW_TMO)};
            pg8::gemm_phase<EpiLn1, DenseOrderDep, true>(F.lds + RING_OFF, g, S, E);
        } else {
        EpiPre E{XN, P + PC_GA, LDP, SEAM34 ? (unsigned*)(F.ctl + CW_P4) : nullptr};
        if (SEAM34) {
            DenseOrderDep S; S.init(F.wave, MREAL / 256, DM / 256, F.G, (int)blockIdx.x, (long)256 * DM * 2, (long)256 * DM * 2);
            S.rdy = (unsigned*)(F.ctl + CW_P3); S.need = 64u; S.tmo = (unsigned*)(F.ctl + CW_TMO);
            pg8::gemm_phase<EpiPre, DenseOrderDep, true>(F.lds + RING_OFF, g, S, E);
        } else {
            DenseOrder S; S.init(F.wave, MREAL / 256, DM / 256, F.G, (int)blockIdx.x, (long)256 * DM * 2, (long)256 * DM * 2);
            pg8::gemm_phase<EpiPre, DenseOrder, true>(F.lds + RING_OFF, g, S, E);
            GRID_BAR();
        }
        }
    }
    STAMP();
    if (IN(5)) { if (LNFUSE) p5_router_final(F, args); else p5_ln1_router(F, args); GRID_BAR(); }
    STAMP();
    volatile LAS int* tp = (volatile LAS int*)(F.MISC + 32);
    volatile LAS int* cn = (volatile LAS int*)(F.MISC + 72);
    if (IN(6) || IN(7) || IN(8)) {
        if (F.wave == 0) {
            const int l = lane_id(); const int c = l < NEXP ? (int)__hip_atomic_load(F.ctl + CW_CNT + 64 * (l & 31), RLX_AGENT) : 0;
            const int nt_e = (c + 255) >> 8; int inc = nt_e;
#pragma unroll
            for (int o = 1; o < 32; o <<= 1) { const int v = __shfl_up(inc, o); if ((l & 31) >= o) inc += v; }
            if (l < NEXP) { tp[l] = inc - nt_e; cn[l] = c; if (l == NEXP - 1) tp[32] = inc; }
        }
        __syncthreads();
    }
    constexpr bool MERGE = MK_MOE_MERGE && N_LAUNCHES == 1;
    if (IN(6)) REP(6) {
        pg8::Gemm g{XN, (const bf16*)(F.ws + WS_WGU), DM, DM, -1};
        MoeOrder<4, true> S{F.wave, tp, cn, F.G, F.vcu, (long)1024 * DM * 2, (long)256 * DM * 2, 0, (const int*)(F.ws + WS_ROWIDX), (unsigned)(DM * 2)};
        EpiAct E{(bf16*)(F.ws + WS_ACT), (unsigned*)(F.ctl + CW_RDY)};
        pg8::gemm_phase<EpiAct, MoeOrder<4, true>, true>(F.lds + RING_OFF, g, S, E);
        if (MERGE) conv_queue<true>((unsigned*)(F.ctl + CW_Q + 64), CT_B1, CT_B, F.ws, F.lds + RING_OFF, F.MISC + 16, F.wave, lane_id(), (unsigned*)(F.ctl + CW_WD));
        else { conv_queue<false>((unsigned*)(F.ctl + CW_Q + 64), CT_B1, CT_B, F.ws, F.lds + RING_OFF, F.MISC + 16, F.wave, lane_id()); GRID_BAR(); }
    }
    STAMP();
    if (IN(7)) REP(7) {
        pg8::Gemm g{(const bf16*)(F.ws + WS_ACT), (const bf16*)(F.ws + WS_WD), DE, DE, -1};
        EpiDown E{(bf16*)(F.ws + WS_Y)};
        if (MERGE) {
            MoeDownOrder S{F.wave, tp, cn, F.G, F.vcu, (long)DM * DE * 2, (long)256 * DE * 2, (long)256 * DE * 2, (unsigned*)(F.ctl + CW_RDY), (unsigned*)(F.ctl + CW_WD), (unsigned*)(F.ctl + CW_TMO), true};
            { pg8::Unit uu; const int l_ = lane_id(); unsigned* wp = nullptr; unsigned need = 0u;
              for (int i = 0; S.next(i, uu); ++i) if (l_ == (i < 62 ? i : 62)) { wp = (unsigned*)(F.ctl + CW_RDY + 64 * uu.pm); need = 32u; }
              if (l_ == 63) { wp = (unsigned*)(F.ctl + CW_WD); need = (unsigned)CT_DN; }
              if (F.wave == 0) { unsigned sp = 0;
                  for (;;) { const unsigned v = wp ? __hip_atomic_load(wp, RLX_AGENT) : need; if (__all(v >= need)) break;
                      __builtin_amdgcn_s_sleep(2); if (++sp > (1u << 22)) { if (l_ == 0) __hip_atomic_store((unsigned*)(F.ctl + CW_TMO), 1u, RLX_AGENT); break; } }
                  __builtin_amdgcn_fence(__ATOMIC_ACQUIRE, "agent"); asm volatile("s_waitcnt vmcnt(0)" ::: "memory"); }
              __syncthreads(); }
            pg8::gemm_phase<EpiDown, MoeDownOrder, true>(F.lds + RING_OFF, g, S, E);
        } else {
            MoeOrder<8, false> S{F.wave, tp, cn, F.G, F.vcu, (long)DM * DE * 2, (long)256 * DE * 2, (long)256 * DE * 2, (const int*)(F.ws + WS_ROWIDX), 0u};
            pg8::gemm_phase<EpiDown, MoeOrder<8, false>, true>(F.lds + RING_OFF, g, S, E);
        }
        GRID_BAR();
    }
    STAMP();
    if (IN(8)) REP(8) { p8_ln2(F, args, tp); }
    STAMP();
    if (MK_SPIN >= 0 && blockIdx.x == 0 && F.wave == 0 && lane_id() == 0) {
        const unsigned long long t_end = __builtin_amdgcn_s_memrealtime();
        const unsigned long long span = (MK_SPIN >= 100) ? (unsigned long long)MK_SPIN * 100ull : (stamps[(MK_SPIN < 9 ? MK_SPIN : 8) + 1] - stamps[MK_SPIN < 9 ? MK_SPIN : 8]);
        while (__builtin_amdgcn_s_memrealtime() - t_end < span) __builtin_amdgcn_s_sleep(8);
    }
#undef IN
#undef GRID_BAR
}

extern "C" void kernel_launch(void* const* d_in, const int* in_sizes, int n_in, void* d_out, int out_size, void* d_ws, size_t ws_size, hipStream_t stream) {
    static int grid = 0;
    if (grid == 0) {
        if (n_in != 21 || in_sizes[0] != MREAL * DM || out_size != MREAL * DM || ws_size < WS_END) { fprintf(stderr, "kernel_launch: unexpected shapes / workspace (n_in %d, ws %zu); nothing launched\n", n_in, ws_size); grid = -1; return; }
        int dev = 0, cus = 0, per_cu = 0;
        if (hipGetDevice(&dev) != hipSuccess || hipDeviceGetAttribute(&cus, hipDeviceAttributeMultiprocessorCount, dev) != hipSuccess) { grid = -1; return; }
        if (hipFuncSetAttribute((const void*)mk_fwd, hipFuncAttributeMaxDynamicSharedMemorySize, LDS_BYTES) != hipSuccess) { fprintf(stderr, "kernel_launch: hipFuncSetAttribute failed\n"); grid = -1; return; }
        if (hipOccupancyMaxActiveBlocksPerMultiprocessor(&per_cu, (const void*)mk_fwd, NWAVES * 64, LDS_BYTES) != hipSuccess || per_cu < 1) { fprintf(stderr, "kernel_launch: occupancy query reports %d\n", per_cu); }
        (void)hipGetLastError();
        grid = cus;
    }
    if (grid < 0) return;
    if (hipMemsetAsync((char*)d_ws + WS_CTL, 0, CTL_ZERO_BYTES, stream) != hipSuccess) return;
    Args a{};
    for (int i = 0; i < 21; ++i) a.in[i] = (const float*)d_in[i];
    a.out = (float*)d_out; a.ws = (unsigned char*)d_ws;
    for (int li = 0; li < N_LAUNCHES; ++li) {
        a.ph_lo = (N_LAUNCHES == 1) ? 0 : li; a.ph_hi = (N_LAUNCHES == 1) ? PER_PHASE : li + 1; a.li = li;
        hipLaunchKernelGGL(mk_fwd, dim3(grid), dim3(NWAVES * 64), LDS_BYTES, stream, a);
    }
}
```
